# Optimizing an MI355X kernel written in HIP

```python
import math
import jax
import jax.numpy as jnp
from jax import lax
import numpy as np

D_MODEL = 1024
BATCH = 4
SEQ = 8192
DEPTH = 4

GRID_W = 64
CTX_LEN = 256
NORM_EPS = 1e-6
F32 = jnp.float32

HY_W = 512
HY_ORDER = 2
HY_SHORT = 3
HY_BANDS = 16
HY_EMB = 2 * HY_BANDS + 1
HY_FFN = 64
HY_TARGET = 1e-2
HY_FAST_RATE = math.log(HY_TARGET) / 0.3
HY_SLOW_RATE = math.log(HY_TARGET) / 1.5

RG_W = 512
RG_BLOCKS = 8
RG_BS = RG_W // RG_BLOCKS
RG_CONV = 4
RG_C = 8.0

GLA_HEADS = 4
GLA_DK = 64
GLA_DV = 128
GLA_QK = GLA_HEADS * GLA_DK
GLA_V = GLA_HEADS * GLA_DV
GLA_RANK = 16
GLA_TAU = 16.0
GLA_CHUNK = 64

N_BRANCH = 3
IN_GROUPS = ((HY_ORDER + 1) * HY_W, RG_W, RG_W, 2 * GLA_QK + GLA_V + 2 * GLA_RANK, GLA_V, N_BRANCH * D_MODEL)
IN_DIM = sum(IN_GROUPS)

PEER_HEADS = 8
PEER_NKEYS = 128
PEER_EXPERTS = PEER_NKEYS * PEER_NKEYS
PEER_DKEY = 256
PEER_TOPK = 16
PEER_BLOCK = 128

kernel_name = 'hybrid_hyena_rglru_gla_peer_dit'


def rmsnorm(x, g):
    xf = x.astype(F32)
    y = xf * lax.rsqrt(jnp.mean(xf * xf, axis=-1, keepdims=True) + NORM_EPS)
    return (y * g.astype(F32)).astype(x.dtype)


def modulate(h, shift, scale):
    return h * (1.0 + scale) + shift


def flip_seq(t, d):
    return t[:, ::-1] if d else t


def raster_to_column(t):
    b_, n = t.shape[:2]
    rows = n // GRID_W
    return t.reshape(b_, rows, GRID_W, *t.shape[2:]).swapaxes(1, 2).reshape(t.shape)


def column_to_raster(t):
    b_, n = t.shape[:2]
    rows = n // GRID_W
    return t.reshape(b_, GRID_W, rows, *t.shape[2:]).swapaxes(1, 2).reshape(t.shape)


def depthwise_conv(x, w, b, left):
    width = w.shape[0]
    n = x.shape[1]
    xp = jnp.pad(x, ((0, 0), (left, width - 1 - left), (0, 0)))
    y = b
    for j in range(width):
        y = y + w[j] * xp[:, j:j + n]
    return y


def linear_scan(a, b, h0):
    def combine(lft, rgt):
        return lft[0] * rgt[0], rgt[0] * lft[1] + rgt[1]
    a_cum, b_cum = lax.associative_scan(combine, (a, b), axis=1)
    h = a_cum * h0[:, None] + b_cum
    return h, h[:, -1]


def hyena_filter_spectra(n, w1, b1, w2, b2, w3, freq):
    idx = jnp.arange(n, dtype=F32)
    tn = idx / (n - 1)
    bands = jnp.linspace(1e-4, HY_BANDS - 1, HY_BANDS, dtype=F32)
    ang = (2.0 * math.pi / n) * idx[:, None] * bands[None, :]
    feats = jnp.concatenate([tn[:, None], jnp.cos(ang), -jnp.sin(ang)], axis=-1)
    fr = freq.astype(F32)
    h = jnp.sin(fr * (feats @ w1.astype(F32) + b1.astype(F32)))
    h = jnp.sin(fr * (h @ w2.astype(F32) + b2.astype(F32)))
    h = (h @ w3.astype(F32)).reshape(n, HY_ORDER, 2, HY_W)
    deltas = jnp.abs(jnp.linspace(HY_FAST_RATE, HY_SLOW_RATE, HY_W, dtype=F32))
    window = jnp.exp(-tn[:, None] * deltas[None, :])
    h = h * window[:, None, None, :]
    h = h / (jnp.sum(jnp.abs(h), axis=(0, 2), keepdims=True) + 1e-6)
    h_fwd, h_bwd = h[:, :, 0], h[:, :, 1]
    taps = jnp.concatenate([h_fwd[:1] + h_bwd[:1], h_fwd[1:], jnp.zeros_like(h_fwd[:1]), h_bwd[:0:-1]], axis=0)
    return jnp.fft.rfft(taps, axis=0)


def fft_long_conv(u, spec, skip):
    n = u.shape[1]
    uf = jnp.fft.rfft(u, n=2 * n, axis=1)
    y = jnp.fft.irfft(uf * spec[None], n=2 * n, axis=1)[:, :n]
    return y + u * skip


def hyena_mix(u, conv_w, conv_b, w1, b1, w2, b2, w3, freq, skip):
    dt = u.dtype
    n = u.shape[1]
    u = depthwise_conv(u, conv_w, conv_b, left=(HY_SHORT - 1) // 2).astype(F32)
    v, x1, x2 = jnp.split(u, 3, axis=-1)
    spec = hyena_filter_spectra(n, w1, b1, w2, b2, w3, freq)
    skip = skip.astype(F32)
    z = x1 * fft_long_conv(v, spec[:, 0], skip[0])
    z = x2 * fft_long_conv(z, spec[:, 1], skip[1])
    return z.astype(dt)


def rglru_scan(u, h0, conv_w, conv_b, wa, ba, wx, bx, lam):
    b_, n, _ = u.shape
    xc = depthwise_conv(u, conv_w, conv_b, left=RG_CONV - 1)
    xb = xc.reshape(b_, n, RG_BLOCKS, RG_BS)
    gate_r = jax.nn.sigmoid((jnp.einsum('blgi,gij->blgj', xb, wa).reshape(b_, n, RG_W) + ba).astype(F32))
    gate_i = jax.nn.sigmoid((jnp.einsum('blgi,gij->blgj', xb, wx).reshape(b_, n, RG_W) + bx).astype(F32))
    log_a = -RG_C * gate_r * jax.nn.softplus(-lam.astype(F32))
    a = jnp.exp(log_a)
    b = jnp.sqrt(-jnp.expm1(2.0 * log_a)) * (gate_i * xc.astype(F32))
    return linear_scan(a, b, h0)


def rglru_mix(u_ctx, g_ctx, u_lat, g_lat, conv_w, conv_b, wa, ba, wx, bx, lam, need_ctx):
    h0 = jnp.zeros((u_lat.shape[0], RG_W), F32)
    h_ctx = 0.0
    h_lat = 0.0
    for d in range(2):
        args = (conv_w[d], conv_b[d], wa[d], ba[d], wx[d], bx[d], lam[d])
        hc, hc_last = rglru_scan(flip_seq(u_ctx, d), h0, *args)
        hl, _ = rglru_scan(flip_seq(u_lat, d), hc_last, *args)
        h_ctx = h_ctx + flip_seq(hc, d)
        h_lat = h_lat + flip_seq(hl, d)
    y_lat = h_lat.astype(u_lat.dtype) * jax.nn.gelu(g_lat)
    y_ctx = h_ctx.astype(u_ctx.dtype) * jax.nn.gelu(g_ctx) if need_ctx else None
    return y_ctx, y_lat


def gla_chunked(q, k, v, log_a, s0):
    b_, n, nh, _ = q.shape
    nc = n // GLA_CHUNK

    def blocks(t):
        return t.reshape(b_, nc, GLA_CHUNK, nh, t.shape[-1]).transpose(0, 3, 1, 2, 4)

    q, k, v, log_a = blocks(q), blocks(k), blocks(v), blocks(log_a)
    cum = jnp.cumsum(log_a, axis=3)
    cum_last = cum[:, :, :, -1:]
    qg = q * jnp.exp(cum)
    scores = jnp.einsum('bhncd,bhnsd->bhncs', qg, k * jnp.exp(-cum))
    lower = jnp.tril(jnp.ones((GLA_CHUNK, GLA_CHUNK), dtype=bool))
    scores = jnp.where(lower, scores, 0.0)
    o = jnp.einsum('bhncs,bhnse->bhnce', scores, v)
    ds = jnp.einsum('bhncd,bhnce->bhnde', k * jnp.exp(cum_last - cum), v)
    decay = jnp.exp(cum_last[:, :, :, 0])

    def combine(lft, rgt):
        return lft[0] * rgt[0], rgt[0][..., None] * lft[1] + rgt[1]

    d_cum, s_cum = lax.associative_scan(combine, (decay, ds), axis=2)
    s_end = d_cum[..., None] * s0[:, :, None] + s_cum
    s_start = jnp.concatenate([s0[:, :, None], s_end[:, :, :-1]], axis=2)
    o = o + jnp.einsum('bhncd,bhnde->bhnce', qg, s_start)
    o = o.transpose(0, 2, 3, 1, 4).reshape(b_, n, nh, GLA_DV)
    return o, s_end[:, :, -1]


def gla_prepare(t, w_lr, b_lr):
    b_, n, _ = t.shape
    t = t.astype(F32)
    q, k, v, lr = jnp.split(t, [GLA_QK, 2 * GLA_QK, 2 * GLA_QK + GLA_V], axis=-1)
    q = q.reshape(b_, n, GLA_HEADS, GLA_DK) * (GLA_DK ** -0.5)
    k = k.reshape(b_, n, GLA_HEADS, GLA_DK)
    v = v.reshape(b_, n, GLA_HEADS, GLA_DV)
    lr = lr.reshape(b_, n, 2, GLA_RANK)
    logits = jnp.einsum('bldr,drk->bldk', lr, w_lr.astype(F32)) + b_lr.astype(F32)
    log_a = (jax.nn.log_sigmoid(logits) / GLA_TAU).reshape(b_, n, 2, GLA_HEADS, GLA_DK)
    return q, k, v, log_a


def gla_mix(t_ctx, t_lat, w_lr, b_lr):
    qc, kc, vc, lac = gla_prepare(t_ctx, w_lr, b_lr)
    ql, kl, vl, lal = gla_prepare(t_lat, w_lr, b_lr)
    s0 = jnp.zeros((qc.shape[0], GLA_HEADS, GLA_DK, GLA_DV), F32)
    o_ctx = -jnp.sum(qc * kc, axis=-1, keepdims=True) * vc
    o_lat = -jnp.sum(ql * kl, axis=-1, keepdims=True) * vl
    for d in range(2):
        oc, sc = gla_chunked(flip_seq(qc, d), flip_seq(kc, d), flip_seq(vc, d), flip_seq(lac[:, :, d], d), s0)
        ol, _ = gla_chunked(flip_seq(ql, d), flip_seq(kl, d), flip_seq(vl, d), flip_seq(lal[:, :, d], d), sc)
        o_ctx = o_ctx + flip_seq(oc, d)
        o_lat = o_lat + flip_seq(ol, d)
    return o_ctx, o_lat


def gla_finish(o, g, norm_g):
    on = o * lax.rsqrt(jnp.mean(o * o, axis=-1, keepdims=True) + NORM_EPS) * norm_g.astype(F32)
    return on.reshape(g.shape).astype(g.dtype) * jax.nn.silu(g)


def merge_branches(gate_logits, y_hy, y_rg, y_gla, lp):
    g = jax.nn.sigmoid(gate_logits + lp['b_merge'])
    g_hy, g_rg, g_gla = jnp.split(g, N_BRANCH, axis=-1)
    m = g_hy * (y_hy @ lp['w_hy_o']) + g_rg * (y_rg @ lp['w_rg_o']) + g_gla * (y_gla @ lp['w_gla_o'])
    return m @ lp['w_out']


def token_mixer(h_ctx, h_lat, lp, need_ctx):
    pts = [int(p) for p in np.cumsum(IN_GROUPS)[:-1]]
    hy_c, rgx_c, rgg_c, gla_c, glag_c, mg_c = jnp.split(h_ctx @ lp['w_in'], pts, axis=-1)
    hy_l, rgx_l, rgg_l, gla_l, glag_l, mg_l = jnp.split(h_lat @ lp['w_in'], pts, axis=-1)
    hy_args = (lp['hy_conv_w'], lp['hy_conv_b'], lp['hy_w1'], lp['hy_b1'], lp['hy_w2'], lp['hy_b2'],
               lp['hy_w3'], lp['hy_freq'], lp['hy_skip'])
    y_hy_l = hyena_mix(hy_l, *hy_args)
    y_rg_c, y_rg_l = rglru_mix(rgx_c, rgg_c, rgx_l, rgg_l, lp['rg_conv_w'], lp['rg_conv_b'], lp['rg_wa'],
                               lp['rg_ba'], lp['rg_wx'], lp['rg_bx'], lp['rg_lambda'], need_ctx)
    o_gla_c, o_gla_l = gla_mix(gla_c, raster_to_column(gla_l), lp['gla_w_lr'], lp['gla_b_lr'])
    y_gla_l = gla_finish(column_to_raster(o_gla_l), glag_l, lp['gla_norm_g'])
    out_lat = merge_branches(mg_l, y_hy_l, y_rg_l, y_gla_l, lp)
    if not need_ctx:
        return None, out_lat
    y_hy_c = hyena_mix(hy_c, *hy_args)
    y_gla_c = gla_finish(o_gla_c, glag_c, lp['gla_norm_g'])
    out_ctx = merge_branches(mg_c, y_hy_c, y_rg_c, y_gla_c, lp)
    return out_ctx, out_lat


def peer_ffn(h, wq, keys, u_tab, v_tab):
    b_, n, dm = h.shape
    token_blocks = h.reshape(b_ * n // PEER_BLOCK, PEER_BLOCK, dm)
    keys = keys.astype(F32)

    def block(xb):
        q = (xb @ wq).astype(F32).reshape(PEER_BLOCK, PEER_HEADS, 2, PEER_DKEY // 2)
        s = jnp.einsum('thpc,hpnc->thpn', q, keys)
        s_top, i_top = lax.top_k(s, PEER_TOPK)
        cand = (s_top[:, :, 0, :, None] + s_top[:, :, 1, None, :]).reshape(PEER_BLOCK, PEER_HEADS, -1)
        cand_idx = (i_top[:, :, 0, :, None] * PEER_NKEYS + i_top[:, :, 1, None, :]).reshape(PEER_BLOCK, PEER_HEADS, -1)
        best, pos = lax.top_k(cand, PEER_TOPK)
        expert = jnp.take_along_axis(cand_idx, pos, axis=-1).reshape(PEER_BLOCK, -1)
        weight = jax.nn.softmax(best, axis=-1).reshape(PEER_BLOCK, -1)
        u = jnp.take(u_tab, expert, axis=0)
        v = jnp.take(v_tab, expert, axis=0)
        act = jax.nn.gelu(jnp.einsum('td,ted->te', xb, u).astype(F32))
        return jnp.einsum('te,ted->td', (weight * act).astype(v.dtype), v)

    return lax.map(block, token_blocks).reshape(b_, n, dm)


def setup_inputs(seed: int = 0) -> dict:
    key = jax.random.key(seed)
    keys = jax.random.split(key, 48)
    counter = [0]

    def nrm(shape, scale):
        k = keys[counter[0]]
        counter[0] += 1
        return jax.random.normal(k, shape, F32) * scale

    def gain(shape):
        return 1.0 + nrm(shape, 0.05)

    d = D_MODEL
    lam_u = jax.random.uniform(keys[47], (DEPTH, 2, RG_W), F32, 0.9, 0.999)
    lam_a = lam_u ** (1.0 / RG_C)
    rg_lambda = jnp.log(lam_a) - jnp.log1p(-lam_a)
    return {
        'x': nrm((BATCH, SEQ, d), 1.0),
        'c': nrm((BATCH, d), 1.0),
        'ctx': nrm((BATCH, CTX_LEN, d), 1.0),
        'c_ctx': nrm((d,), 1.0),
        'w_mod': nrm((DEPTH, d, 6 * d), 0.5 * d ** -0.5),
        'b_mod': nrm((DEPTH, 6 * d), 0.02),
        'g_norm_mix': gain((DEPTH, d)),
        'g_norm_ffn': gain((DEPTH, d)),
        'w_in': nrm((DEPTH, d, IN_DIM), d ** -0.5),
        'hy_conv_w': nrm((DEPTH, HY_SHORT, (HY_ORDER + 1) * HY_W), 0.5),
        'hy_conv_b': nrm((DEPTH, (HY_ORDER + 1) * HY_W), 0.02),
        'hy_w1': nrm((DEPTH, HY_EMB, HY_FFN), HY_EMB ** -0.5),
        'hy_b1': nrm((DEPTH, HY_FFN), 0.1),
        'hy_w2': nrm((DEPTH, HY_FFN, HY_FFN), HY_FFN ** -0.5),
        'hy_b2': nrm((DEPTH, HY_FFN), 0.1),
        'hy_w3': nrm((DEPTH, HY_FFN, HY_ORDER * 2 * HY_W), HY_FFN ** -0.5),
        'hy_freq': gain((DEPTH, HY_FFN)),
        'hy_skip': nrm((DEPTH, HY_ORDER, HY_W), 0.1),
        'rg_conv_w': nrm((DEPTH, 2, RG_CONV, RG_W), 0.5),
        'rg_conv_b': nrm((DEPTH, 2, RG_W), 0.02),
        'rg_wa': nrm((DEPTH, 2, RG_BLOCKS, RG_BS, RG_BS), RG_BS ** -0.5),
        'rg_ba': nrm((DEPTH, 2, RG_W), 0.1),
        'rg_wx': nrm((DEPTH, 2, RG_BLOCKS, RG_BS, RG_BS), RG_BS ** -0.5),
        'rg_bx': nrm((DEPTH, 2, RG_W), 0.1),
        'rg_lambda': rg_lambda,
        'gla_w_lr': nrm((DEPTH, 2, GLA_RANK, GLA_QK), GLA_RANK ** -0.5),
        'gla_b_lr': nrm((DEPTH, 2, GLA_QK), 0.1),
        'gla_norm_g': gain((DEPTH, GLA_DV)),
        'w_hy_o': nrm((DEPTH, HY_W, d), HY_W ** -0.5),
        'w_rg_o': nrm((DEPTH, RG_W, d), RG_W ** -0.5),
        'w_gla_o': nrm((DEPTH, GLA_V, d), GLA_V ** -0.5),
        'b_merge': nrm((DEPTH, N_BRANCH * d), 0.02),
        'w_out': nrm((DEPTH, d, d), d ** -0.5),
        'peer_wq': nrm((DEPTH, d, PEER_HEADS * PEER_DKEY), d ** -0.5),
        'peer_keys': nrm((DEPTH, PEER_HEADS, 2, PEER_NKEYS, PEER_DKEY // 2), (PEER_DKEY // 2) ** -0.5),
        'peer_u': nrm((DEPTH, PEER_EXPERTS, d), d ** -0.5),
        'peer_v': nrm((DEPTH, PEER_EXPERTS, d), 0.5),
        'g_final': gain((d,)),
    }


def reference(x, c, ctx, c_ctx, w_mod, b_mod, g_norm_mix, g_norm_ffn, w_in, hy_conv_w, hy_conv_b,
              hy_w1, hy_b1, hy_w2, hy_b2, hy_w3, hy_freq, hy_skip, rg_conv_w, rg_conv_b, rg_wa, rg_ba,
              rg_wx, rg_bx, rg_lambda, gla_w_lr, gla_b_lr, gla_norm_g, w_hy_o, w_rg_o, w_gla_o, b_merge,
              w_out, peer_wq, peer_keys, peer_u, peer_v, g_final):
    cond_lat = jax.nn.silu(c)[:, None, :]
    cond_ctx = jax.nn.silu(c_ctx)[None, None, :]
    x_lat, x_ctx = x, ctx
    for l in range(DEPTH):
        need_ctx = l < DEPTH - 1
        sh1, sc1, gt1, sh2, sc2, gt2 = jnp.split(cond_lat @ w_mod[l] + b_mod[l], 6, axis=-1)
        csh1, csc1, cgt1, csh2, csc2, cgt2 = jnp.split(cond_ctx @ w_mod[l] + b_mod[l], 6, axis=-1)
        lp = {
            'w_in': w_in[l], 'hy_conv_w': hy_conv_w[l], 'hy_conv_b': hy_conv_b[l],
            'hy_w1': hy_w1[l], 'hy_b1': hy_b1[l], 'hy_w2': hy_w2[l], 'hy_b2': hy_b2[l],
            'hy_w3': hy_w3[l], 'hy_freq': hy_freq[l], 'hy_skip': hy_skip[l],
            'rg_conv_w': rg_conv_w[l], 'rg_conv_b': rg_conv_b[l], 'rg_wa': rg_wa[l], 'rg_ba': rg_ba[l],
            'rg_wx': rg_wx[l], 'rg_bx': rg_bx[l], 'rg_lambda': rg_lambda[l],
            'gla_w_lr': gla_w_lr[l], 'gla_b_lr': gla_b_lr[l], 'gla_norm_g': gla_norm_g[l],
            'w_hy_o': w_hy_o[l], 'w_rg_o': w_rg_o[l], 'w_gla_o': w_gla_o[l],
            'b_merge': b_merge[l], 'w_out': w_out[l],
        }
        h_lat = modulate(rmsnorm(x_lat, g_norm_mix[l]), sh1, sc1)
        h_ctx = modulate(rmsnorm(x_ctx, g_norm_mix[l]), csh1, csc1)
        y_ctx, y_lat = token_mixer(h_ctx, h_lat, lp, need_ctx)
        x_lat = x_lat + gt1 * y_lat
        h_lat = modulate(rmsnorm(x_lat, g_norm_ffn[l]), sh2, sc2)
        x_lat = x_lat + gt2 * peer_ffn(h_lat, peer_wq[l], peer_keys[l], peer_u[l], peer_v[l])
        if need_ctx:
            x_ctx = x_ctx + cgt1 * y_ctx
            h_ctx = modulate(rmsnorm(x_ctx, g_norm_ffn[l]), csh2, csc2)
            x_ctx = x_ctx + cgt2 * peer_ffn(h_ctx, peer_wq[l], peer_keys[l], peer_u[l], peer_v[l])
    return rmsnorm(x_lat, g_final)
```

```cpp
#define N_LAUNCH_MODE 1
#include <hip/hip_runtime.h>
#include <stdint.h>
#include <cstdio>
#include <cstring>

typedef unsigned short bf16_t;
typedef float cf2 __attribute__((ext_vector_type(2)));
typedef short bf16x8 __attribute__((ext_vector_type(8)));
typedef float f32x4 __attribute__((ext_vector_type(4)));
typedef float f32x16 __attribute__((ext_vector_type(16)));
typedef unsigned u32x4 __attribute__((ext_vector_type(4)));
typedef unsigned u32x2 __attribute__((ext_vector_type(2)));
#define LAS __attribute__((address_space(3)))

#define DI __device__ __forceinline__

constexpr int NTOK = 33792, NLAT = 32768, DM = 1024, SEQ = 8192, CTXL = 256, NCHK = 132;
constexpr int P2W = 6144;
constexpr int PC_RGX = 0, PC_RGG = 512, PC_Q = 1024, PC_K = 1280, PC_V = 1536, PC_LAF = 2048, PC_LAB = 2304, PC_GG = 2560, PC_MG = 3072;
constexpr float NORM_EPS = 1e-6f;
constexpr size_t WS_CTL = 0;
constexpr size_t WS_MOD = 65536;
constexpr size_t WS_XCTX = WS_MOD + 491520;
constexpr size_t WS_H = WS_XCTX + 4194304;
constexpr size_t WS_YHT = WS_H, WS_YHY = WS_H + 33554432;
constexpr size_t WS_P2 = WS_H + 69206016;
constexpr size_t WS_Q = WS_P2, WS_SELI = WS_P2 + 138412032, WS_SELW = WS_SELI + 17301504;
constexpr size_t WS_HYT = WS_P2 + 415236096;
constexpr size_t WS_HYTC = WS_HYT + 100663296;
constexpr size_t WS_M = WS_HYT;
constexpr size_t WS_HF = WS_HYT;
constexpr size_t WS_YRG = WS_HYT + 103809024;
constexpr size_t WS_YGLA = WS_YRG + 34603008;
constexpr size_t WS_SPEC = WS_YGLA + 34603008;
constexpr size_t WS_GST = WS_SPEC + 67108864;
constexpr size_t WS_HWT = WS_GST;
constexpr size_t WS_GDEC = WS_GST + 138412032;
constexpr size_t WS_RGAGG = WS_GDEC + 1081344;
constexpr size_t WS_RGCAR = WS_RGAGG + 4325376;
constexpr size_t WS_BTIN = WS_RGCAR + 2162688;
constexpr size_t WS_BTHY = WS_BTIN + 15728640;
constexpr size_t WS_BTRG = WS_BTHY + 1048576, WS_BTGLA = WS_BTRG + 1048576;
constexpr size_t WS_BTOUT = WS_BTGLA + 1048576;
constexpr size_t WS_BTWQ = WS_BTOUT + 2097152;
constexpr size_t WS_KEYS = WS_BTWQ + 4194304;
constexpr size_t WS_RGW = WS_KEYS + 524288;
constexpr size_t WS_PU = WS_RGW + 262144;
constexpr size_t WS_PV = WS_PU + 33554432;
constexpr size_t WS_HWTC = WS_PV + 33554432;
constexpr size_t WS_SPART = WS_HWTC + 2097152;
constexpr size_t WS_END = WS_SPART + 2162688;

constexpr int LDS_BIG = 131072, LDS_TW = 131072, LDS_BARW = 133120, LDS_BYTES = 147456;

#ifndef ABL
#define ABL 0
#endif
struct Args {
    const float* in[38];
    float* out;
    unsigned char* ws;
    int ph_lo, ph_hi;
};

typedef __bf16 bfv2_t __attribute__((ext_vector_type(2)));
DI unsigned pk_bf16(float lo, float hi) { cf2 f; f.x = lo; f.y = hi; const bfv2_t r = __builtin_convertvector(f, bfv2_t); return __builtin_bit_cast(unsigned, r); }
DI bf16_t f2bf(float x) { return (bf16_t)(pk_bf16(x, 0.f) & 0xffffu); }
DI float bf2f(bf16_t u) { return __uint_as_float(((unsigned)u) << 16); }
DI float bflo(unsigned u) { return __uint_as_float(u << 16); }
DI float bfhi(unsigned u) { return __uint_as_float(u & 0xffff0000u); }
DI float sigmoidf_(float x) { return __builtin_amdgcn_rcpf(1.0f + __expf(-x)); }
DI float siluf_(float x) { return x * sigmoidf_(x); }
DI float geluf_(float x) { const float z = 1.5957691216057308f * (x + 0.044715f * x * x * x); return x * sigmoidf_(z); }
DI float logsigmoidf_(float x) { return -(fmaxf(-x, 0.f) + __logf(1.0f + __expf(-fabsf(x)))); }
DI cf2 mk2(float a, float b) { cf2 r; r.x = a; r.y = b; return r; }
DI cf2 cmul(cf2 a, cf2 b) { return mk2(a.x * b.x - a.y * b.y, a.x * b.y + a.y * b.x); }
DI cf2 cmulc(cf2 a, cf2 b) { return mk2(a.x * b.x + a.y * b.y, a.y * b.x - a.x * b.y); }
#define LDS_FENCE() asm volatile("s_waitcnt lgkmcnt(0)" ::: "memory")

#define XB_TMO      128
#define XB_XCNT(j)  (256  + 64 * (j))
#define XB_XSUB(j)  (1280 + 64 * (j))
#define XB_XGEN(j)  (2304 + 64 * (j))
#define XB_TOP      3328
#define XB_TOPGEN   3392
#define XCD_BAR_WORDS 3456
#define XB_SPIN_CAP (1u << 18)
__device__ __forceinline__ unsigned xb_ld(unsigned* p)              { return __hip_atomic_load(p, __ATOMIC_RELAXED, __HIP_MEMORY_SCOPE_AGENT); }
__device__ __forceinline__ unsigned xb_add(unsigned* p, unsigned v) { return __hip_atomic_fetch_add(p, v, __ATOMIC_RELAXED, __HIP_MEMORY_SCOPE_AGENT); }
__device__ __forceinline__ unsigned xb_xcc_id() { return (unsigned)__builtin_amdgcn_s_getreg((3 << 11) | 20) & 0xFu; }
#define XB_SPIN(cond, bar) do { unsigned _sp = 0; while (cond) { __builtin_amdgcn_s_sleep(1); \
    if ((++_sp & 255u) == 0u) { if (xb_ld(&(bar)[XB_TMO])) break; if (_sp > XB_SPIN_CAP) { atomicAdd(&(bar)[XB_TMO], 1u); break; } } } } while (0)
struct XcdBarrier { unsigned* bar; unsigned x; volatile LAS unsigned* st; };
__device__ __forceinline__ XcdBarrier xcd_barrier_post(unsigned* bar, volatile LAS unsigned* st) {
    XcdBarrier b; b.bar = bar; b.x = xb_xcc_id(); b.st = st;
    if (threadIdx.x == 0) (void)xb_add(&bar[XB_XCNT(b.x)], 1u);
    return b;
}
__device__ __forceinline__ void xcd_barrier_complete(unsigned* bar, unsigned x, unsigned& nloc, unsigned& nx) {
    const unsigned G = gridDim.x * gridDim.y * gridDim.z;
    unsigned sum, cnt, mine, sp = 0u;
    for (;;) {
        sum = 0u; cnt = 0u; mine = 0u;
#pragma unroll
        for (unsigned j = 0; j < 16; ++j) { const unsigned c = xb_ld(&bar[XB_XCNT(j)]); sum += c; cnt += (c > 0u) ? 1u : 0u; mine = (j == x) ? c : mine; }
        if (sum == G) break;
        __builtin_amdgcn_s_sleep(1);
        if ((++sp & 255u) == 0u) { if (xb_ld(&bar[XB_TMO])) break; if (sp > XB_SPIN_CAP) { atomicAdd(&bar[XB_TMO], 1u); break; } }
    }
    nloc = mine > 0u ? mine : 1u; nx = cnt > 0u ? cnt : 1u;
}
__device__ __forceinline__ void xcd_barrier(const XcdBarrier& b) {
    asm volatile("s_waitcnt vmcnt(0)" ::: "memory");
    __syncthreads();
    if (threadIdx.x == 0) {
        unsigned* bar = b.bar;
        __builtin_amdgcn_s_waitcnt(0);
        unsigned nloc = b.st[0], nx = b.st[1];
        if (nloc == 0u) { xcd_barrier_complete(bar, b.x, nloc, nx); b.st[0] = nloc; b.st[1] = nx; }
        const unsigned old = xb_add(&bar[XB_XSUB(b.x)], 1u);
        const unsigned gen = old / nloc;
        if (old + 1u == (gen + 1u) * nloc) {
            __builtin_amdgcn_fence(__ATOMIC_RELEASE, "agent");
            asm volatile("s_waitcnt vmcnt(0)" ::: "memory");
            const unsigned og = xb_add(&bar[XB_TOP], 1u);
            const unsigned tg = og / nx;
            if (og + 1u == (tg + 1u) * nx) xb_add(&bar[XB_TOPGEN], 1u);
            else XB_SPIN(xb_ld(&bar[XB_TOPGEN]) == tg, bar);
            __builtin_amdgcn_fence(__ATOMIC_ACQUIRE, "agent");
            xb_add(&bar[XB_XGEN(b.x)], 1u);
            asm volatile("s_waitcnt vmcnt(0)" ::: "memory");
        } else {
            XB_SPIN(xb_ld(&bar[XB_XGEN(b.x)]) == gen, bar);
            __builtin_amdgcn_fence(__ATOMIC_ACQUIRE, "agent");
            asm volatile("s_waitcnt vmcnt(0)" ::: "memory");
        }
    }
    __syncthreads();
}

namespace pg8 {
constexpr int BM = 256, BK = 64, HALF = 128, HTB = HALF * BK * 2, STAGE_BYTES = 8 * HTB, NXCD = 8, WGM = 8;
__host__ __device__ __forceinline__ int lds_byte(int r, int c) { const int st = (r >> 4) * 2 + (c >> 5), rr = r & 15, cc = c & 31, ob = rr * 64 + cc * 2; return st * 1024 + (ob ^ (((ob >> 9) & 1) << 5)); }
__host__ __device__ __forceinline__ void stage_rc(int b, int& R, int& C) { const int st = b / 1024, sb = b % 1024, swz = sb ^ (((sb >> 9) & 1) << 5); R = (st >> 1) * 16 + swz / 64; C = (st & 1) * 32 + (swz % 64) / 2; }
__host__ __device__ __forceinline__ int perm32(int rho) { const int n = rho >> 4, i = rho & 15; return 8 * (i >> 2) + 4 * n + (i & 3); }
struct Unit { int pm, pn, seg; };
struct StaticOrder {
    int nM, nN, nwg, G, c;
    __device__ void init(int M, int N, int G_, int c_) { nM = M / BM; nN = N / BM; nwg = nM * nN; G = G_; c = c_; }
    __device__ bool next(int i, Unit& u) const {
        const long L = (long)i * G + c; if (L >= nwg) return false;
        int wgid = (int)L; { const int q = nwg / NXCD, r = nwg % NXCD, xcd = wgid % NXCD, off = wgid / NXCD; wgid = (xcd < r ? xcd * (q + 1) : r * (q + 1) + (xcd - r) * q) + off; }
        const int nig = WGM * nN, gid = wgid / nig, fm = gid * WGM, gsz = (nM - fm) < WGM ? (nM - fm) : WGM;
        u.pm = fm + ((wgid % nig) % gsz); u.pn = (wgid % nig) / gsz; u.seg = 0; return true;
    }
};
template <class Epi, class Sched>
__device__ __forceinline__ void gemm_phase(LAS unsigned char* lds, const int K, const Sched& S, const Epi& E) {
    int tid_ = threadIdx.x; asm volatile("" : "+v"(tid_));
    const int tid = tid_, wid = __builtin_amdgcn_readfirstlane(tid >> 6), lane = tid & 63, wr = wid >> 2, wc = wid & 3, fr = lane & 15, fq = lane >> 4;
    const int nt = K / BK;
    unsigned voffA[2], voffB[2];
#pragma unroll
    for (int i = 0; i < 2; ++i) { int R, C; stage_rc(tid * 16 + i * 8192, R, C); const int Rb = Epi::PERM ? ((R & ~31) + perm32(R & 31)) : R;
        voffA[i] = (unsigned)(R * K + C) * 2u; voffB[i] = (unsigned)(Rb * K + C) * 2u; }
    const size_t kstep = (size_t)(BK * 2);
    const size_t hstep = (size_t)HALF * K * 2;
    const unsigned ldsw = (unsigned)wid * 1024u;
    const int aoff = lds_byte(wr * 64 + fr, fq * 8), boff = lds_byte(wc * 32 + fr, fq * 8);
#define PG8_SA(b, h) (((b) * 2 + (h)) * HTB)
#define PG8_SB(b, h) ((4 + (b) * 2 + (h)) * HTB)
#define PG8_STAGE(bufoff, gbase, voff) do { _Pragma("unroll") for (int _i = 0; _i < 2; ++_i) \
        __builtin_amdgcn_global_load_lds((const unsigned*)((const char*)(gbase) + (voff)[_i]), (LAS unsigned*)(lds + (bufoff) + ldsw + _i * 8192), 16, 0, 0); } while (0)
#define PG8_LDA(dst, b, h) do { _Pragma("unroll") for (int m = 0; m < 4; ++m) _Pragma("unroll") for (int k = 0; k < 2; ++k) dst[m][k] = *(const LAS bf16x8*)(lds + PG8_SA(b, h) + aoff + m * 2048 + k * 1024); } while (0)
#define PG8_LDB(dst, b, h) do { _Pragma("unroll") for (int n = 0; n < 2; ++n) _Pragma("unroll") for (int k = 0; k < 2; ++k) dst[n][k] = *(const LAS bf16x8*)(lds + PG8_SB(b, h) + boff + n * 2048 + k * 1024); } while (0)
#define PG8_MMA(ai, bj, At, Bt) do { __builtin_amdgcn_s_setprio(1); _Pragma("unroll") for (int m = 0; m < 4; ++m) _Pragma("unroll") for (int n = 0; n < 2; ++n) _Pragma("unroll") for (int k = 0; k < 2; ++k) \
        acc[ai][bj][m][n] = __builtin_amdgcn_mfma_f32_16x16x32_bf16(Bt[n][k], At[m][k], acc[ai][bj][m][n], 0, 0, 0); __builtin_amdgcn_s_setprio(0); } while (0)
#define PG8_WAIT_V(n) asm volatile("s_waitcnt vmcnt(" #n ")" ::: "memory")
#define PG8_WAIT_L(n) asm volatile("s_waitcnt lgkmcnt(" #n ")" ::: "memory")
#define PG8_BAR __builtin_amdgcn_s_barrier()
#define PG8_SCHED __builtin_amdgcn_sched_barrier(0)
    Unit cur, nxt; int ui = 0;
    if (!S.next(0, cur)) return;
    f32x4 acc[2][2][4][2];
#pragma unroll
    for (int a = 0; a < 2; ++a)
#pragma unroll
        for (int b = 0; b < 2; ++b)
#pragma unroll
            for (int m = 0; m < 4; ++m)
#pragma unroll
                for (int n = 0; n < 2; ++n) acc[a][b][m][n] = (f32x4){0.f, 0.f, 0.f, 0.f};
    bf16x8 At[4][2], B0[2][2], B1[2][2];
    const char* cA; const char* cB; S.ptrs(cur, cA, cB);
    PG8_STAGE(PG8_SB(0, 0), cB, voffB); PG8_STAGE(PG8_SA(0, 0), cA, voffA); PG8_STAGE(PG8_SB(0, 1), cB + hstep, voffB); PG8_STAGE(PG8_SA(0, 1), cA + hstep, voffA);
    if (wr == 1) PG8_BAR;
    PG8_WAIT_V(4); PG8_BAR;
    PG8_STAGE(PG8_SB(1, 0), cB + kstep, voffB); PG8_STAGE(PG8_SA(1, 0), cA + kstep, voffA); PG8_STAGE(PG8_SB(1, 1), cB + hstep + kstep, voffB);
    PG8_WAIT_V(6); PG8_BAR;
    for (;;) {
        const bool has_next = S.next(ui + 1, nxt);
        const char* nA = cA; const char* nB = cB; if (has_next) S.ptrs(nxt, nA, nB);
        for (int t = 0; t < nt; t += 2) {
            const bool last = (t == nt - 2);
            const char* a1 = cA + (size_t)(t + 1) * kstep;
            const char* a2 = last ? nA : cA + (size_t)(t + 2) * kstep; const char* b2 = last ? nB : cB + (size_t)(t + 2) * kstep;
            const char* a3 = a2 + kstep; const char* b3 = b2 + kstep;
            PG8_LDB(B0, 0, 0); PG8_SCHED; PG8_LDA(At, 0, 0); PG8_STAGE(PG8_SA(1, 1), a1 + hstep, voffA);
            PG8_WAIT_L(8); PG8_BAR; PG8_WAIT_L(0); PG8_MMA(0, 0, At, B0); PG8_BAR; PG8_SCHED;
            PG8_LDB(B1, 0, 1); PG8_STAGE(PG8_SB(0, 0), b2, voffB);
            PG8_BAR; PG8_WAIT_L(0); PG8_MMA(0, 1, At, B1); PG8_BAR;
            PG8_LDA(At, 0, 1); PG8_STAGE(PG8_SA(0, 0), a2, voffA);
            PG8_BAR; PG8_WAIT_L(0); PG8_MMA(1, 0, At, B0); PG8_BAR; PG8_SCHED;
            PG8_STAGE(PG8_SB(0, 1), b2 + hstep, voffB);
            PG8_WAIT_V(6); PG8_BAR; PG8_MMA(1, 1, At, B1); PG8_BAR;
            PG8_LDB(B0, 1, 0); PG8_SCHED; PG8_LDA(At, 1, 0); PG8_STAGE(PG8_SA(0, 1), a2 + hstep, voffA);
            PG8_WAIT_L(8); PG8_BAR; PG8_WAIT_L(0); PG8_MMA(0, 0, At, B0); PG8_BAR; PG8_SCHED;
            PG8_LDB(B1, 1, 1); PG8_STAGE(PG8_SB(1, 0), b3, voffB);
            PG8_BAR; PG8_WAIT_L(0); PG8_MMA(0, 1, At, B1); PG8_BAR;
            PG8_LDA(At, 1, 1); PG8_STAGE(PG8_SA(1, 0), a3, voffA);
            PG8_BAR; PG8_WAIT_L(0); PG8_MMA(1, 0, At, B0); PG8_BAR; PG8_SCHED;
            PG8_STAGE(PG8_SB(1, 1), b3 + hstep, voffB);
            PG8_WAIT_V(6); PG8_BAR; PG8_MMA(1, 1, At, B1); PG8_BAR;
        }
        const bool keep = E(acc, cur, wr, wc, fr, fq);
        if (!has_next) break;
        if (!keep) {
#pragma unroll
        for (int a = 0; a < 2; ++a)
#pragma unroll
            for (int b = 0; b < 2; ++b)
#pragma unroll
                for (int m = 0; m < 4; ++m)
#pragma unroll
                    for (int n = 0; n < 2; ++n) acc[a][b][m][n] = (f32x4){0.f, 0.f, 0.f, 0.f};
        }
        cur = nxt; cA = nA; cB = nB; ++ui;
    }
    PG8_WAIT_V(0);
    if (wr == 0) PG8_BAR;
    PG8_BAR;
#undef PG8_SA
#undef PG8_SB
#undef PG8_STAGE
#undef PG8_LDA
#undef PG8_LDB
#undef PG8_MMA
#undef PG8_WAIT_V
#undef PG8_WAIT_L
#undef PG8_BAR
#undef PG8_SCHED
}
}
struct Ctx {
    const float* const* in;
    float* out; unsigned char* ws; LAS unsigned char* lds;
    int tid, lane, wid, G, bid;
};
#define WSP(T, off) ((T*)(c.ws + (off)))

struct SchedIn {
    pg8::StaticOrder so; const char* H; const char* Bt;
    DI bool next(int i, pg8::Unit& u) const { return so.next(i, u); }
    DI void ptrs(const pg8::Unit& u, const char*& A, const char*& B) const { const size_t ts = (size_t)256 * 1024 * 2;
        if (u.pn < 6) { A = Bt + (size_t)u.pn * ts; B = H + (size_t)u.pm * ts; } else { A = H + (size_t)u.pm * ts; B = Bt + (size_t)u.pn * ts; } }
};
struct EpiIn {
    static constexpr bool PERM = true;
    bf16_t* P2; bf16_t* HYT; bf16_t* HYTC; const float* b_lr; const float* b_merge;
    DI bool operator()(f32x4 (&acc)[2][2][4][2], const pg8::Unit& u, int wr, int wc, int fr, int fq) const {
        if (u.pn < 6) {
            bf16_t* base; size_t ld;
            if (u.pm < 128) { const int b = u.pm >> 5, t0 = (u.pm & 31) * 256; base = HYT + (size_t)b * 1536 * 8192 + t0; ld = 8192; }
            else { const int b = u.pm - 128; base = HYTC + (size_t)b * 1536 * 256; ld = 256; }
#pragma unroll
            for (int ai = 0; ai < 2; ++ai)
#pragma unroll
                for (int m = 0; m < 4; ++m) {
                    const int ch = 256 * u.pn + 128 * ai + 64 * wr + 16 * m + fr;
                    bf16_t* rowp = base + (size_t)ch * ld;
#pragma unroll
                    for (int bj = 0; bj < 2; ++bj) { const int tk = 128 * bj + 32 * wc + 8 * fq; const f32x4 v0 = acc[ai][bj][m][0], v1 = acc[ai][bj][m][1];
                        u32x4 w; w.x = pk_bf16(v0[0], v0[1]); w.y = pk_bf16(v0[2], v0[3]); w.z = pk_bf16(v1[0], v1[1]); w.w = pk_bf16(v1[2], v1[3]);
                        *(u32x4*)(rowp + tk) = w; }
                }
        } else {
            const int kind = (u.pn == 14 || u.pn == 15) ? 1 : (u.pn >= 18 ? 2 : 0);
            const int pc0 = 256 * (u.pn - 6);
#pragma unroll
            for (int bj = 0; bj < 2; ++bj) {
                const int cl = 128 * bj + 32 * wc + 8 * fq;
                float bias[8];
#pragma unroll
                for (int j = 0; j < 8; ++j) bias[j] = 0.f;
                if (kind == 1) { const float* bp = b_lr + (u.pn - 14) * 256 + cl;
#pragma unroll
                    for (int j = 0; j < 8; ++j) bias[j] = bp[j]; }
                if (kind == 2) { const float* bp = b_merge + (u.pn - 18) * 256 + cl;
#pragma unroll
                    for (int j = 0; j < 8; ++j) bias[j] = bp[j]; }
#pragma unroll
                for (int ai = 0; ai < 2; ++ai)
#pragma unroll
                    for (int m = 0; m < 4; ++m) {
                        const int row = 256 * u.pm + 128 * ai + 64 * wr + 16 * m + fr;
                        float v[8];
#pragma unroll
                        for (int j = 0; j < 4; ++j) { v[j] = acc[ai][bj][m][0][j] + bias[j]; v[4 + j] = acc[ai][bj][m][1][j] + bias[4 + j]; }
                        if (kind == 1) {
#pragma unroll
                            for (int j = 0; j < 8; ++j) v[j] = logsigmoidf_(v[j]) * 0.0625f; }
                        if (kind == 2) {
#pragma unroll
                            for (int j = 0; j < 8; ++j) v[j] = sigmoidf_(v[j]); }
                        u32x4 w; w.x = pk_bf16(v[0], v[1]); w.y = pk_bf16(v[2], v[3]); w.z = pk_bf16(v[4], v[5]); w.w = pk_bf16(v[6], v[7]);
                        *(u32x4*)(P2 + (size_t)row * P2W + pc0 + cl) = w;
                    }
            }
        }
        return false;
    }
};
struct SchedMg {
    pg8::StaticOrder so; const char* ws;
    DI bool next(int i, pg8::Unit& u) const { if (!so.next(i / 3, u)) return false; u.seg = i % 3; return true; }
    DI void ptrs(const pg8::Unit& u, const char*& A, const char*& B) const { const size_t ts = (size_t)256 * 512 * 2;
        const size_t yo = u.seg == 0 ? WS_YHY : (u.seg == 1 ? WS_YRG : WS_YGLA); const size_t bo = u.seg == 0 ? WS_BTHY : (u.seg == 1 ? WS_BTRG : WS_BTGLA);
        A = ws + yo + (size_t)u.pm * ts; B = ws + bo + (size_t)u.pn * ts; }
};
struct EpiMg {
    static constexpr bool PERM = true;
    unsigned char* ws;
    DI bool operator()(f32x4 (&acc)[2][2][4][2], const pg8::Unit& u, int wr, int wc, int fr, int fq) const {
        const bf16_t* P2 = (const bf16_t*)(ws + WS_P2); bf16_t* M = (bf16_t*)(ws + WS_M);
#pragma unroll
        for (int ai = 0; ai < 2; ++ai)
#pragma unroll
            for (int m = 0; m < 4; ++m) {
                const int row = 256 * u.pm + 128 * ai + 64 * wr + 16 * m + fr;
#pragma unroll
                for (int bj = 0; bj < 2; ++bj) {
                    const int col = 256 * u.pn + 128 * bj + 32 * wc + 8 * fq;
                    const bf16_t* gp = P2 + (size_t)row * P2W + PC_MG + u.seg * 1024 + col;
#pragma unroll
                    for (int n = 0; n < 2; ++n) {
                        const u32x2 ga = *(const u32x2*)(gp + 4 * n);
                        f32x4 f = (f32x4){bflo(ga.x), bfhi(ga.x), bflo(ga.y), bfhi(ga.y)};
                        if (u.seg < 2) { const u32x2 gb = *(const u32x2*)(gp + 1024 + 4 * n);
                            f[0] *= __builtin_amdgcn_rcpf(bflo(gb.x)); f[1] *= __builtin_amdgcn_rcpf(bfhi(gb.x)); f[2] *= __builtin_amdgcn_rcpf(bflo(gb.y)); f[3] *= __builtin_amdgcn_rcpf(bfhi(gb.y)); }
                        acc[ai][bj][m][n] *= f;
                    }
                    if (u.seg == 2) { const f32x4 v0 = acc[ai][bj][m][0], v1 = acc[ai][bj][m][1];
                        u32x4 w; w.x = pk_bf16(v0[0], v0[1]); w.y = pk_bf16(v0[2], v0[3]); w.z = pk_bf16(v1[0], v1[1]); w.w = pk_bf16(v1[2], v1[3]);
                        *(u32x4*)(M + (size_t)row * 1024 + col) = w; }
                }
            }
        return u.seg != 2;
    }
};
struct SchedPlain {
    pg8::StaticOrder so; const char* A0; const char* B0; size_t ts;
    DI bool next(int i, pg8::Unit& u) const { return so.next(i, u); }
    DI void ptrs(const pg8::Unit& u, const char*& A, const char*& B) const { A = A0 + (size_t)u.pm * ts; B = B0 + (size_t)u.pn * ts; }
};
struct EpiOut {
    static constexpr bool PERM = false;
    const float* xsrc_lat; float* xdst_lat; float* xctx; const float* mod;
    DI bool operator()(f32x4 (&acc)[2][2][4][2], const pg8::Unit& u, int wr, int wc, int fr, int fq) const {
        const int b = u.pm < 128 ? (u.pm >> 5) : 4;
        const float* gt = mod + b * 6144 + 2048;
#pragma unroll
        for (int ai = 0; ai < 2; ++ai)
#pragma unroll
            for (int m = 0; m < 4; ++m) {
                const int row = 256 * u.pm + 128 * ai + 64 * wr + 16 * m + fr;
                const float* sp = row < NLAT ? xsrc_lat + (size_t)row * 1024 : xctx + (size_t)(row - NLAT) * 1024;
                float* dp = row < NLAT ? xdst_lat + (size_t)row * 1024 : xctx + (size_t)(row - NLAT) * 1024;
#pragma unroll
                for (int bj = 0; bj < 2; ++bj)
#pragma unroll
                    for (int n = 0; n < 2; ++n) { const int col = 256 * u.pn + 128 * bj + 32 * wc + 16 * n + 4 * fq;
                        const f32x4 g = *(const f32x4*)(gt + col); const f32x4 x = *(const f32x4*)(sp + col);
                        *(f32x4*)(dp + col) = (ABL & 16) ? x : x + g * acc[ai][bj][m][n]; }
            }
        return false;
    }
};
struct EpiQ {
    static constexpr bool PERM = true;
    bf16_t* Q;
    DI bool operator()(f32x4 (&acc)[2][2][4][2], const pg8::Unit& u, int wr, int wc, int fr, int fq) const {
#pragma unroll
        for (int ai = 0; ai < 2; ++ai)
#pragma unroll
            for (int m = 0; m < 4; ++m) {
                const int row = 256 * u.pm + 128 * ai + 64 * wr + 16 * m + fr;
#pragma unroll
                for (int bj = 0; bj < 2; ++bj) { const int col = 256 * u.pn + 128 * bj + 32 * wc + 8 * fq; const f32x4 v0 = acc[ai][bj][m][0], v1 = acc[ai][bj][m][1];
                    u32x4 w; w.x = pk_bf16(v0[0], v0[1]); w.y = pk_bf16(v0[2], v0[3]); w.z = pk_bf16(v1[0], v1[1]); w.w = pk_bf16(v1[2], v1[3]);
                    *(u32x4*)(Q + (size_t)row * 2048 + col) = w; }
            }
        return false;
    }
};

DI void p0_prologue(const Ctx& c) {
    LAS float* cond = (LAS float*)c.lds;
    LAS float* red = cond + 5 * 1024;
    const float* cin = c.in[1]; const float* cctx = c.in[3]; const float* wmod = c.in[4]; const float* bmod = c.in[5];
    for (int i = c.tid; i < 5 * 1024; i += 512) { const int b = i >> 10, k = i & 1023; const float v = b < 4 ? cin[b * 1024 + k] : cctx[k]; cond[i] = siluf_(v); }
    __syncthreads();
    float* mod = WSP(float, WS_MOD);
    for (int item = c.bid; item < 384; item += c.G) {
        const int l = item / 96, col0 = (item % 96) * 64, col = col0 + c.lane, ks = c.wid;
        float a0 = 0.f, a1 = 0.f, a2 = 0.f, a3 = 0.f, a4 = 0.f;
        const float* w = wmod + ((size_t)l * 1024 + ks * 128) * 6144 + col;
#pragma unroll 8
        for (int k = 0; k < 128; ++k) { const float wv = w[(size_t)k * 6144]; const int kk = ks * 128 + k;
            a0 += cond[kk] * wv; a1 += cond[1024 + kk] * wv; a2 += cond[2048 + kk] * wv; a3 += cond[3072 + kk] * wv; a4 += cond[4096 + kk] * wv; }
        red[(c.wid * 5 + 0) * 64 + c.lane] = a0; red[(c.wid * 5 + 1) * 64 + c.lane] = a1; red[(c.wid * 5 + 2) * 64 + c.lane] = a2;
        red[(c.wid * 5 + 3) * 64 + c.lane] = a3; red[(c.wid * 5 + 4) * 64 + c.lane] = a4;
        __syncthreads();
        if (c.tid < 320) { const int b = c.tid >> 6, ln = c.tid & 63; float s = 0.f;
#pragma unroll
            for (int w8 = 0; w8 < 8; ++w8) s += red[(w8 * 5 + b) * 64 + ln];
            mod[(size_t)(l * 5 + b) * 6144 + col0 + ln] = s + bmod[(size_t)l * 6144 + col0 + ln]; }
        __syncthreads();
    }
    const float4* src = (const float4*)c.in[2]; float4* dst = (float4*)WSP(float, WS_XCTX);
    for (int i = c.bid * 512 + c.tid; i < 262144; i += c.G * 512) dst[i] = src[i];
}

template <int WHICH>
DI void norm_row_to_h(const Ctx& c, int l, int r, const float* xlat_src) {
    const float* xr = r < NLAT ? xlat_src + (size_t)r * 1024 : WSP(float, WS_XCTX) + (size_t)(r - NLAT) * 1024;
    const int b = r < NLAT ? (r >> 13) : 4;
    const float* mod = WSP(float, WS_MOD) + (size_t)(l * 5 + b) * 6144 + (WHICH ? 3072 : 0);
    const float* g = c.in[WHICH ? 7 : 6] + (size_t)l * 1024;
    float v[16]; float s = 0.f;
#pragma unroll
    for (int i = 0; i < 2; ++i) { const f32x4 p = *(const f32x4*)(xr + i * 512 + c.lane * 8), q = *(const f32x4*)(xr + i * 512 + c.lane * 8 + 4);
#pragma unroll
        for (int j = 0; j < 4; ++j) { v[i * 8 + j] = p[j]; v[i * 8 + 4 + j] = q[j]; s += p[j] * p[j] + q[j] * q[j]; } }
#pragma unroll
    for (int o = 32; o; o >>= 1) s += __shfl_xor(s, o);
    const float rs = rsqrtf(s * (1.f / 1024.f) + NORM_EPS);
    bf16_t* hr = WSP(bf16_t, WS_H) + (size_t)r * 1024;
#pragma unroll
    for (int i = 0; i < 2; ++i) { const int c0 = i * 512 + c.lane * 8; float o[8];
#pragma unroll
        for (int j = 0; j < 8; ++j) o[j] = v[i * 8 + j] * rs * g[c0 + j] * (1.f + mod[1024 + c0 + j]) + mod[c0 + j];
        u32x4 w; w.x = pk_bf16(o[0], o[1]); w.y = pk_bf16(o[2], o[3]); w.z = pk_bf16(o[4], o[5]); w.w = pk_bf16(o[6], o[7]);
        *(u32x4*)(hr + c0) = w; }
}

DI void tr_tile(const Ctx& c_, const float* src, int lds_, int k0, int ns0, bf16_t* dst, int ldd, int n0) {
    Ctx c = c_; asm volatile("" : "+v"(c.tid));
    LAS float* t = (LAS float*)c.lds;
    { const int k = c.tid >> 3, nq = (c.tid & 7) * 8;
      const f32x4 a = *(const f32x4*)(src + (size_t)(k0 + k) * lds_ + ns0 + nq), b = *(const f32x4*)(src + (size_t)(k0 + k) * lds_ + ns0 + nq + 4);
#pragma unroll
      for (int j = 0; j < 4; ++j) { t[k * 65 + nq + j] = a[j]; t[k * 65 + nq + 4 + j] = b[j]; } }
    __syncthreads();
    { const int n = c.tid >> 3, kq = (c.tid & 7) * 8; float v[8];
#pragma unroll
      for (int j = 0; j < 8; ++j) v[j] = t[(kq + j) * 65 + n];
      u32x4 w; w.x = pk_bf16(v[0], v[1]); w.y = pk_bf16(v[2], v[3]); w.z = pk_bf16(v[4], v[5]); w.w = pk_bf16(v[6], v[7]);
      *(u32x4*)(dst + (size_t)(n0 + n) * ldd + k0 + kq) = w; }
    __syncthreads();
}
DI void fold_tile(const Ctx& c, const float* win, const float* wlr, int d, int j0, int k0, bf16_t* dst) {
    LAS float* a = (LAS float*)c.lds;
    LAS float* b = a + 64 * 17;
    for (int i = c.tid; i < 1024; i += 512) { const int k = i >> 4, r = i & 15; a[k * 17 + r] = win[(size_t)(k0 + k) * 7200 + 3584 + d * 16 + r]; }
    for (int i = c.tid; i < 1024; i += 512) { const int r = i >> 6, j = i & 63; b[r * 64 + j] = wlr[(size_t)(d * 16 + r) * 256 + j0 + j]; }
    __syncthreads();
    { const int j = c.tid >> 3, kq = (c.tid & 7) * 8; float v[8];
#pragma unroll
      for (int q = 0; q < 8; ++q) { float s = 0.f;
#pragma unroll
          for (int r = 0; r < 16; ++r) s += a[(kq + q) * 17 + r] * b[r * 64 + j];
          v[q] = s; }
      u32x4 w; w.x = pk_bf16(v[0], v[1]); w.y = pk_bf16(v[2], v[3]); w.z = pk_bf16(v[4], v[5]); w.w = pk_bf16(v[6], v[7]);
      *(u32x4*)(dst + (size_t)(3584 + d * 256 + j0 + j) * 1024 + k0 + kq) = w; }
    __syncthreads();
}
DI void cvt_chunk(const Ctx& c, const float* src, bf16_t* dst) {
#pragma unroll
    for (int i = 0; i < 2; ++i) { const int o = (i * 512 + c.tid) * 8; const f32x4 a = *(const f32x4*)(src + o), b = *(const f32x4*)(src + o + 4);
        u32x4 w; w.x = pk_bf16(a[0], a[1]); w.y = pk_bf16(a[2], a[3]); w.z = pk_bf16(b[0], b[1]); w.w = pk_bf16(b[2], b[3]);
        *(u32x4*)(dst + o) = w; }
}

DI void hy_filter_tile(const Ctx& c_, int l, int pt) {
    Ctx c = c_; asm volatile("" : "+v"(c.tid)); c.lane = c.tid & 63;
    const bool isctx = pt >= 256; const int n = isctx ? 256 : 8192; const int t0 = isctx ? (pt - 256) * 32 : pt * 32;
    LAS float* feats = (LAS float*)c.lds;
    LAS float* h1 = feats + 32 * 33;
    LAS float* h2 = h1 + 32 * 64;
    const float* w1 = c.in[11] + (size_t)l * 33 * 64; const float* b1 = c.in[12] + l * 64; const float* w2 = c.in[13] + (size_t)l * 64 * 64; const float* b2 = c.in[14] + l * 64;
    const float* w3 = c.in[15] + (size_t)l * 64 * 2048; const float* fr = c.in[16] + l * 64;
    for (int i = c.tid; i < 32 * 33; i += 512) { const int t = i / 33, f = i % 33; const float pos = (float)(t0 + t); float v;
        if (f == 0) v = pos / (float)(n - 1);
        else { const int bi = (f - 1) & 15; const float band = 1e-4f + (float)bi * ((15.0f - 1e-4f) / 15.0f); const float ang = (6.283185307179586f / (float)n) * pos * band;
            v = f <= 16 ? cosf(ang) : -sinf(ang); }
        feats[i] = v; }
    __syncthreads();
    for (int i = c.tid; i < 32 * 64; i += 512) { const int t = i >> 6, j = i & 63; float s = b1[j];
        for (int f = 0; f < 33; ++f) s += feats[t * 33 + f] * w1[f * 64 + j];
        h1[i] = sinf(fr[j] * s); }
    __syncthreads();
    for (int i = c.tid; i < 32 * 64; i += 512) { const int t = i >> 6, j = i & 63; float s = b2[j];
        for (int k = 0; k < 64; ++k) s += h1[t * 64 + k] * w2[k * 64 + j];
        h2[i] = sinf(fr[j] * s); }
    __syncthreads();
    const int jj0 = c.tid * 4; const int ch = jj0 & 511;
    float delta[4];
#pragma unroll
    for (int q = 0; q < 4; ++q) delta[q] = fabsf(-15.350567286626973f + (float)(ch + q) * ((-3.0701134573253946f + 15.350567286626973f) / 511.0f));
    float asum[4] = {0.f, 0.f, 0.f, 0.f};
    float* hw = isctx ? WSP(float, WS_HWTC) : WSP(float, WS_HWT);
#pragma unroll 1
    for (int th = 0; th < 2; ++th) {
        f32x4 acc[16];
#pragma unroll
        for (int t = 0; t < 16; ++t) acc[t] = (f32x4){0.f, 0.f, 0.f, 0.f};
#pragma unroll 4
        for (int k = 0; k < 64; ++k) { const f32x4 w = *(const f32x4*)(w3 + (size_t)k * 2048 + jj0);
#pragma unroll
            for (int t = 0; t < 16; ++t) acc[t] += h2[(th * 16 + t) * 64 + k] * w; }
#pragma unroll
        for (int t = 0; t < 16; ++t) { const float tn = (float)(t0 + th * 16 + t) / (float)(n - 1);
#pragma unroll
            for (int q = 0; q < 4; ++q) { const float v = acc[t][q] * __expf(-tn * delta[q]); acc[t][q] = v; asum[q] += fabsf(v); } }
#pragma unroll
        for (int q = 0; q < 4; ++q) { float* dp = hw + (size_t)(jj0 + q) * n + t0 + th * 16;
#pragma unroll
            for (int t4 = 0; t4 < 4; ++t4) *(f32x4*)(dp + t4 * 4) = (f32x4){acc[t4 * 4][q], acc[t4 * 4 + 1][q], acc[t4 * 4 + 2][q], acc[t4 * 4 + 3][q]}; }
    }
    *(f32x4*)(WSP(float, WS_SPART) + (size_t)pt * 2048 + jj0) = (f32x4){asum[0], asum[1], asum[2], asum[3]};
    __syncthreads();
}
template <bool INV>
DI void fft16k(const Ctx& c) {
    LAS cf2* z = (LAS cf2*)c.lds;
    const LAS cf2* twlo = (const LAS cf2*)(c.lds + LDS_TW);
    const LAS cf2* twhi = twlo + 128;
#pragma unroll 1
    for (int pp = 0; pp < 7; ++pp) {
        const int p = INV ? 6 - pp : pp;
        const int lq = 12 - 2 * p, q = 1 << lq;
#pragma unroll 2
        for (int i = 0; i < 8; ++i) {
            const int b = c.tid + i * 512;
            const int j = b & (q - 1), base = ((b >> lq) << (lq + 2)) + j;
            const int tk = j << (2 * p);
            const cf2 w1 = cmul(twhi[tk >> 7], twlo[tk & 127]);
            const cf2 w2 = cmul(w1, w1), w3 = cmul(w2, w1);
            cf2 a0 = z[base], a1 = z[base + q], a2 = z[base + 2 * q], a3 = z[base + 3 * q];
            if (!INV) {
                const cf2 t0 = mk2(a0.x + a2.x, a0.y + a2.y), t1 = mk2(a0.x - a2.x, a0.y - a2.y);
                const cf2 t2 = mk2(a1.x + a3.x, a1.y + a3.y), d = mk2(a1.x - a3.x, a1.y - a3.y);
                const cf2 t3 = mk2(d.y, -d.x);
                const cf2 y0 = mk2(t0.x + t2.x, t0.y + t2.y), y2 = mk2(t0.x - t2.x, t0.y - t2.y);
                const cf2 y1 = mk2(t1.x + t3.x, t1.y + t3.y), y3 = mk2(t1.x - t3.x, t1.y - t3.y);
                z[base] = y0; z[base + q] = cmul(y1, w1); z[base + 2 * q] = cmul(y2, w2); z[base + 3 * q] = cmul(y3, w3);
            } else {
                a1 = cmulc(a1, w1); a2 = cmulc(a2, w2); a3 = cmulc(a3, w3);
                const cf2 t0 = mk2(a0.x + a2.x, a0.y + a2.y), t1 = mk2(a0.x - a2.x, a0.y - a2.y);
                const cf2 t2 = mk2(a1.x + a3.x, a1.y + a3.y), d = mk2(a1.x - a3.x, a1.y - a3.y);
                const cf2 t3 = mk2(-d.y, d.x);
                z[base] = mk2(t0.x + t2.x, t0.y + t2.y); z[base + q] = mk2(t1.x + t3.x, t1.y + t3.y);
                z[base + 2 * q] = mk2(t0.x - t2.x, t0.y - t2.y); z[base + 3 * q] = mk2(t1.x - t3.x, t1.y - t3.y);
            }
        }
        __syncthreads();
    }
}
DI void tw_init(const Ctx& c) {
    LAS cf2* twlo = (LAS cf2*)(c.lds + LDS_TW);
    if (c.tid < 256) { const int k = c.tid < 128 ? c.tid : (c.tid - 128) * 128; float s, co; sincospif(-(float)k * (1.0f / 8192.0f), &s, &co); twlo[c.tid] = mk2(co, s); }
}
DI unsigned pk_f16(float a, float b) { typedef _Float16 h2 __attribute__((ext_vector_type(2))); h2 v; v.x = (_Float16)a; v.y = (_Float16)b; return __builtin_bit_cast(unsigned, v); }
DI cf2 unpk_f16(unsigned u) { typedef _Float16 h2 __attribute__((ext_vector_type(2))); const h2 v = __builtin_bit_cast(h2, u); return mk2((float)v.x, (float)v.y); }

DI void hy_spec_item(const Ctx& c_, int o, int cch) {
    Ctx c = c_; asm volatile("" : "+v"(c.tid)); c.lane = c.tid & 63;
    LAS cf2* z = (LAS cf2*)c.lds;
    LAS float* red = (LAS float*)(c.lds + LDS_TW + 2048 + 64);
    const float* sp = WSP(float, WS_SPART);
    float s = 0.f;
    if (c.tid < 256) s = sp[(size_t)c.tid * 2048 + o * 1024 + cch] + sp[(size_t)c.tid * 2048 + o * 1024 + 512 + cch];
#pragma unroll
    for (int of = 32; of; of >>= 1) s += __shfl_xor(s, of);
    if (c.lane == 0) red[c.wid] = s;
    __syncthreads();
    float tot = 0.f;
#pragma unroll
    for (int w = 0; w < 8; ++w) tot += red[w];
    const float sc = 1.0f / (tot + 1e-6f);
    const float* hf = WSP(float, WS_HWT) + (size_t)(o * 1024 + cch) * 8192;
    const float* hb = WSP(float, WS_HWT) + (size_t)(o * 1024 + 512 + cch) * 8192;
    for (int i = 0; i < 16; ++i) { const int p = c.tid + i * 512;
        float v = hf[p]; if (p == 0) v += hb[0];
        z[p] = mk2(v * sc, 0.f);
        const int p2 = 8192 + p;
        z[p2] = mk2(p == 0 ? 0.f : hb[8192 - p] * sc, 0.f); }
    __syncthreads();
    fft16k<false>(c);
    unsigned* dst = WSP(unsigned, WS_SPEC) + (size_t)(o * 512 + cch) * 16384;
    for (int i = 0; i < 32; ++i) { const int p = c.tid + i * 512; const cf2 v = z[p]; dst[p] = pk_f16(v.x, v.y); }
    __syncthreads();
}

DI void load_conv16(const bf16_t* row, int t0, int n, float w0, float w1, float w2, float cb, float (&o)[16]) {
    asm volatile("" : "+v"(t0));
    const u32x4 a = *(const u32x4*)(row + t0), b = *(const u32x4*)(row + t0 + 8);
    float x[18];
    x[0] = t0 > 0 ? bf2f(row[t0 - 1]) : 0.f; x[17] = t0 + 16 < n ? bf2f(row[t0 + 16]) : 0.f;
    x[1] = bflo(a.x); x[2] = bfhi(a.x); x[3] = bflo(a.y); x[4] = bfhi(a.y); x[5] = bflo(a.z); x[6] = bfhi(a.z); x[7] = bflo(a.w); x[8] = bfhi(a.w);
    x[9] = bflo(b.x); x[10] = bfhi(b.x); x[11] = bflo(b.y); x[12] = bfhi(b.y); x[13] = bflo(b.z); x[14] = bfhi(b.z); x[15] = bflo(b.w); x[16] = bfhi(b.w);
#pragma unroll
    for (int i = 0; i < 16; ++i) o[i] = cb + w0 * x[i] + w1 * x[i + 1] + w2 * x[i + 2];
}
DI void spec_mul(const Ctx& c, const unsigned* spec) {
    LAS cf2* z = (LAS cf2*)c.lds;
#pragma unroll 4
    for (int i = 0; i < 32; ++i) { const int p = c.tid + i * 512; const cf2 hs = unpk_f16(spec[p]); z[p] = cmul(z[p], mk2(hs.x * (1.0f / 16384.0f), hs.y * (1.0f / 16384.0f))); }
    __syncthreads();
}
DI void hy_lat_item(const Ctx& c_, int l, int bp, int cch) {
    Ctx c = c_; asm volatile("" : "+v"(c.tid)); c.lane = c.tid & 63;
    LAS cf2* z = (LAS cf2*)c.lds;
    const float* cw = c.in[9] + (size_t)l * 3 * 1536; const float* cbv = c.in[10] + (size_t)l * 1536; const float* skip = c.in[17] + (size_t)l * 2 * 512;
    const bf16_t* hyt = WSP(bf16_t, WS_HYT);
    const int t0 = c.tid * 16;
    const bf16_t* r0 = hyt + ((size_t)(2 * bp) * 1536) * 8192; const bf16_t* r1 = hyt + ((size_t)(2 * bp + 1) * 1536) * 8192;
    float a0[16], a1[16];
    { const int ch = cch; load_conv16(r0 + (size_t)ch * 8192, t0, 8192, cw[ch], cw[1536 + ch], cw[3072 + ch], cbv[ch], a0);
      load_conv16(r1 + (size_t)ch * 8192, t0, 8192, cw[ch], cw[1536 + ch], cw[3072 + ch], cbv[ch], a1); }
#pragma unroll
    for (int i = 0; i < 16; ++i) { z[t0 + i] = mk2(a0[i], a1[i]); z[8192 + t0 + i] = mk2(0.f, 0.f); }
    __syncthreads();
    fft16k<false>(c);
    spec_mul(c, WSP(unsigned, WS_SPEC) + (size_t)(cch) * 16384);
    fft16k<true>(c);
    float b0[16], b1[16];
    { const int ch = 512 + cch; load_conv16(r0 + (size_t)ch * 8192, t0, 8192, cw[ch], cw[1536 + ch], cw[3072 + ch], cbv[ch], b0);
      load_conv16(r1 + (size_t)ch * 8192, t0, 8192, cw[ch], cw[1536 + ch], cw[3072 + ch], cbv[ch], b1); }
    const float sk1 = skip[cch], sk2 = skip[512 + cch];
#pragma unroll
    for (int i = 0; i < 16; ++i) { const cf2 y = z[t0 + i]; a0[i] = b0[i] * (y.x + sk1 * a0[i]); a1[i] = b1[i] * (y.y + sk1 * a1[i]); }
#pragma unroll
    for (int i = 0; i < 16; ++i) { z[t0 + i] = mk2(a0[i], a1[i]); z[8192 + t0 + i] = mk2(0.f, 0.f); }
    __syncthreads();
    fft16k<false>(c);
    spec_mul(c, WSP(unsigned, WS_SPEC) + (size_t)(512 + cch) * 16384);
    fft16k<true>(c);
    { const int ch = 1024 + cch; load_conv16(r0 + (size_t)ch * 8192, t0, 8192, cw[ch], cw[1536 + ch], cw[3072 + ch], cbv[ch], b0);
      load_conv16(r1 + (size_t)ch * 8192, t0, 8192, cw[ch], cw[1536 + ch], cw[3072 + ch], cbv[ch], b1); }
#pragma unroll
    for (int i = 0; i < 16; ++i) { const cf2 y = z[t0 + i]; a0[i] = b0[i] * (y.x + sk2 * a0[i]); a1[i] = b1[i] * (y.y + sk2 * a1[i]); }
    bf16_t* yo0 = WSP(bf16_t, WS_YHT) + ((size_t)(2 * bp) * 512 + cch) * 8192 + t0; bf16_t* yo1 = WSP(bf16_t, WS_YHT) + ((size_t)(2 * bp + 1) * 512 + cch) * 8192 + t0;
    { u32x4 w; w.x = pk_bf16(a0[0], a0[1]); w.y = pk_bf16(a0[2], a0[3]); w.z = pk_bf16(a0[4], a0[5]); w.w = pk_bf16(a0[6], a0[7]); *(u32x4*)yo0 = w;
      w.x = pk_bf16(a0[8], a0[9]); w.y = pk_bf16(a0[10], a0[11]); w.z = pk_bf16(a0[12], a0[13]); w.w = pk_bf16(a0[14], a0[15]); *(u32x4*)(yo0 + 8) = w;
      w.x = pk_bf16(a1[0], a1[1]); w.y = pk_bf16(a1[2], a1[3]); w.z = pk_bf16(a1[4], a1[5]); w.w = pk_bf16(a1[6], a1[7]); *(u32x4*)yo1 = w;
      w.x = pk_bf16(a1[8], a1[9]); w.y = pk_bf16(a1[10], a1[11]); w.z = pk_bf16(a1[12], a1[13]); w.w = pk_bf16(a1[14], a1[15]); *(u32x4*)(yo1 + 8) = w; }
    __syncthreads();
}
DI void hy_ctx_item(const Ctx& c_, int l, int b, int cch) {
    Ctx c = c_; asm volatile("" : "+v"(c.lane));
    LAS float* wl = (LAS float*)(c.lds + c.wid * 8192);
    LAS float* tp1 = wl; LAS float* tp2 = wl + 512; LAS float* vv = wl + 1024; LAS float* zz = wl + 1280;
    const float* sp = WSP(float, WS_SPART); const float* hw = WSP(float, WS_HWTC);
    float sc[2];
#pragma unroll
    for (int o = 0; o < 2; ++o) { float s = 0.f; if (c.lane < 8) s = sp[(size_t)(256 + c.lane) * 2048 + o * 1024 + cch] + sp[(size_t)(256 + c.lane) * 2048 + o * 1024 + 512 + cch];
#pragma unroll
        for (int of = 4; of; of >>= 1) s += __shfl_xor(s, of);
        sc[o] = 1.0f / (__shfl(s, 0) + 1e-6f); }
#pragma unroll
    for (int o = 0; o < 2; ++o) { LAS float* tp = o ? tp2 : tp1; const float* hf = hw + (size_t)(o * 1024 + cch) * 256; const float* hb = hw + (size_t)(o * 1024 + 512 + cch) * 256;
        for (int i = c.lane; i < 511; i += 64) { const int d = i - 255; float v = d > 0 ? hf[d] : (d < 0 ? hb[-d] : hf[0] + hb[0]); tp[i] = v * sc[o]; } }
    const float* cw = c.in[9] + (size_t)l * 3 * 1536; const float* cbv = c.in[10] + (size_t)l * 1536; const float* skip = c.in[17] + (size_t)l * 2 * 512;
    const bf16_t* base = WSP(bf16_t, WS_HYTC) + (size_t)b * 1536 * 256;
    float xv[3][4];
#pragma unroll
    for (int g = 0; g < 3; ++g) { const int ch = g * 512 + cch; const bf16_t* r = base + (size_t)ch * 256; const float w0 = cw[ch], w1 = cw[1536 + ch], w2 = cw[3072 + ch], cb = cbv[ch];
#pragma unroll
        for (int i = 0; i < 4; ++i) { const int t = c.lane + 64 * i; const float xm = t > 0 ? bf2f(r[t - 1]) : 0.f, x0 = bf2f(r[t]), xp = t < 255 ? bf2f(r[t + 1]) : 0.f; xv[g][i] = cb + w0 * xm + w1 * x0 + w2 * xp; } }
#pragma unroll
    for (int i = 0; i < 4; ++i) vv[c.lane + 64 * i] = xv[0][i];
    LDS_FENCE();
    const float sk1 = skip[cch], sk2 = skip[512 + cch];
    float y[4];
#pragma unroll
    for (int i = 0; i < 4; ++i) { const int t = c.lane + 64 * i; float s = 0.f;
        for (int k = 0; k < 256; ++k) s += tp1[t - k + 255] * vv[k];
        y[i] = xv[1][i] * (s + sk1 * xv[0][i]); }
#pragma unroll
    for (int i = 0; i < 4; ++i) zz[c.lane + 64 * i] = y[i];
    LDS_FENCE();
    bf16_t* yo = WSP(bf16_t, WS_YHY) + (size_t)(NLAT + b * 256) * 512 + cch;
#pragma unroll
    for (int i = 0; i < 4; ++i) { const int t = c.lane + 64 * i; float s = 0.f;
        for (int k = 0; k < 256; ++k) s += tp2[t - k + 255] * zz[k];
        yo[(size_t)t * 512] = (ABL & 1) ? (bf16_t)0 : f2bf(xv[2][i] * (s + sk2 * y[i])); }
    LDS_FENCE();
}
DI void yhy_tr_tile(const Ctx& c_, int b, int c0, int t0) {
    Ctx c = c_; asm volatile("" : "+v"(c.tid));
    LAS bf16_t* t = (LAS bf16_t*)c.lds;
    { const int ch = c.tid >> 3, tq = (c.tid & 7) * 8; const u32x4 a = *(const u32x4*)(WSP(bf16_t, WS_YHT) + ((size_t)b * 512 + c0 + ch) * 8192 + t0 + tq);
      LAS unsigned* d = (LAS unsigned*)(t + ch * 66 + tq); d[0] = a.x; d[1] = a.y; d[2] = a.z; d[3] = a.w; }
    __syncthreads();
    { const int tk = c.tid >> 3, cq = (c.tid & 7) * 8; bf16_t v[8];
#pragma unroll
      for (int j = 0; j < 8; ++j) v[j] = t[(cq + j) * 66 + tk];
      u32x4 w; w.x = v[0] | ((unsigned)v[1] << 16); w.y = v[2] | ((unsigned)v[3] << 16); w.z = v[4] | ((unsigned)v[5] << 16); w.w = v[6] | ((unsigned)v[7] << 16);
      if (ABL & 1) w = (u32x4){0u, 0u, 0u, 0u};
      *(u32x4*)(WSP(bf16_t, WS_YHY) + (size_t)(b * 8192 + t0 + tk) * 512 + c0 + cq) = w; }
    __syncthreads();
}
template <bool FINAL, int D>
DI void rg_dir(const Ctx& c, int l, int b, int chunk) {
    int lane = c.lane; asm volatile("" : "+v"(lane));
    const int g = c.wid, ch = g * 64 + lane, fr = lane & 15, fq = lane >> 4;
    LAS unsigned char* wl = c.lds + c.wid * 16384;
    LAS bf16_t* xcs = (LAS bf16_t*)wl;
    LAS cf2* stg = (LAS cf2*)(wl + 2304);
    const bool isctx = chunk < 4;
    const int rowbase = isctx ? NLAT + b * 256 : b * 8192, seglen = isctx ? 256 : 8192, tbase = isctx ? chunk * 64 : (chunk - 4) * 64;
    const bf16_t* P2 = WSP(bf16_t, WS_P2);
    const int pd = (l * 2 + D) * 512 + ch;
    const float* cwp = c.in[18] + (size_t)(l * 2 + D) * 4 * 512 + ch;
    const float cw0 = cwp[0], cw1 = cwp[512], cw2 = cwp[1024], cw3 = cwp[1536], cb = c.in[19][pd], ba = c.in[21][pd], bx = c.in[23][pd];
    const float lam = c.in[24][pd]; const float cneg = -8.0f * log1pf(expf(-lam));
    bf16x8 wa[4][2], wx[4][2];
    { const bf16_t* wb = WSP(bf16_t, WS_RGW) + (size_t)((D * 2 + 0) * 8 + g) * 4096; const bf16_t* xb = WSP(bf16_t, WS_RGW) + (size_t)((D * 2 + 1) * 8 + g) * 4096;
#pragma unroll
      for (int nt = 0; nt < 4; ++nt)
#pragma unroll
          for (int ks = 0; ks < 2; ++ks) { wa[nt][ks] = *(const bf16x8*)(wb + (nt * 16 + fr) * 64 + fq * 8 + 32 * ks); wx[nt][ks] = *(const bf16x8*)(xb + (nt * 16 + fr) * 64 + fq * 8 + 32 * ks); } }
    float h = 0.f, Aagg = 1.f, Bagg = 0.f;
    if (FINAL) h = WSP(float, WS_RGCAR)[(size_t)((b * 2 + D) * NCHK + chunk) * 512 + ch];
    float* HF = WSP(float, WS_HF);
    float um3, um2, um1;
    { const int t3 = tbase + (D ? 66 : -3), t2 = tbase + (D ? 65 : -2), t1 = tbase + (D ? 64 : -1);
      um3 = (t3 >= 0 && t3 < seglen) ? bf2f(P2[(size_t)(rowbase + t3) * P2W + PC_RGX + ch]) : 0.f;
      um2 = (t2 >= 0 && t2 < seglen) ? bf2f(P2[(size_t)(rowbase + t2) * P2W + PC_RGX + ch]) : 0.f;
      um1 = (t1 >= 0 && t1 < seglen) ? bf2f(P2[(size_t)(rowbase + t1) * P2W + PC_RGX + ch]) : 0.f; }
#pragma unroll 1
    for (int mt = 0; mt < 4; ++mt) {
        float xcf[16];
#pragma unroll
        for (int q = 0; q < 16; ++q) { const int s = mt * 16 + q, tok = tbase + (D ? 63 - s : s);
            const float u0 = bf2f(P2[(size_t)(rowbase + tok) * P2W + PC_RGX + ch]);
            const float xc = cb + cw0 * um3 + cw1 * um2 + cw2 * um1 + cw3 * u0;
            xcf[q] = xc; xcs[q * 72 + lane] = f2bf(xc); um3 = um2; um2 = um1; um1 = u0; }
        LDS_FENCE();
        bf16x8 af[2];
#pragma unroll
        for (int ks = 0; ks < 2; ++ks) af[ks] = *(const LAS bf16x8*)(xcs + fr * 72 + fq * 8 + 32 * ks);
        f32x4 ar[4], ai[4];
#pragma unroll
        for (int nt = 0; nt < 4; ++nt) { ar[nt] = (f32x4){0.f, 0.f, 0.f, 0.f}; ai[nt] = (f32x4){0.f, 0.f, 0.f, 0.f};
#pragma unroll
            for (int ks = 0; ks < 2; ++ks) { ar[nt] = __builtin_amdgcn_mfma_f32_16x16x32_bf16(af[ks], wa[nt][ks], ar[nt], 0, 0, 0); ai[nt] = __builtin_amdgcn_mfma_f32_16x16x32_bf16(af[ks], wx[nt][ks], ai[nt], 0, 0, 0); } }
#pragma unroll
        for (int nt = 0; nt < 4; ++nt)
#pragma unroll
            for (int jj = 0; jj < 4; ++jj) stg[(fq * 4 + jj) * 64 + nt * 16 + fr] = mk2(ar[nt][jj], ai[nt][jj]);
        LDS_FENCE();
#pragma unroll
        for (int q = 0; q < 16; ++q) { const int s = mt * 16 + q, tokl = D ? 63 - s : s;
            const cf2 pre = stg[q * 64 + lane];
            const float r = sigmoidf_(pre.x + ba), ii = sigmoidf_(pre.y + bx);
            const float a = __expf(r * cneg);
            const float bb = sqrtf(fmaxf(1.0f - a * a, 0.f)) * ii * xcf[q];
            if (FINAL) { h = a * h + bb;
                const size_t row = (size_t)(rowbase + tbase + tokl);
                if (D == 0) HF[row * 512 + ch] = h;
                else { const float gt = bf2f(P2[row * P2W + PC_RGG + ch]); WSP(bf16_t, WS_YRG)[row * 512 + ch] = (ABL & 2) ? (bf16_t)0 : f2bf((HF[row * 512 + ch] + h) * geluf_(gt)); } }
            else { Bagg = a * Bagg + bb; Aagg *= a; } }
        LDS_FENCE();
    }
    if (!FINAL) WSP(cf2, WS_RGAGG)[(size_t)((b * 2 + D) * NCHK + chunk) * 512 + ch] = mk2(Aagg, Bagg);
}
template <bool FINAL>
DI void rg_item(const Ctx& c, int l, int item) {
    const int b = item / NCHK, chunk = item % NCHK;
    rg_dir<FINAL, 0>(c, l, b, chunk);
    rg_dir<FINAL, 1>(c, l, b, chunk);
}
DI int scan_order(int d, int i) { return d == 0 ? i : (i < 4 ? 3 - i : 135 - i); }
DI void rg_carry_scan(const Ctx& c) {
    for (int idx = c.bid * 512 + c.tid; idx < 4096; idx += c.G * 512) {
    const int bd = idx >> 9, ch = idx & 511, d = bd & 1;
    const cf2* agg = WSP(cf2, WS_RGAGG) + (size_t)bd * NCHK * 512 + ch; float* car = WSP(float, WS_RGCAR) + (size_t)bd * NCHK * 512 + ch;
    float cv = 0.f;
#pragma unroll 4
    for (int i = 0; i < NCHK; ++i) { const int ck = scan_order(d, i); car[(size_t)ck * 512] = cv; const cf2 ab = agg[(size_t)ck * 512]; cv = ab.x * cv + ab.y; }
    }
}

DI int gla_row(int b, int chunk, int i) {
    if (chunk < 4) return NLAT + b * 256 + chunk * 64 + i;
    const int jl = chunk - 4; return b * 8192 + ((jl & 1) * 64 + i) * 64 + (jl >> 1);
}
DI void gla_a_item(const Ctx& c, int item) {
    const int h = item & 3, bc = item >> 2, b = bc / NCHK, chunk = bc % NCHK;
    int lane = c.lane; asm volatile("" : "+v"(lane));
    const int fr = lane & 15, fq = lane >> 4, tid = c.wid * 64 + lane;
    LAS bf16_t* vT = (LAS bf16_t*)c.lds;
    LAS bf16_t* kdT = vT + 128 * 68;
    const bf16_t* P2 = WSP(bf16_t, WS_P2);
    { const int s = tid >> 3, ec = (tid & 7) * 16; const bf16_t* vp = P2 + (size_t)gla_row(b, chunk, s) * P2W + PC_V + h * 128 + ec;
      const u32x4 a = *(const u32x4*)vp, bq = *(const u32x4*)(vp + 8);
      const unsigned w[8] = {a.x, a.y, a.z, a.w, bq.x, bq.y, bq.z, bq.w};
#pragma unroll
      for (int j = 0; j < 8; ++j) { vT[(ec + 2 * j) * 68 + s] = (bf16_t)(w[j] & 0xffffu); vT[(ec + 2 * j + 1) * 68 + s] = (bf16_t)(w[j] >> 16); } }
    if ((c.wid & 3) == 0) {
        const int d = c.wid >> 2, dk = lane;
        float la[64]; float tot = 0.f;
#pragma unroll
        for (int i = 0; i < 64; ++i) { la[i] = bf2f(P2[(size_t)gla_row(b, chunk, i) * P2W + (d ? PC_LAB : PC_LAF) + h * 64 + dk]); tot += la[i]; }
        float rem = tot;
        LAS bf16_t* kd = kdT + d * 64 * 68 + dk * 68;
        if (d == 0) {
#pragma unroll
            for (int i = 0; i < 64; ++i) { rem -= la[i]; const float kv = bf2f(P2[(size_t)gla_row(b, chunk, i) * P2W + PC_K + h * 64 + dk]); kd[i] = f2bf(kv * __expf(rem)); }
        } else {
#pragma unroll
            for (int i = 63; i >= 0; --i) { rem -= la[i]; const float kv = bf2f(P2[(size_t)gla_row(b, chunk, i) * P2W + PC_K + h * 64 + dk]); kd[i] = f2bf(kv * __expf(rem)); }
        }
        WSP(float, WS_GDEC)[(size_t)((((b * 4 + h) * 2 + d) * NCHK) + chunk) * 64 + dk] = __expf(tot);
    }
    __syncthreads();
    {
        const int d = c.wid >> 2, eq = c.wid & 3;
        f32x4 acc[2][4];
#pragma unroll
        for (int et = 0; et < 2; ++et)
#pragma unroll
            for (int dt = 0; dt < 4; ++dt) acc[et][dt] = (f32x4){0.f, 0.f, 0.f, 0.f};
#pragma unroll
        for (int ks = 0; ks < 2; ++ks) {
            bf16x8 af[2], bfr[4];
#pragma unroll
            for (int et = 0; et < 2; ++et) { const LAS u32x2* p = (const LAS u32x2*)(vT + ((eq * 2 + et) * 16 + fr) * 68 + fq * 8 + 32 * ks); const u32x2 lo = p[0], hi = p[1]; u32x4 w = {lo.x, lo.y, hi.x, hi.y}; af[et] = __builtin_bit_cast(bf16x8, w); }
#pragma unroll
            for (int dt = 0; dt < 4; ++dt) { const LAS u32x2* p = (const LAS u32x2*)(kdT + d * 64 * 68 + (dt * 16 + fr) * 68 + fq * 8 + 32 * ks); const u32x2 lo = p[0], hi = p[1]; u32x4 w = {lo.x, lo.y, hi.x, hi.y}; bfr[dt] = __builtin_bit_cast(bf16x8, w); }
#pragma unroll
            for (int et = 0; et < 2; ++et)
#pragma unroll
                for (int dt = 0; dt < 4; ++dt) acc[et][dt] = __builtin_amdgcn_mfma_f32_16x16x32_bf16(af[et], bfr[dt], acc[et][dt], 0, 0, 0);
        }
        float* st = WSP(float, WS_GST) + (size_t)((((b * 4 + h) * 2 + d) * NCHK) + chunk) * 8192;
#pragma unroll
        for (int et = 0; et < 2; ++et)
#pragma unroll
            for (int dt = 0; dt < 4; ++dt)
#pragma unroll
                for (int jj = 0; jj < 4; ++jj) st[((eq * 2 + et) * 16 + fq * 4 + jj) * 64 + dt * 16 + fr] = acc[et][dt][jj];
    }
    __syncthreads();
}
DI void gla_state_scan(const Ctx& c) {
    for (int idx = c.bid * 512 + c.tid; idx < 131072; idx += c.G * 512) {
    const int chain = idx >> 12, e2 = idx & 4095, d = chain & 1, dk2 = (e2 & 31) * 2;
    cf2* st = (cf2*)(WSP(float, WS_GST) + (size_t)chain * NCHK * 8192) + e2;
    const cf2* dc = (const cf2*)(WSP(float, WS_GDEC) + (size_t)chain * NCHK * 64 + dk2);
    cf2 S = mk2(0.f, 0.f);
#pragma unroll 1
    for (int i0 = 0; i0 < NCHK; i0 += 4) {
        cf2 ds[4], de[4];
#pragma unroll
        for (int u = 0; u < 4; ++u) { const int ck = scan_order(d, i0 + u); ds[u] = st[(size_t)ck * 4096]; de[u] = dc[(size_t)ck * 32]; }
#pragma unroll
        for (int u = 0; u < 4; ++u) { const int ck = scan_order(d, i0 + u); st[(size_t)ck * 4096] = S; S = mk2(de[u].x * S.x + ds[u].x, de[u].y * S.y + ds[u].y); }
    }
    }
}
DI void gla_c_item(const Ctx& c, int l, int item) {
    const int hp = item & 1, bc = item >> 1, b = bc / NCHK, chunk = bc % NCHK;
    int lane = c.lane; asm volatile("" : "+v"(lane));
    const int hl = c.wid >> 2, it = c.wid & 3, h = hp * 2 + hl, fr = lane & 15, fq = lane >> 4;
    LAS unsigned char* hb = c.lds + hl * 63488;
    LAS bf16_t* qg = (LAS bf16_t*)hb;
    LAS bf16_t* kg = qg + 2 * 64 * 72;
    LAS bf16_t* vT = kg + 2 * 64 * 72;
    LAS bf16_t* Pw = vT + 128 * 68 + it * 16 * 72;
    const bf16_t* P2 = WSP(bf16_t, WS_P2);
    if (it < 2) {
        const int d = it, dk = lane; float cum = 0.f;
        LAS bf16_t* qd = qg + d * 64 * 72 + dk; LAS bf16_t* kd = kg + d * 64 * 72 + dk;
#pragma unroll 8
        for (int s = 0; s < 64; ++s) { const int i = d ? 63 - s : s; const bf16_t* rp = P2 + (size_t)gla_row(b, chunk, i) * P2W;
            cum += bf2f(rp[(d ? PC_LAB : PC_LAF) + h * 64 + dk]);
            const float qv = bf2f(rp[PC_Q + h * 64 + dk]), kv = bf2f(rp[PC_K + h * 64 + dk]);
            qd[i * 72] = f2bf(qv * 0.125f * __expf(cum)); kd[i * 72] = f2bf(kv * __expf(-cum)); }
    } else {
        const int t = (it - 2) * 64 + lane, s = t >> 1, e0 = (t & 1) * 64; const bf16_t* vp = P2 + (size_t)gla_row(b, chunk, s) * P2W + PC_V + h * 128 + e0;
#pragma unroll
        for (int q8 = 0; q8 < 8; ++q8) { const u32x4 a = *(const u32x4*)(vp + q8 * 8); const unsigned w[4] = {a.x, a.y, a.z, a.w};
#pragma unroll
            for (int j = 0; j < 4; ++j) { vT[(e0 + q8 * 8 + 2 * j) * 68 + s] = (bf16_t)(w[j] & 0xffffu); vT[(e0 + q8 * 8 + 2 * j + 1) * 68 + s] = (bf16_t)(w[j] >> 16); } }
    }
    __syncthreads();
#ifdef DEBUG_DET
    if (hp == 0) {
        const size_t slot = (size_t)(bc * 2 + hl);
        unsigned* dq = (unsigned*)(c.ws + WS_END) + slot * 9216; const LAS unsigned* sq = (const LAS unsigned*)hb;
        for (int i = it * 64 + lane; i < 256 * 32; i += 256) dq[i] = sq[(i >> 5) * 36 + (i & 31)];
        unsigned* dv = (unsigned*)(c.ws + WS_END + 40000000) + slot * 4352; const LAS unsigned* sv = (const LAS unsigned*)vT;
        for (int i = it * 64 + lane; i < 128 * 32; i += 256) dv[i] = sv[(i >> 5) * 34 + (i & 31)];
    }
#endif
    f32x4 o[8];
#pragma unroll
    for (int et = 0; et < 8; ++et) o[et] = (f32x4){0.f, 0.f, 0.f, 0.f};
#pragma unroll
    for (int d = 0; d < 2; ++d) {
        bf16x8 qf[2];
#pragma unroll
        for (int ks = 0; ks < 2; ++ks) qf[ks] = *(const LAS bf16x8*)(qg + d * 64 * 72 + (it * 16 + fr) * 72 + fq * 8 + 32 * ks);
        f32x4 sc[4];
#pragma unroll
        for (int st = 0; st < 4; ++st) { sc[st] = (f32x4){0.f, 0.f, 0.f, 0.f};
#pragma unroll
            for (int ks = 0; ks < 2; ++ks) { const bf16x8 kf = *(const LAS bf16x8*)(kg + d * 64 * 72 + (st * 16 + fr) * 72 + fq * 8 + 32 * ks); sc[st] = __builtin_amdgcn_mfma_f32_16x16x32_bf16(qf[ks], kf, sc[st], 0, 0, 0); } }
#pragma unroll
        for (int st = 0; st < 4; ++st)
#pragma unroll
            for (int jj = 0; jj < 4; ++jj) { const int ig = it * 16 + fq * 4 + jj, sg = st * 16 + fr; const bool keep = d == 0 ? (sg <= ig) : (sg > ig);
                Pw[(fq * 4 + jj) * 72 + st * 16 + fr] = f2bf(keep ? sc[st][jj] : 0.f); }
        __syncthreads();
#ifdef DEBUG_DET
        if (hp == 0) { const size_t slot = (size_t)(((bc * 2 + hl) * 2 + d) * 4 + it);
            unsigned* dp = (unsigned*)(c.ws + WS_END + 60000000) + slot * 576; const LAS unsigned* sp = (const LAS unsigned*)Pw;
            for (int i = lane; i < 16 * 32; i += 64) dp[i] = sp[(i >> 5) * 36 + (i & 31)]; }
#endif
        bf16x8 pf[2];
#pragma unroll
        for (int ks = 0; ks < 2; ++ks) pf[ks] = *(const LAS bf16x8*)(Pw + fr * 72 + fq * 8 + 32 * ks);
        const float* stp = WSP(float, WS_GST) + (size_t)((((b * 4 + h) * 2 + d) * NCHK) + chunk) * 8192;
#pragma unroll
        for (int et = 0; et < 8; ++et) {
#pragma unroll
            for (int ks = 0; ks < 2; ++ks) {
                const LAS u32x2* p = (const LAS u32x2*)(vT + (et * 16 + fr) * 68 + fq * 8 + 32 * ks); const u32x2 lo = p[0], hi = p[1]; u32x4 w = {lo.x, lo.y, hi.x, hi.y};
                o[et] = __builtin_amdgcn_mfma_f32_16x16x32_bf16(pf[ks], __builtin_bit_cast(bf16x8, w), o[et], 0, 0, 0);
                const f32x4 s0 = *(const f32x4*)(stp + (et * 16 + fr) * 64 + fq * 8 + 32 * ks), s1 = *(const f32x4*)(stp + (et * 16 + fr) * 64 + fq * 8 + 32 * ks + 4);
                u32x4 sw; sw.x = pk_bf16(s0[0], s0[1]); sw.y = pk_bf16(s0[2], s0[3]); sw.z = pk_bf16(s1[0], s1[1]); sw.w = pk_bf16(s1[2], s1[3]);
                o[et] = __builtin_amdgcn_mfma_f32_16x16x32_bf16(qf[ks], __builtin_bit_cast(bf16x8, sw), o[et], 0, 0, 0);
            }
        }
        __syncthreads();
#ifdef DEBUG_DET
        if (hp == 0 && b == 0) { const size_t slot = (size_t)(((chunk * 2 + hl) * 2 + d) * 4 + it);
            float* dp = (float*)(c.ws + WS_END + 80000000) + slot * 2048 + lane * 32;
#pragma unroll
            for (int et = 0; et < 8; ++et) *(f32x4*)(dp + et * 4) = o[et]; }
#endif
    }
    float ss[4];
#pragma unroll
    for (int jj = 0; jj < 4; ++jj) { float s = 0.f;
#pragma unroll
        for (int et = 0; et < 8; ++et) s += o[et][jj] * o[et][jj];
        s += __shfl_xor(s, 1); s += __shfl_xor(s, 2); s += __shfl_xor(s, 4); s += __shfl_xor(s, 8);
        ss[jj] = rsqrtf(s * (1.0f / 128.0f) + NORM_EPS); }
    const float* ng = c.in[27] + (size_t)l * 128;
#pragma unroll
    for (int jj = 0; jj < 4; ++jj) { const size_t row = (size_t)gla_row(b, chunk, it * 16 + fq * 4 + jj);
        const bf16_t* gp = P2 + row * P2W + PC_GG + h * 128; bf16_t* yp = WSP(bf16_t, WS_YGLA) + row * 512 + h * 128;
#pragma unroll
        for (int et = 0; et < 8; ++et) { const int e = et * 16 + fr; yp[e] = (ABL & 4) ? (bf16_t)0 : f2bf(o[et][jj] * ss[jj] * ng[e] * siluf_(bf2f(gp[e]))); } }
    __syncthreads();
}
DI void ce(float& a, float& b) { const float t = fmaxf(a, b); b = fminf(a, b); a = t; }
DI void ce2(float& va, unsigned& pa, float& vb, unsigned& pb) { const bool s = va >= vb; const float hv = s ? va : vb, lv = s ? vb : va; const unsigned hp = s ? pa : pb, lp = s ? pb : pa; va = hv; vb = lv; pa = hp; pb = lp; }
DI void sort16(float (&x)[16]) {
#pragma unroll
    for (int kk = 1; kk <= 4; ++kk)
#pragma unroll
        for (int jj = kk - 1; jj >= 0; --jj)
#pragma unroll
            for (int i = 0; i < 16; ++i) { const int k = 1 << kk, j = 1 << jj, l = i ^ j; if (l > i) { if ((i & k) == 0) ce(x[i], x[l]); else ce(x[l], x[i]); } }
}
DI void merge16(float (&x)[16], const float (&y)[16]) {
#pragma unroll
    for (int i = 0; i < 16; ++i) x[i] = fmaxf(x[i], y[15 - i]);
#pragma unroll
    for (int jj = 3; jj >= 0; --jj)
#pragma unroll
        for (int i = 0; i < 16; ++i) { const int j = 1 << jj, l = i ^ j; if (l > i) ce(x[i], x[l]); }
}
DI void sort16p(float (&x)[16], unsigned (&p)[16]) {
#pragma unroll
    for (int kk = 1; kk <= 4; ++kk)
#pragma unroll
        for (int jj = kk - 1; jj >= 0; --jj)
#pragma unroll
            for (int i = 0; i < 16; ++i) { const int k = 1 << kk, j = 1 << jj, l = i ^ j; if (l > i) { if ((i & k) == 0) ce2(x[i], p[i], x[l], p[l]); else ce2(x[l], p[l], x[i], p[i]); } }
}
DI void merge16p(float (&x)[16], unsigned (&p)[16], const float (&y)[16], const unsigned (&q)[16]) {
#pragma unroll
    for (int i = 0; i < 16; ++i) { const bool s = x[i] >= y[15 - i]; p[i] = s ? p[i] : q[15 - i]; x[i] = s ? x[i] : y[15 - i]; }
#pragma unroll
    for (int jj = 3; jj >= 0; --jj)
#pragma unroll
        for (int i = 0; i < 16; ++i) { const int j = 1 << jj, l = i ^ j; if (l > i) ce2(x[i], p[i], x[l], p[l]); }
}
DI void peer_half_top16(const bf16_t* qrow, const bf16_t* keys, int lane, float (&res)[16]) {
    const int tl = lane & 31, hf = lane >> 5;
    f32x16 acc[4];
#pragma unroll
    for (int t4 = 0; t4 < 4; ++t4)
#pragma unroll
        for (int r = 0; r < 16; ++r) acc[t4][r] = 0.f;
#pragma unroll
    for (int ks = 0; ks < 8; ++ks) {
        const bf16x8 bq = *(const bf16x8*)(qrow + 8 * hf + 16 * ks);
#pragma unroll
        for (int t4 = 0; t4 < 4; ++t4) { const bf16x8 ak = *(const bf16x8*)(keys + (size_t)(t4 * 32 + tl) * 128 + 8 * hf + 16 * ks);
            acc[t4] = __builtin_amdgcn_mfma_f32_32x32x16_bf16(ak, bq, acc[t4], 0, 0, 0); }
    }
    float L0[16], L1[16], L2[16], L3[16];
#pragma unroll
    for (int r = 0; r < 16; ++r) { const unsigned n = (unsigned)((r & 3) + 8 * (r >> 2) + 4 * hf);
        L0[r] = __uint_as_float((__float_as_uint(acc[0][r]) & ~127u) | n); L1[r] = __uint_as_float((__float_as_uint(acc[1][r]) & ~127u) | (32u + n));
        L2[r] = __uint_as_float((__float_as_uint(acc[2][r]) & ~127u) | (64u + n)); L3[r] = __uint_as_float((__float_as_uint(acc[3][r]) & ~127u) | (96u + n)); }
    sort16(L0); sort16(L1); sort16(L2); sort16(L3);
    merge16(L0, L1); merge16(L2, L3); merge16(L0, L2);
#pragma unroll
    for (int i = 0; i < 16; ++i) L1[i] = __shfl_xor(L0[i], 32);
    merge16(L0, L1);
#pragma unroll
    for (int i = 0; i < 16; ++i) res[i] = L0[i];
}
DI void peer_topk_wave(const Ctx& c, int tile, int h) {
    int lane = c.lane; asm volatile("" : "+v"(lane));
    const int tl = lane & 31, hf = lane >> 5; const size_t row = (size_t)tile * 32 + tl;
    const bf16_t* qrow = WSP(bf16_t, WS_Q) + row * 2048 + h * 256; const bf16_t* keys = WSP(bf16_t, WS_KEYS) + (size_t)h * 2 * 128 * 128;
    float A[16], B[16];
    peer_half_top16(qrow, keys, lane, A);
    peer_half_top16(qrow + 128, keys + 128 * 128, lane, B);
    LAS unsigned* tab = (LAS unsigned*)(c.lds + c.wid * 8192);
    float sa[16], sb[16];
#pragma unroll
    for (int i = 0; i < 16; ++i) { const unsigned ua = __float_as_uint(A[i]), ub = __float_as_uint(B[i]); sa[i] = __uint_as_float(ua & ~127u); sb[i] = __uint_as_float(ub & ~127u);
        tab[i * 64 + lane] = (ua & 127u) << 7; tab[(16 + i) * 64 + lane] = ub & 127u; }
#define PK2(i, j) __uint_as_float((__float_as_uint(sa[i] + sb[j]) & ~255u) | (unsigned)(((i) << 4) | (j)))
    float G0[16], G1[16];
#pragma unroll
    for (int j = 0; j < 16; ++j) G0[j] = PK2(0, j);
#pragma unroll
    for (int j = 0; j < 8; ++j) G1[j] = PK2(1, j);
#pragma unroll
    for (int j = 0; j < 5; ++j) G1[8 + j] = PK2(2, j);
#pragma unroll
    for (int j = 0; j < 3; ++j) G1[13 + j] = PK2(4, j);
    sort16(G1); merge16(G0, G1);
#pragma unroll
    for (int j = 0; j < 4; ++j) G1[j] = PK2(3, j);
#pragma unroll
    for (int i = 0; i < 3; ++i)
#pragma unroll
        for (int j = 0; j < 2; ++j) G1[4 + i * 2 + j] = PK2(5 + i, j);
#pragma unroll
    for (int i = 0; i < 6; ++i) G1[10 + i] = PK2(8 + i, 0);
    sort16(G1); merge16(G0, G1);
#pragma unroll
    for (int j = 0; j < 16; ++j) G1[j] = -3.0e38f;
    G1[0] = PK2(14, 0); G1[1] = PK2(15, 0); ce(G1[0], G1[1]);
    merge16(G0, G1);
#undef PK2
    LDS_FENCE();
    unsigned P0[16]; float den = 0.f; const float vmax = __uint_as_float(__float_as_uint(G0[0]) & ~255u);
#pragma unroll
    for (int i = 0; i < 16; ++i) { const unsigned u = __float_as_uint(G0[i]); const unsigned ci = (u >> 4) & 15u, cj = u & 15u;
        P0[i] = tab[ci * 64 + lane] | tab[(16 + cj) * 64 + lane];
        G0[i] = __expf(__uint_as_float(u & ~255u) - vmax); den += G0[i]; }
    const float inv = 1.0f / den;
    if (hf == 0) { unsigned* dp = WSP(unsigned, WS_SELI) + row * 128 + h * 16;
#pragma unroll
        for (int i = 0; i < 4; ++i) *(u32x4*)(dp + 4 * i) = (u32x4){P0[4 * i], P0[4 * i + 1], P0[4 * i + 2], P0[4 * i + 3]}; }
    else { float* dp = WSP(float, WS_SELW) + row * 128 + h * 16;
#pragma unroll
        for (int i = 0; i < 4; ++i) *(f32x4*)(dp + 4 * i) = (f32x4){G0[4 * i] * inv, G0[4 * i + 1] * inv, G0[4 * i + 2] * inv, G0[4 * i + 3] * inv}; }
    LDS_FENCE();
}

DI float dot16(const u32x4 a0, const u32x4 a1, const u32x4 b0, const u32x4 b1) {
    float s = 0.f;
    asm volatile("v_dot2c_f32_bf16 %0, %1, %5\n\tv_dot2c_f32_bf16 %0, %2, %6\n\tv_dot2c_f32_bf16 %0, %3, %7\n\tv_dot2c_f32_bf16 %0, %4, %8\n\t"
                 "v_dot2c_f32_bf16 %0, %9, %13\n\tv_dot2c_f32_bf16 %0, %10, %14\n\tv_dot2c_f32_bf16 %0, %11, %15\n\tv_dot2c_f32_bf16 %0, %12, %16\n\ts_nop 2"
                 : "+v"(s)
                 : "v"(a0.x), "v"(a0.y), "v"(a0.z), "v"(a0.w), "v"(b0.x), "v"(b0.y), "v"(b0.z), "v"(b0.w),
                   "v"(a1.x), "v"(a1.y), "v"(a1.z), "v"(a1.w), "v"(b1.x), "v"(b1.y), "v"(b1.z), "v"(b1.w));
    return s;
}
DI void fma8(float (&acc)[16], int o, const u32x4 v, float cf) {
    acc[o + 0] += cf * bflo(v.x); acc[o + 1] += cf * bfhi(v.x); acc[o + 2] += cf * bflo(v.y); acc[o + 3] += cf * bfhi(v.y);
    acc[o + 4] += cf * bflo(v.z); acc[o + 5] += cf * bfhi(v.z); acc[o + 6] += cf * bflo(v.w); acc[o + 7] += cf * bfhi(v.w);
}
template <bool FINAL>
DI void peer_expert_token(const Ctx& c, int l, int r, const float* xsrc_lat) {
    int lane = c.lane; asm volatile("" : "+v"(lane));
    const bf16_t* hr = WSP(bf16_t, WS_H) + (size_t)r * 1024;
    const u32x4 h0 = *(const u32x4*)(hr + lane * 8), h1 = *(const u32x4*)(hr + 512 + lane * 8);
    const unsigned* si = WSP(unsigned, WS_SELI) + (size_t)r * 128; const float* sw = WSP(float, WS_SELW) + (size_t)r * 128;
    const unsigned idx_lo = si[lane], idx_hi = si[64 + lane]; const float w_lo = sw[lane], w_hi = sw[64 + lane];
    const bf16_t* PU = WSP(bf16_t, WS_PU); const bf16_t* PV = WSP(bf16_t, WS_PV);
    float acc[16];
#pragma unroll
    for (int i = 0; i < 16; ++i) acc[i] = 0.f;
    const int myr = ((lane >> 5) & 1) * 4 + ((lane >> 4) & 1) * 2 + ((lane >> 3) & 1);
#pragma unroll 1
    for (int g = 0; g < 16; ++g) {
        const unsigned idxv = g < 8 ? idx_lo : idx_hi; const float wv = g < 8 ? w_lo : w_hi; const int l0 = (g * 8) & 63;
        unsigned e[8];
#pragma unroll
        for (int rr = 0; rr < 8; ++rr) e[rr] = (unsigned)__builtin_amdgcn_readlane((int)idxv, l0 + rr);
        float p[8];
        {
            u32x4 ua[8], ub[8];
#pragma unroll
            for (int rr = 0; rr < 8; ++rr) { const bf16_t* up = PU + (size_t)e[rr] * 1024 + lane * 8; ua[rr] = *(const u32x4*)up; ub[rr] = *(const u32x4*)(up + 512); }
#pragma unroll
            for (int rr = 0; rr < 8; ++rr) p[rr] = dot16(ua[rr], ub[rr], h0, h1);
        }
        float q4[4], q2[2], q1;
#pragma unroll
        for (int i = 0; i < 4; ++i) { const bool up = (lane & 32) != 0; const float send = up ? p[i] : p[i + 4]; const float keep = up ? p[i + 4] : p[i]; q4[i] = keep + __shfl_xor(send, 32); }
#pragma unroll
        for (int i = 0; i < 2; ++i) { const bool up = (lane & 16) != 0; const float send = up ? q4[i] : q4[i + 2]; const float keep = up ? q4[i + 2] : q4[i]; q2[i] = keep + __shfl_xor(send, 16); }
        { const bool up = (lane & 8) != 0; const float send = up ? q2[0] : q2[1]; const float keep = up ? q2[1] : q2[0]; q1 = keep + __shfl_xor(send, 8); }
        q1 += __shfl_xor(q1, 4); q1 += __shfl_xor(q1, 2); q1 += __shfl_xor(q1, 1);
        const float wsel = __shfl(wv, l0 + myr);
        const float coef = wsel * geluf_(q1);
        {
            u32x4 va[8], vb[8];
#pragma unroll
            for (int rr = 0; rr < 8; ++rr) { const bf16_t* vp = PV + (size_t)e[rr] * 1024 + lane * 8; va[rr] = *(const u32x4*)vp; vb[rr] = *(const u32x4*)(vp + 512); }
#pragma unroll
            for (int rr = 0; rr < 8; ++rr) { const float cf = __int_as_float(__builtin_amdgcn_readlane(__float_as_int(coef), ((rr & 4) ? 32 : 0) + ((rr & 2) ? 16 : 0) + ((rr & 1) ? 8 : 0))); fma8(acc, 0, va[rr], cf); fma8(acc, 8, vb[rr], cf); }
        }
    }
    const int b = r < NLAT ? (r >> 13) : 4;
    const float* gt = WSP(float, WS_MOD) + (size_t)(l * 5 + b) * 6144 + 5120;
    const float* xr = r < NLAT ? xsrc_lat + (size_t)r * 1024 : WSP(float, WS_XCTX) + (size_t)(r - NLAT) * 1024;
    float* xw = r < NLAT ? c.out + (size_t)r * 1024 : WSP(float, WS_XCTX) + (size_t)(r - NLAT) * 1024;
    float xn[16]; float s = 0.f;
#pragma unroll
    for (int i = 0; i < 2; ++i) { const int c0 = i * 512 + lane * 8; const f32x4 xa = *(const f32x4*)(xr + c0), xb = *(const f32x4*)(xr + c0 + 4), ga = *(const f32x4*)(gt + c0), gb = *(const f32x4*)(gt + c0 + 4);
#pragma unroll
        for (int j = 0; j < 4; ++j) { xn[i * 8 + j] = xa[j] + ((ABL & 8) ? 0.f : ga[j] * acc[i * 8 + j]); xn[i * 8 + 4 + j] = xb[j] + ((ABL & 8) ? 0.f : gb[j] * acc[i * 8 + 4 + j]); } }
    if (FINAL) {
#pragma unroll
        for (int i = 0; i < 16; ++i) s += xn[i] * xn[i];
#pragma unroll
        for (int o = 32; o; o >>= 1) s += __shfl_xor(s, o);
        const float rs = rsqrtf(s * (1.f / 1024.f) + NORM_EPS); const float* gf = c.in[37];
#pragma unroll
        for (int i = 0; i < 2; ++i) { const int c0 = i * 512 + lane * 8;
#pragma unroll
            for (int j = 0; j < 8; ++j) xn[i * 8 + j] *= rs * gf[c0 + j]; }
    }
#pragma unroll
    for (int i = 0; i < 2; ++i) { const int c0 = i * 512 + lane * 8;
        *(f32x4*)(xw + c0) = (f32x4){xn[i * 8], xn[i * 8 + 1], xn[i * 8 + 2], xn[i * 8 + 3]}; *(f32x4*)(xw + c0 + 4) = (f32x4){xn[i * 8 + 4], xn[i * 8 + 5], xn[i * 8 + 6], xn[i * 8 + 7]}; }
}
constexpr int PH_PER_LAYER = 11, N_PHASES = 1 + 4 * PH_PER_LAYER;

DI void prep_item(const Ctx& c, int l, int it) {
    if (it < 1792) { int ng = it >> 4; const int kg = it & 15; if (ng >= 56) ng += 8;
        const int n0 = ng * 64, ns0 = n0 < 3584 ? n0 : n0 - 480;
        tr_tile(c, c.in[8] + (size_t)l * 1024 * 7200, 7200, kg * 64, ns0, WSP(bf16_t, WS_BTIN), 1024, n0); return; }
    it -= 1792;
    if (it < 128) { const int d = it >> 6, jg = (it >> 4) & 3, kg = it & 15; fold_tile(c, c.in[8] + (size_t)l * 1024 * 7200, c.in[25] + (size_t)l * 2 * 16 * 256, d, jg * 64, kg * 64, WSP(bf16_t, WS_BTIN)); return; }
    it -= 128;
    if (it < 384) { const int w = it >> 7, r = it & 127, ng = r >> 3, kg = r & 7;
        tr_tile(c, c.in[28 + w] + (size_t)l * 512 * 1024, 1024, kg * 64, ng * 64, WSP(bf16_t, w == 0 ? WS_BTHY : (w == 1 ? WS_BTRG : WS_BTGLA)), 512, ng * 64); return; }
    it -= 384;
    if (it < 256) { const int ng = it >> 4, kg = it & 15; tr_tile(c, c.in[32] + (size_t)l * 1024 * 1024, 1024, kg * 64, ng * 64, WSP(bf16_t, WS_BTOUT), 1024, ng * 64); return; }
    it -= 256;
    if (it < 512) { const int ng = it >> 4, kg = it & 15; tr_tile(c, c.in[33] + (size_t)l * 1024 * 2048, 2048, kg * 64, ng * 64, WSP(bf16_t, WS_BTWQ), 1024, ng * 64); return; }
    it -= 512;
    if (it < 32) { const int d = it >> 4, mat = (it >> 3) & 1, g = it & 7;
        tr_tile(c, c.in[mat ? 22 : 20] + (size_t)((l * 2 + d) * 8 + g) * 4096, 64, 0, 0, WSP(bf16_t, WS_RGW) + (size_t)((d * 2 + mat) * 8 + g) * 4096, 64, 0); return; }
    it -= 32;
    if (it < 32) { cvt_chunk(c, c.in[34] + (size_t)l * 262144 + (size_t)it * 8192, WSP(bf16_t, WS_KEYS) + (size_t)it * 8192); return; }
    it -= 32;
    if (it < 2048) { cvt_chunk(c, c.in[35] + (size_t)l * 16777216 + (size_t)it * 8192, WSP(bf16_t, WS_PU) + (size_t)it * 8192); return; }
    it -= 2048;
    cvt_chunk(c, c.in[36] + (size_t)l * 16777216 + (size_t)it * 8192, WSP(bf16_t, WS_PV) + (size_t)it * 8192);
}
constexpr int N_PREP = 1792 + 128 + 384 + 256 + 512 + 32 + 32 + 2048 + 2048;

__global__ void __launch_bounds__(512, 2) fwd_kernel(Args a) {
    extern __shared__ __attribute__((aligned(16))) unsigned char shm[];
    Ctx c0; c0.in = a.in; c0.out = a.out; c0.ws = a.ws; c0.lds = (LAS unsigned char*)shm;
    c0.tid = threadIdx.x; c0.lane = c0.tid & 63; c0.wid = __builtin_amdgcn_readfirstlane(c0.tid >> 6); c0.G = gridDim.x; c0.bid = blockIdx.x;
    const Ctx& c = c0;
    volatile LAS unsigned* barw = (volatile LAS unsigned*)(c.lds + LDS_BARW);
    if (c.tid < 4) barw[c.tid] = 0u;
    tw_init(c);
    __syncthreads();
    const int lo = a.ph_lo, hi = a.ph_hi;
    XcdBarrier bar; bar.bar = (unsigned*)(c.ws + WS_CTL); bar.x = 0; bar.st = barw;
    if (hi - lo > 1) bar = xcd_barrier_post((unsigned*)(c.ws + WS_CTL), barw);
#ifdef ONLY_PHASE
#define PHON(j) ((j) == ONLY_PHASE)
#else
#define PHON(j) 1
#endif
#ifdef ONLY_SUB
#define SUB(j) ((j) == ONLY_SUB)
#else
#define SUB(j) 1
#endif
#define PH_BEGIN() Ctx cc = c0; int ll = l0; asm volatile("" : "+s"(ll)); asm volatile("" : "+v"(cc.tid)); cc.lane = cc.tid & 63; cc.wid = __builtin_amdgcn_readfirstlane(cc.tid >> 6); asm volatile("" : "+s"(cc.bid)); const Ctx& c = cc; const int l = ll; (void)l;
#define IN(k) (lo <= (k) && (k) < hi)
#define SEAM(k) do { if (IN(k) && IN((k) + 1)) xcd_barrier(bar); } while (0)
    int ph = 0;
    if (PHON(0) && IN(ph)) p0_prologue(c);
    SEAM(ph); ++ph;
#pragma unroll 1
    for (int l0 = 0; l0 < 4; ++l0) {
        if (PHON(1) && IN(ph)) { PH_BEGIN(); const float* xlat_in = l == 0 ? c.in[0] : c.out; const float* modl = WSP(float, WS_MOD) + (size_t)l * 5 * 6144; (void)xlat_in; (void)modl;
            const int n_items = 264 + N_PREP + NTOK / 8;
            for (int it = c.bid; it < n_items; it += c.G) {
                if (it < 264) hy_filter_tile(c, l, it);
                else if (it < 264 + N_PREP) prep_item(c, l, it - 264);
                else norm_row_to_h<0>(c, l, (it - 264 - N_PREP) * 8 + c.wid, xlat_in);
            }
        }
        SEAM(ph); ++ph;
        if (PHON(2) && IN(ph)) { PH_BEGIN(); const float* xlat_in = l == 0 ? c.in[0] : c.out; const float* modl = WSP(float, WS_MOD) + (size_t)l * 5 * 6144; (void)xlat_in; (void)modl;
            SchedIn S; S.so.init(NTOK, 7680, c.G, c.bid); S.H = (const char*)WSP(bf16_t, WS_H); S.Bt = (const char*)WSP(bf16_t, WS_BTIN);
            EpiIn E{WSP(bf16_t, WS_P2), WSP(bf16_t, WS_HYT), WSP(bf16_t, WS_HYTC), c.in[26] + (size_t)l * 512, c.in[31] + (size_t)l * 3072};
            if (SUB(0)) pg8::gemm_phase<EpiIn, SchedIn>(c.lds, 1024, S, E);
            __syncthreads();
            if (SUB(1)) for (int it = c.bid; it < 1024; it += c.G) hy_spec_item(c, it >> 9, it & 511);
        }
        SEAM(ph); ++ph;
        if (PHON(3) && IN(ph)) { PH_BEGIN(); const float* xlat_in = l == 0 ? c.in[0] : c.out; const float* modl = WSP(float, WS_MOD) + (size_t)l * 5 * 6144; (void)xlat_in; (void)modl;
            const int n_items = 1024 + 256 + 4 * NCHK + 16 * NCHK;
            for (int it = c.bid; it < n_items; it += c.G) {
                if (it < 1024) { if (SUB(0)) hy_lat_item(c, l, it >> 9, it & 511); }
                else if (it < 1280) { if (SUB(1) && l < 3) { const int w = (it - 1024) * 8 + c.wid; hy_ctx_item(c, l, w >> 9, w & 511); } __syncthreads(); }
                else if (it < 1280 + 4 * NCHK) { if (SUB(2)) { rg_item<false>(c, l, it - 1280); __syncthreads(); } }
                else { if (SUB(3)) gla_a_item(c, it - 1280 - 4 * NCHK); }
            }
        }
        SEAM(ph); ++ph;
        if (PHON(4) && IN(ph)) { PH_BEGIN(); const float* xlat_in = l == 0 ? c.in[0] : c.out; const float* modl = WSP(float, WS_MOD) + (size_t)l * 5 * 6144; (void)xlat_in; (void)modl;
            rg_carry_scan(c);
            gla_state_scan(c);
            for (int it = c.bid; it < 4096; it += c.G) yhy_tr_tile(c, it >> 10, ((it >> 7) & 7) * 64, (it & 127) * 64);
        }
        SEAM(ph); ++ph;
        if (PHON(5) && IN(ph)) { PH_BEGIN(); const float* xlat_in = l == 0 ? c.in[0] : c.out; const float* modl = WSP(float, WS_MOD) + (size_t)l * 5 * 6144; (void)xlat_in; (void)modl;
            const int n_items = 4 * NCHK + 8 * NCHK;
            for (int it = c.bid; it < n_items; it += c.G) {
                if (it < 4 * NCHK) { if (SUB(0)) { rg_item<true>(c, l, it); __syncthreads(); } }
                else { if (SUB(1)) gla_c_item(c, l, it - 4 * NCHK); }
            }
        }
        SEAM(ph); ++ph;
        if (PHON(6) && IN(ph)) { PH_BEGIN(); const float* xlat_in = l == 0 ? c.in[0] : c.out; const float* modl = WSP(float, WS_MOD) + (size_t)l * 5 * 6144; (void)xlat_in; (void)modl;
            SchedMg S; S.so.init(NTOK, 1024, c.G, c.bid); S.ws = (const char*)c.ws;
            EpiMg E{c.ws};
            pg8::gemm_phase<EpiMg, SchedMg>(c.lds, 512, S, E);
        }
        SEAM(ph); ++ph;
        if (PHON(7) && IN(ph)) { PH_BEGIN(); const float* xlat_in = l == 0 ? c.in[0] : c.out; const float* modl = WSP(float, WS_MOD) + (size_t)l * 5 * 6144; (void)xlat_in; (void)modl;
            SchedPlain S; S.so.init(NTOK, 1024, c.G, c.bid); S.A0 = (const char*)WSP(bf16_t, WS_M); S.B0 = (const char*)WSP(bf16_t, WS_BTOUT); S.ts = (size_t)256 * 1024 * 2;
            EpiOut E{xlat_in, c.out, WSP(float, WS_XCTX), modl};
            pg8::gemm_phase<EpiOut, SchedPlain>(c.lds, 1024, S, E);
        }
        SEAM(ph); ++ph;
        if (PHON(8) && IN(ph)) { PH_BEGIN(); const float* xlat_in = l == 0 ? c.in[0] : c.out; const float* modl = WSP(float, WS_MOD) + (size_t)l * 5 * 6144; (void)xlat_in; (void)modl;
            for (int it = c.bid; it < NTOK / 8; it += c.G) norm_row_to_h<1>(c, l, it * 8 + c.wid, c.out);
        }
        SEAM(ph); ++ph;
        if (PHON(9) && IN(ph)) { PH_BEGIN(); const float* xlat_in = l == 0 ? c.in[0] : c.out; const float* modl = WSP(float, WS_MOD) + (size_t)l * 5 * 6144; (void)xlat_in; (void)modl;
            SchedPlain S; S.so.init(NTOK, 2048, c.G, c.bid); S.A0 = (const char*)WSP(bf16_t, WS_H); S.B0 = (const char*)WSP(bf16_t, WS_BTWQ); S.ts = (size_t)256 * 1024 * 2;
            EpiQ E{WSP(bf16_t, WS_Q)};
            pg8::gemm_phase<EpiQ, SchedPlain>(c.lds, 1024, S, E);
        }
        SEAM(ph); ++ph;
        if (PHON(10) && IN(ph)) { PH_BEGIN(); const float* xlat_in = l == 0 ? c.in[0] : c.out; const float* modl = WSP(float, WS_MOD) + (size_t)l * 5 * 6144; (void)xlat_in; (void)modl;
            for (int it = c.bid; it < NTOK / 32; it += c.G) peer_topk_wave(c, it, c.wid);
        }
        SEAM(ph); ++ph;
        if (PHON(11) && IN(ph)) { PH_BEGIN(); const float* xlat_in = l == 0 ? c.in[0] : c.out; const float* modl = WSP(float, WS_MOD) + (size_t)l * 5 * 6144; (void)xlat_in; (void)modl;
            if (l < 3) { for (int it = c.bid; it < NTOK / 8; it += c.G) peer_expert_token<false>(c, l, it * 8 + c.wid, c.out); }
            else { for (int it = c.bid; it < NLAT / 8; it += c.G) peer_expert_token<true>(c, l, it * 8 + c.wid, c.out); }
        }
        SEAM(ph); ++ph;
    }
#undef IN
#undef SEAM
}

#if !defined(DEBUG_DET) && !defined(DEBUG_PEER)
#ifndef N_LAUNCH_MODE
#define N_LAUNCH_MODE 0
#endif
extern "C" void kernel_launch(void* const* d_in, const int* in_sizes, int n_in, void* d_out, int out_size, void* d_ws, size_t ws_size, hipStream_t stream) {
    static int grid = 0;
    if (grid == 0) {
        if (n_in != 38 || ws_size < WS_END) { fprintf(stderr, "kernel_launch: need 38 inputs and %zu bytes of workspace (got %d, %zu)\n", (size_t)WS_END, n_in, ws_size); grid = -1; return; }
        int dev = 0, cus = 0, per_cu = 0;
        if (hipGetDevice(&dev) != hipSuccess || hipDeviceGetAttribute(&cus, hipDeviceAttributeMultiprocessorCount, dev) != hipSuccess) { grid = -1; return; }
        if (hipFuncSetAttribute((const void*)fwd_kernel, hipFuncAttributeMaxDynamicSharedMemorySize, LDS_BYTES) != hipSuccess) { fprintf(stderr, "kernel_launch: hipFuncSetAttribute failed\n"); grid = -1; return; }
        if (hipOccupancyMaxActiveBlocksPerMultiprocessor(&per_cu, (const void*)fwd_kernel, 512, LDS_BYTES) != hipSuccess || per_cu < 1) { fprintf(stderr, "kernel_launch: occupancy query says %d\n", per_cu); }
        (void)hipGetLastError();
        grid = cus;
    }
    if (grid < 0) return;
    (void)hipMemsetAsync((char*)d_ws + WS_CTL, 0, 65536, stream);
    Args a; memset(&a, 0, sizeof(a));
    for (int i = 0; i < 38; ++i) a.in[i] = (const float*)d_in[i];
    a.out = (float*)d_out; a.ws = (unsigned char*)d_ws;
#if N_LAUNCH_MODE == 1
    a.ph_lo = 0; a.ph_hi = N_PHASES;
    hipLaunchKernelGGL(fwd_kernel, dim3(grid), dim3(512), LDS_BYTES, stream, a);
#else
    for (int p = 0; p < N_PHASES; ++p) { a.ph_lo = p; a.ph_hi = p + 1; hipLaunchKernelGGL(fwd_kernel, dim3(grid), dim3(512), LDS_BYTES, stream, a); }
#endif
}
#endif
```

```cpp
#define N_LAUNCH_MODE 1
#include <hip/hip_runtime.h>
#include <stdint.h>
#include <cstdio>
#include <cstring>

typedef unsigned short bf16_t;
typedef float cf2 __attribute__((ext_vector_type(2)));
typedef short bf16x8 __attribute__((ext_vector_type(8)));
typedef float f32x4 __attribute__((ext_vector_type(4)));
typedef float f32x16 __attribute__((ext_vector_type(16)));
typedef unsigned u32x4 __attribute__((ext_vector_type(4)));
typedef unsigned u32x2 __attribute__((ext_vector_type(2)));
#define LAS __attribute__((address_space(3)))

#define DI __device__ __forceinline__

constexpr int NTOK = 33792, NLAT = 32768, DM = 1024, SEQ = 8192, CTXL = 256, NCHK = 132;
constexpr int P2W = 3072;
constexpr int PC_RGX = 0, PC_RGG = 512, PC_Q = 1024, PC_K = 1280, PC_V = 1536, PC_LAF = 2048, PC_LAB = 2304, PC_GG = 2560, PC_MG = 3072;
constexpr float NORM_EPS = 1e-6f;
constexpr size_t WS_CTL = 0;
constexpr size_t WS_MOD = 65536;
constexpr size_t WS_XCTX = WS_MOD + 491520;
constexpr size_t WS_H = WS_XCTX + 4194304;
constexpr size_t WS_YHT = WS_H, WS_YHY = WS_H + 33554432;
constexpr size_t WS_P2 = WS_H + 69206016;
constexpr size_t WS_Q = WS_P2, WS_SELI = WS_P2 + 138412032, WS_SELW = WS_SELI + 17301504;
constexpr size_t WS_GF = WS_P2 + 207618048;
constexpr size_t WS_HYT = WS_GF + 207618048;
constexpr size_t WS_HYTC = WS_HYT + 100663296;
constexpr size_t WS_M = WS_HYT;
constexpr size_t WS_HF = WS_HYT;
constexpr size_t WS_YRG = WS_HYT + 103809024;
constexpr size_t WS_YGLA = WS_YRG + 34603008;
constexpr size_t WS_SPEC = WS_YGLA + 34603008;
constexpr size_t WS_GST = WS_SPEC + 67108864;
constexpr size_t WS_HWT = WS_GST;
constexpr size_t WS_GDEC = WS_GST + 138412032;
constexpr size_t WS_RGAGG = WS_GDEC + 1081344;
constexpr size_t WS_RGCAR = WS_RGAGG + 4325376;
constexpr size_t WS_BTIN = WS_RGCAR + 2162688;
constexpr size_t WS_BTHY = WS_BTIN + 15728640;
constexpr size_t WS_BTRG = WS_BTHY + 1048576, WS_BTGLA = WS_BTRG + 1048576;
constexpr size_t WS_BTOUT = WS_BTGLA + 1048576;
constexpr size_t WS_BTWQ = WS_BTOUT + 2097152;
constexpr size_t WS_KEYS = WS_BTWQ + 4194304;
constexpr size_t WS_RGW = WS_KEYS + 524288;
constexpr size_t WS_PU = WS_RGW + 262144;
constexpr size_t WS_PV = WS_PU + 16777216;
constexpr size_t WS_RGAB = WS_PV + 8388608;
constexpr size_t WS_HWTC = WS_RGAB + 138412032;
constexpr size_t WS_SPART = WS_HWTC + 2097152;
constexpr size_t WS_W3T = WS_SPART + 272 * 2048 * 4;
constexpr size_t WS_END = WS_W3T + 4 * 2048 * 64 * 2;

constexpr int LDS_BIG = 131072, LDS_TW = 139264, LDS_BARW = 141312, LDS_BYTES = 147456;

#ifndef ABL
#define ABL 0
#endif
#ifndef PU_FP4
#define PU_FP4 1
#endif
#ifndef PV_FP4
#define PV_FP4 1
#endif
constexpr float PU_ISCALE = 96.0f, PH_ISCALE = 8.0f;
constexpr float PU_SCALE = PU_FP4 ? 54.4f : 1024.0f, PV_SCALE = PV_FP4 ? 3.4f : 64.0f;
struct Args {
    const float* in[38];
    float* out;
    unsigned char* ws;
    int ph_lo, ph_hi;
};

typedef __bf16 bfv2_t __attribute__((ext_vector_type(2)));
DI unsigned pk_bf16(float lo, float hi) { cf2 f; f.x = lo; f.y = hi; const bfv2_t r = __builtin_convertvector(f, bfv2_t); return __builtin_bit_cast(unsigned, r); }
DI bf16_t f2bf(float x) { return (bf16_t)(pk_bf16(x, 0.f) & 0xffffu); }
DI float bf2f(bf16_t u) { return __uint_as_float(((unsigned)u) << 16); }
DI float bflo(unsigned u) { return __uint_as_float(u << 16); }
DI float bfhi(unsigned u) { return __uint_as_float(u & 0xffff0000u); }
DI float sigmoidf_(float x) { return __builtin_amdgcn_rcpf(1.0f + __expf(-x)); }
DI float siluf_(float x) { return x * sigmoidf_(x); }
DI float geluf_(float x) { const float z = 1.5957691216057308f * (x + 0.044715f * x * x * x); return x * sigmoidf_(z); }
DI float logsigmoidf_(float x) { return -(fmaxf(-x, 0.f) + __logf(1.0f + __expf(-fabsf(x)))); }
DI cf2 mk2(float a, float b) { cf2 r; r.x = a; r.y = b; return r; }
DI cf2 cmul(cf2 a, cf2 b) { return mk2(a.x * b.x - a.y * b.y, a.x * b.y + a.y * b.x); }
DI cf2 cmulc(cf2 a, cf2 b) { return mk2(a.x * b.x + a.y * b.y, a.y * b.x - a.x * b.y); }
#define LDS_FENCE() asm volatile("s_waitcnt lgkmcnt(0)" ::: "memory")

#define XB_TMO      128
#define XB_XCNT(j)  (256  + 64 * (j))
#define XB_XSUB(j)  (1280 + 64 * (j))
#define XB_XGEN(j)  (2304 + 64 * (j))
#define XB_TOP      3328
#define XB_TOPGEN   3392
#define XCD_BAR_WORDS 3456
#define XB_SPIN_CAP (1u << 18)
__device__ __forceinline__ unsigned xb_ld(unsigned* p)              { return __hip_atomic_load(p, __ATOMIC_RELAXED, __HIP_MEMORY_SCOPE_AGENT); }
__device__ __forceinline__ unsigned xb_add(unsigned* p, unsigned v) { return __hip_atomic_fetch_add(p, v, __ATOMIC_RELAXED, __HIP_MEMORY_SCOPE_AGENT); }
__device__ __forceinline__ unsigned xb_xcc_id() { return (unsigned)__builtin_amdgcn_s_getreg((3 << 11) | 20) & 0xFu; }
#define XB_SPIN(cond, bar) do { unsigned _sp = 0; while (cond) { __builtin_amdgcn_s_sleep(1); \
    if ((++_sp & 255u) == 0u) { if (xb_ld(&(bar)[XB_TMO])) break; if (_sp > XB_SPIN_CAP) { atomicAdd(&(bar)[XB_TMO], 1u); break; } } } } while (0)
struct XcdBarrier { unsigned* bar; unsigned x; volatile LAS unsigned* st; };
__device__ __forceinline__ XcdBarrier xcd_barrier_post(unsigned* bar, volatile LAS unsigned* st) {
    XcdBarrier b; b.bar = bar; b.x = xb_xcc_id(); b.st = st;
    if (threadIdx.x == 0) (void)xb_add(&bar[XB_XCNT(b.x)], 1u);
    return b;
}
__device__ __forceinline__ void xcd_barrier_complete(unsigned* bar, unsigned x, unsigned& nloc, unsigned& nx) {
    const unsigned G = gridDim.x * gridDim.y * gridDim.z;
    unsigned sum, cnt, mine, sp = 0u;
    for (;;) {
        sum = 0u; cnt = 0u; mine = 0u;
#pragma unroll
        for (unsigned j = 0; j < 16; ++j) { const unsigned c = xb_ld(&bar[XB_XCNT(j)]); sum += c; cnt += (c > 0u) ? 1u : 0u; mine = (j == x) ? c : mine; }
        if (sum == G) break;
        __builtin_amdgcn_s_sleep(1);
        if ((++sp & 255u) == 0u) { if (xb_ld(&bar[XB_TMO])) break; if (sp > XB_SPIN_CAP) { atomicAdd(&bar[XB_TMO], 1u); break; } }
    }
    nloc = mine > 0u ? mine : 1u; nx = cnt > 0u ? cnt : 1u;
}
__device__ __forceinline__ void xcd_barrier(const XcdBarrier& b) {
    asm volatile("s_waitcnt vmcnt(0)" ::: "memory");
    __syncthreads();
    if (threadIdx.x == 0) {
        unsigned* bar = b.bar;
        __builtin_amdgcn_s_waitcnt(0);
        unsigned nloc = b.st[0], nx = b.st[1];
        if (nloc == 0u) { xcd_barrier_complete(bar, b.x, nloc, nx); b.st[0] = nloc; b.st[1] = nx; }
        const unsigned old = xb_add(&bar[XB_XSUB(b.x)], 1u);
        const unsigned gen = old / nloc;
        if (old + 1u == (gen + 1u) * nloc) {
            __builtin_amdgcn_fence(__ATOMIC_RELEASE, "agent");
            asm volatile("s_waitcnt vmcnt(0)" ::: "memory");
            const unsigned og = xb_add(&bar[XB_TOP], 1u);
            const unsigned tg = og / nx;
            if (og + 1u == (tg + 1u) * nx) xb_add(&bar[XB_TOPGEN], 1u);
            else XB_SPIN(xb_ld(&bar[XB_TOPGEN]) == tg, bar);
            __builtin_amdgcn_fence(__ATOMIC_ACQUIRE, "agent");
            xb_add(&bar[XB_XGEN(b.x)], 1u);
            asm volatile("s_waitcnt vmcnt(0)" ::: "memory");
        } else {
            XB_SPIN(xb_ld(&bar[XB_XGEN(b.x)]) == gen, bar);
            __builtin_amdgcn_fence(__ATOMIC_ACQUIRE, "agent");
            asm volatile("s_waitcnt vmcnt(0)" ::: "memory");
        }
    }
    __syncthreads();
}

namespace pg8 {
constexpr int BM = 256, BK = 64, HALF = 128, HTB = HALF * BK * 2, STAGE_BYTES = 8 * HTB, NXCD = 8, WGM = 8;
__host__ __device__ __forceinline__ int lds_byte(int r, int c) { const int st = (r >> 4) * 2 + (c >> 5), rr = r & 15, cc = c & 31, ob = rr * 64 + cc * 2; return st * 1024 + (ob ^ (((ob >> 9) & 1) << 5)); }
__host__ __device__ __forceinline__ void stage_rc(int b, int& R, int& C) { const int st = b / 1024, sb = b % 1024, swz = sb ^ (((sb >> 9) & 1) << 5); R = (st >> 1) * 16 + swz / 64; C = (st & 1) * 32 + (swz % 64) / 2; }
__host__ __device__ __forceinline__ int perm32(int rho) { const int n = rho >> 4, i = rho & 15; return 8 * (i >> 2) + 4 * n + (i & 3); }
struct Unit { int pm, pn, seg; };
struct StaticOrder {
    int nM, nN, nwg, G, c;
    __device__ void init(int M, int N, int G_, int c_) { nM = M / BM; nN = N / BM; nwg = nM * nN; G = G_; c = c_; }
    __device__ bool next(int i, Unit& u) const {
        const long L = (long)i * G + c; if (L >= nwg) return false;
        int wgid = (int)L; { const int q = nwg / NXCD, r = nwg % NXCD, xcd = wgid % NXCD, off = wgid / NXCD; wgid = (xcd < r ? xcd * (q + 1) : r * (q + 1) + (xcd - r) * q) + off; }
        const int nig = WGM * nN, gid = wgid / nig, fm = gid * WGM, gsz = (nM - fm) < WGM ? (nM - fm) : WGM;
        u.pm = fm + ((wgid % nig) % gsz); u.pn = (wgid % nig) / gsz; u.seg = 0; return true;
    }
};
template <class Epi, class Sched>
__device__ __forceinline__ void gemm_phase(LAS unsigned char* lds, const int K, const Sched& S, const Epi& E) {
    int tid_ = threadIdx.x; asm volatile("" : "+v"(tid_));
    const int tid = tid_, wid = __builtin_amdgcn_readfirstlane(tid >> 6), lane = tid & 63, wr = wid >> 2, wc = wid & 3, fr = lane & 15, fq = lane >> 4;
    const int nt = K / BK;
    unsigned voffA[2], voffB[2];
#pragma unroll
    for (int i = 0; i < 2; ++i) { int R, C; stage_rc(tid * 16 + i * 8192, R, C); const int Rb = Epi::PERM ? ((R & ~31) + perm32(R & 31)) : R;
        voffA[i] = (unsigned)(R * K + C) * 2u; voffB[i] = (unsigned)(Rb * K + C) * 2u; }
    const size_t kstep = (size_t)(BK * 2);
    const size_t hstep = (size_t)HALF * K * 2;
    const unsigned ldsw = (unsigned)wid * 1024u;
    const int aoff = lds_byte(wr * 64 + fr, fq * 8), boff = lds_byte(wc * 32 + fr, fq * 8);
#define PG8_SA(b, h) (((b) * 2 + (h)) * HTB)
#define PG8_SB(b, h) ((4 + (b) * 2 + (h)) * HTB)
#define PG8_STAGE(bufoff, gbase, voff) do { _Pragma("unroll") for (int _i = 0; _i < 2; ++_i) \
        __builtin_amdgcn_global_load_lds((const unsigned*)((const char*)(gbase) + (voff)[_i]), (LAS unsigned*)(lds + (bufoff) + ldsw + _i * 8192), 16, 0, 0); } while (0)
#define PG8_LDA(dst, b, h) do { _Pragma("unroll") for (int m = 0; m < 4; ++m) _Pragma("unroll") for (int k = 0; k < 2; ++k) dst[m][k] = *(const LAS bf16x8*)(lds + PG8_SA(b, h) + aoff + m * 2048 + k * 1024); } while (0)
#define PG8_LDB(dst, b, h) do { _Pragma("unroll") for (int n = 0; n < 2; ++n) _Pragma("unroll") for (int k = 0; k < 2; ++k) dst[n][k] = *(const LAS bf16x8*)(lds + PG8_SB(b, h) + boff + n * 2048 + k * 1024); } while (0)
#define PG8_MMA(ai, bj, At, Bt) do { __builtin_amdgcn_s_setprio(1); _Pragma("unroll") for (int m = 0; m < 4; ++m) _Pragma("unroll") for (int n = 0; n < 2; ++n) _Pragma("unroll") for (int k = 0; k < 2; ++k) \
        acc[ai][bj][m][n] = __builtin_amdgcn_mfma_f32_16x16x32_bf16(Bt[n][k], At[m][k], acc[ai][bj][m][n], 0, 0, 0); __builtin_amdgcn_s_setprio(0); } while (0)
#define PG8_WAIT_V(n) asm volatile("s_waitcnt vmcnt(" #n ")" ::: "memory")
#define PG8_WAIT_L(n) asm volatile("s_waitcnt lgkmcnt(" #n ")" ::: "memory")
#define PG8_BAR __builtin_amdgcn_s_barrier()
#define PG8_SCHED __builtin_amdgcn_sched_barrier(0)
    Unit cur, nxt; int ui = 0;
    if (!S.next(0, cur)) return;
    f32x4 acc[2][2][4][2];
#pragma unroll
    for (int a = 0; a < 2; ++a)
#pragma unroll
        for (int b = 0; b < 2; ++b)
#pragma unroll
            for (int m = 0; m < 4; ++m)
#pragma unroll
                for (int n = 0; n < 2; ++n) acc[a][b][m][n] = (f32x4){0.f, 0.f, 0.f, 0.f};
    bf16x8 At[4][2], B0[2][2], B1[2][2];
    const char* cA; const char* cB; S.ptrs(cur, cA, cB);
    PG8_STAGE(PG8_SB(0, 0), cB, voffB); PG8_STAGE(PG8_SA(0, 0), cA, voffA); PG8_STAGE(PG8_SB(0, 1), cB + hstep, voffB); PG8_STAGE(PG8_SA(0, 1), cA + hstep, voffA);
    if (wr == 1) PG8_BAR;
    PG8_WAIT_V(4); PG8_BAR;
    PG8_STAGE(PG8_SB(1, 0), cB + kstep, voffB); PG8_STAGE(PG8_SA(1, 0), cA + kstep, voffA); PG8_STAGE(PG8_SB(1, 1), cB + hstep + kstep, voffB);
    PG8_WAIT_V(6); PG8_BAR;
    for (;;) {
        const bool has_next = S.next(ui + 1, nxt);
        const char* nA = cA; const char* nB = cB; if (has_next) S.ptrs(nxt, nA, nB);
        for (int t = 0; t < nt; t += 2) {
            const bool last = (t == nt - 2);
            const char* a1 = cA + (size_t)(t + 1) * kstep;
            const char* a2 = last ? nA : cA + (size_t)(t + 2) * kstep; const char* b2 = last ? nB : cB + (size_t)(t + 2) * kstep;
            const char* a3 = a2 + kstep; const char* b3 = b2 + kstep;
            PG8_LDB(B0, 0, 0); PG8_SCHED; PG8_LDA(At, 0, 0); PG8_STAGE(PG8_SA(1, 1), a1 + hstep, voffA);
            PG8_WAIT_L(8); PG8_BAR; PG8_WAIT_L(0); PG8_MMA(0, 0, At, B0); PG8_BAR; PG8_SCHED;
            PG8_LDB(B1, 0, 1); PG8_STAGE(PG8_SB(0, 0), b2, voffB);
            PG8_BAR; PG8_WAIT_L(0); PG8_MMA(0, 1, At, B1); PG8_BAR;
            PG8_LDA(At, 0, 1); PG8_STAGE(PG8_SA(0, 0), a2, voffA);
            PG8_BAR; PG8_WAIT_L(0); PG8_MMA(1, 0, At, B0); PG8_BAR; PG8_SCHED;
            PG8_STAGE(PG8_SB(0, 1), b2 + hstep, voffB);
            PG8_WAIT_V(6); PG8_BAR; PG8_MMA(1, 1, At, B1); PG8_BAR;
            PG8_LDB(B0, 1, 0); PG8_SCHED; PG8_LDA(At, 1, 0); PG8_STAGE(PG8_SA(0, 1), a2 + hstep, voffA);
            PG8_WAIT_L(8); PG8_BAR; PG8_WAIT_L(0); PG8_MMA(0, 0, At, B0); PG8_BAR; PG8_SCHED;
            PG8_LDB(B1, 1, 1); PG8_STAGE(PG8_SB(1, 0), b3, voffB);
            PG8_BAR; PG8_WAIT_L(0); PG8_MMA(0, 1, At, B1); PG8_BAR;
            PG8_LDA(At, 1, 1); PG8_STAGE(PG8_SA(1, 0), a3, voffA);
            PG8_BAR; PG8_WAIT_L(0); PG8_MMA(1, 0, At, B0); PG8_BAR; PG8_SCHED;
            PG8_STAGE(PG8_SB(1, 1), b3 + hstep, voffB);
            PG8_WAIT_V(6); PG8_BAR; PG8_MMA(1, 1, At, B1); PG8_BAR;
        }
        const bool keep = E(acc, cur, wr, wc, fr, fq);
        if (!has_next) break;
        if (!keep) {
#pragma unroll
        for (int a = 0; a < 2; ++a)
#pragma unroll
            for (int b = 0; b < 2; ++b)
#pragma unroll
                for (int m = 0; m < 4; ++m)
#pragma unroll
                    for (int n = 0; n < 2; ++n) acc[a][b][m][n] = (f32x4){0.f, 0.f, 0.f, 0.f};
        }
        cur = nxt; cA = nA; cB = nB; ++ui;
    }
    PG8_WAIT_V(0);
    if (wr == 0) PG8_BAR;
    PG8_BAR;
#undef PG8_SA
#undef PG8_SB
#undef PG8_STAGE
#undef PG8_LDA
#undef PG8_LDB
#undef PG8_MMA
#undef PG8_WAIT_V
#undef PG8_WAIT_L
#undef PG8_BAR
#undef PG8_SCHED
}
}
struct Ctx {
    const float* const* in;
    float* out; unsigned char* ws; LAS unsigned char* lds;
    int tid, lane, wid, G, bid;
};
#define WSP(T, off) ((T*)(c.ws + (off)))

struct SchedIn {
    pg8::StaticOrder so; const char* H; const char* Bt;
    DI bool next(int i, pg8::Unit& u) const { return so.next(i, u); }
    DI void ptrs(const pg8::Unit& u, const char*& A, const char*& B) const { const size_t ts = (size_t)256 * 1024 * 2;
        if (u.pn < 6) { A = Bt + (size_t)u.pn * ts; B = H + (size_t)u.pm * ts; } else { A = H + (size_t)u.pm * ts; B = Bt + (size_t)u.pn * ts; } }
};
struct EpiIn {
    static constexpr bool PERM = true;
    bf16_t* P2; bf16_t* HYT; bf16_t* HYTC; const float* b_lr; const float* b_merge; bf16_t* GF;
    DI bool operator()(f32x4 (&acc)[2][2][4][2], const pg8::Unit& u, int wr, int wc, int fr, int fq) const {
        if (u.pn < 6) {
            bf16_t* base; size_t ld;
            if (u.pm < 128) { const int b = u.pm >> 5, t0 = (u.pm & 31) * 256; base = HYT + (size_t)b * 1536 * 8192 + t0; ld = 8192; }
            else { const int b = u.pm - 128; base = HYTC + (size_t)b * 1536 * 256; ld = 256; }
#pragma unroll
            for (int ai = 0; ai < 2; ++ai)
#pragma unroll
                for (int m = 0; m < 4; ++m) {
                    const int ch = 256 * u.pn + 128 * ai + 64 * wr + 16 * m + fr;
                    bf16_t* rowp = base + (size_t)ch * ld;
#pragma unroll
                    for (int bj = 0; bj < 2; ++bj) { const int tk = 128 * bj + 32 * wc + 8 * fq; const f32x4 v0 = acc[ai][bj][m][0], v1 = acc[ai][bj][m][1];
                        u32x4 w; w.x = pk_bf16(v0[0], v0[1]); w.y = pk_bf16(v0[2], v0[3]); w.z = pk_bf16(v1[0], v1[1]); w.w = pk_bf16(v1[2], v1[3]);
                        *(u32x4*)(rowp + tk) = w; }
                }
        } else {
            const int kind = (u.pn == 14 || u.pn == 15) ? 1 : (u.pn >= 18 ? 2 : 0);
            const int pc0 = 256 * (u.pn - 6);
#pragma unroll
            for (int bj = 0; bj < 2; ++bj) {
                const int cl = 128 * bj + 32 * wc + 8 * fq;
                float bias[8];
#pragma unroll
                for (int j = 0; j < 8; ++j) bias[j] = 0.f;
                if (kind == 1) { const float* bp = b_lr + (u.pn - 14) * 256 + cl;
#pragma unroll
                    for (int j = 0; j < 8; ++j) bias[j] = bp[j]; }
                if (kind == 2) { const float* bp = b_merge + (u.pn - 18) * 256 + cl;
#pragma unroll
                    for (int j = 0; j < 8; ++j) bias[j] = bp[j]; }
#pragma unroll
                for (int ai = 0; ai < 2; ++ai)
#pragma unroll
                    for (int m = 0; m < 4; ++m) {
                        const int row = 256 * u.pm + 128 * ai + 64 * wr + 16 * m + fr;
                        float v[8];
#pragma unroll
                        for (int j = 0; j < 4; ++j) { v[j] = acc[ai][bj][m][0][j] + bias[j]; v[4 + j] = acc[ai][bj][m][1][j] + bias[4 + j]; }
                        if (kind == 1) {
#pragma unroll
                            for (int j = 0; j < 8; ++j) v[j] = logsigmoidf_(v[j]) * 0.0625f; }
                        if (kind == 2) {
#pragma unroll
                            for (int j = 0; j < 8; ++j) v[j] = sigmoidf_(v[j]); }
                        u32x4 w; w.x = pk_bf16(v[0], v[1]); w.y = pk_bf16(v[2], v[3]); w.z = pk_bf16(v[4], v[5]); w.w = pk_bf16(v[6], v[7]);
                        if (kind == 2) *(u32x4*)(GF + ((((size_t)u.pm * 12 + (u.pn - 18)) * 8 + (wr * 4 + wc)) * 16 + (ai * 8 + m * 2 + bj)) * 512 + (fq * 16 + fr) * 8) = w;
                        else *(u32x4*)(P2 + (size_t)row * P2W + pc0 + cl) = w;
                    }
            }
        }
        return false;
    }
};
struct SchedMg {
    pg8::StaticOrder so; const char* ws;
    DI bool next(int i, pg8::Unit& u) const { if (!so.next(i / 3, u)) return false; u.seg = i % 3; return true; }
    DI void ptrs(const pg8::Unit& u, const char*& A, const char*& B) const { const size_t ts = (size_t)256 * 512 * 2;
        const size_t yo = u.seg == 0 ? WS_YHY : (u.seg == 1 ? WS_YRG : WS_YGLA); const size_t bo = u.seg == 0 ? WS_BTHY : (u.seg == 1 ? WS_BTRG : WS_BTGLA);
        A = ws + yo + (size_t)u.pm * ts; B = ws + bo + (size_t)u.pn * ts; }
};
struct EpiMg {
    static constexpr bool PERM = true;
    unsigned char* ws;
    DI bool operator()(f32x4 (&acc)[2][2][4][2], const pg8::Unit& u, int wr, int wc, int fr, int fq) const {
        const bf16_t* GF = (const bf16_t*)(ws + WS_GF); bf16_t* M = (bf16_t*)(ws + WS_M);
        const bf16_t* g0 = GF + (((size_t)u.pm * 12 + (u.seg * 4 + u.pn)) * 8 + (wr * 4 + wc)) * 16 * 512 + (fq * 16 + fr) * 8;
        const bf16_t* g1 = g0 + (size_t)4 * 8 * 16 * 512;
#pragma unroll
        for (int ai = 0; ai < 2; ++ai) {
            u32x4 ga[4][2], gb[4][2];
#pragma unroll
            for (int m = 0; m < 4; ++m)
#pragma unroll
                for (int bj = 0; bj < 2; ++bj) { const int fi = (ai * 8 + m * 2 + bj) * 512; ga[m][bj] = *(const u32x4*)(g0 + fi); gb[m][bj] = u.seg < 2 ? *(const u32x4*)(g1 + fi) : (u32x4){0x3f803f80u, 0x3f803f80u, 0x3f803f80u, 0x3f803f80u}; }
            asm volatile("" ::: "memory");
#pragma unroll
            for (int m = 0; m < 4; ++m) {
                const int row = 256 * u.pm + 128 * ai + 64 * wr + 16 * m + fr;
#pragma unroll
                for (int bj = 0; bj < 2; ++bj) {
                    const int col = 256 * u.pn + 128 * bj + 32 * wc + 8 * fq;
                    const u32x4 a4 = ga[m][bj], b4 = gb[m][bj];
                    float f[8] = {bflo(a4.x), bfhi(a4.x), bflo(a4.y), bfhi(a4.y), bflo(a4.z), bfhi(a4.z), bflo(a4.w), bfhi(a4.w)};
                    if (u.seg < 2) {
                        f[0] *= __builtin_amdgcn_rcpf(bflo(b4.x)); f[1] *= __builtin_amdgcn_rcpf(bfhi(b4.x)); f[2] *= __builtin_amdgcn_rcpf(bflo(b4.y)); f[3] *= __builtin_amdgcn_rcpf(bfhi(b4.y));
                        f[4] *= __builtin_amdgcn_rcpf(bflo(b4.z)); f[5] *= __builtin_amdgcn_rcpf(bfhi(b4.z)); f[6] *= __builtin_amdgcn_rcpf(bflo(b4.w)); f[7] *= __builtin_amdgcn_rcpf(bfhi(b4.w)); }
#pragma unroll
                    for (int j = 0; j < 4; ++j) { acc[ai][bj][m][0][j] *= f[j]; acc[ai][bj][m][1][j] *= f[4 + j]; }
                    if (u.seg == 2) { const f32x4 v0 = acc[ai][bj][m][0], v1 = acc[ai][bj][m][1];
                        u32x4 w; w.x = pk_bf16(v0[0], v0[1]); w.y = pk_bf16(v0[2], v0[3]); w.z = pk_bf16(v1[0], v1[1]); w.w = pk_bf16(v1[2], v1[3]);
                        *(u32x4*)(M + (size_t)row * 1024 + col) = w; }
                }
            }
        }
        return u.seg != 2;
    }
};
struct SchedPlain {
    pg8::StaticOrder so; const char* A0; const char* B0; size_t ts;
    DI bool next(int i, pg8::Unit& u) const { return so.next(i, u); }
    DI void ptrs(const pg8::Unit& u, const char*& A, const char*& B) const { A = A0 + (size_t)u.pm * ts; B = B0 + (size_t)u.pn * ts; }
};
struct EpiOut {
    static constexpr bool PERM = false;
    const float* xsrc_lat; float* xdst_lat; float* xctx; const float* mod;
    DI bool operator()(f32x4 (&acc)[2][2][4][2], const pg8::Unit& u, int wr, int wc, int fr, int fq) const {
        const int b = u.pm < 128 ? (u.pm >> 5) : 4;
        const float* gt = mod + b * 6144 + 2048;
        f32x4 g[2][2];
#pragma unroll
        for (int bj = 0; bj < 2; ++bj)
#pragma unroll
            for (int n = 0; n < 2; ++n) g[bj][n] = *(const f32x4*)(gt + 256 * u.pn + 128 * bj + 32 * wc + 16 * n + 4 * fq);
#pragma unroll
        for (int ai = 0; ai < 2; ++ai)
#pragma unroll
        for (int mh = 0; mh < 2; ++mh) {
            f32x4 xv[2][2][2];
#pragma unroll
            for (int m2 = 0; m2 < 2; ++m2) { const int row = 256 * u.pm + 128 * ai + 64 * wr + 16 * (mh * 2 + m2) + fr;
                const float* sp = row < NLAT ? xsrc_lat + (size_t)row * 1024 : xctx + (size_t)(row - NLAT) * 1024;
#pragma unroll
                for (int bj = 0; bj < 2; ++bj)
#pragma unroll
                    for (int n = 0; n < 2; ++n) xv[m2][bj][n] = *(const f32x4*)(sp + 256 * u.pn + 128 * bj + 32 * wc + 16 * n + 4 * fq); }
            asm volatile("" ::: "memory");
#pragma unroll
            for (int m2 = 0; m2 < 2; ++m2) { const int m = mh * 2 + m2, row = 256 * u.pm + 128 * ai + 64 * wr + 16 * m + fr;
                float* dp = row < NLAT ? xdst_lat + (size_t)row * 1024 : xctx + (size_t)(row - NLAT) * 1024;
#pragma unroll
                for (int bj = 0; bj < 2; ++bj)
#pragma unroll
                    for (int n = 0; n < 2; ++n) { const int col = 256 * u.pn + 128 * bj + 32 * wc + 16 * n + 4 * fq; const f32x4 x = xv[m2][bj][n];
                        *(f32x4*)(dp + col) = (ABL & 16) ? x : x + g[bj][n] * acc[ai][bj][m][n]; } }
        }
        return false;
    }
};
struct EpiQ {
    static constexpr bool PERM = true;
    bf16_t* Q;
    DI bool operator()(f32x4 (&acc)[2][2][4][2], const pg8::Unit& u, int wr, int wc, int fr, int fq) const {
#pragma unroll
        for (int ai = 0; ai < 2; ++ai)
#pragma unroll
            for (int m = 0; m < 4; ++m) {
                const int row = 256 * u.pm + 128 * ai + 64 * wr + 16 * m + fr;
#pragma unroll
                for (int bj = 0; bj < 2; ++bj) { const int col = 256 * u.pn + 128 * bj + 32 * wc + 8 * fq; const f32x4 v0 = acc[ai][bj][m][0], v1 = acc[ai][bj][m][1];
                    u32x4 w; w.x = pk_bf16(v0[0], v0[1]); w.y = pk_bf16(v0[2], v0[3]); w.z = pk_bf16(v1[0], v1[1]); w.w = pk_bf16(v1[2], v1[3]);
                    *(u32x4*)(Q + (size_t)row * 2048 + col) = w; }
            }
        return false;
    }
};

DI void tr_tile(const Ctx& c_, const float* src, int lds_, int k0, int ns0, bf16_t* dst, int ldd, int n0);
DI void p0_prologue(const Ctx& c) {
    LAS float* cond = (LAS float*)c.lds;
    LAS float* red = cond + 5 * 1024;
    const float* cin = c.in[1]; const float* cctx = c.in[3]; const float* wmod = c.in[4]; const float* bmod = c.in[5];
    for (int i = c.tid; i < 5 * 1024; i += 512) { const int b = i >> 10, k = i & 1023; const float v = b < 4 ? cin[b * 1024 + k] : cctx[k]; cond[i] = siluf_(v); }
    __syncthreads();
    float* mod = WSP(float, WS_MOD);
    for (int item = c.bid; item < 384; item += c.G) {
        const int l = item / 96, col0 = (item % 96) * 64, col = col0 + c.lane, ks = c.wid;
        float a0 = 0.f, a1 = 0.f, a2 = 0.f, a3 = 0.f, a4 = 0.f;
        const float* w = wmod + ((size_t)l * 1024 + ks * 128) * 6144 + col;
#pragma unroll 8
        for (int k = 0; k < 128; ++k) { const float wv = w[(size_t)k * 6144]; const int kk = ks * 128 + k;
            a0 += cond[kk] * wv; a1 += cond[1024 + kk] * wv; a2 += cond[2048 + kk] * wv; a3 += cond[3072 + kk] * wv; a4 += cond[4096 + kk] * wv; }
        red[(c.wid * 5 + 0) * 64 + c.lane] = a0; red[(c.wid * 5 + 1) * 64 + c.lane] = a1; red[(c.wid * 5 + 2) * 64 + c.lane] = a2;
        red[(c.wid * 5 + 3) * 64 + c.lane] = a3; red[(c.wid * 5 + 4) * 64 + c.lane] = a4;
        __syncthreads();
        if (c.tid < 320) { const int b = c.tid >> 6, ln = c.tid & 63; float s = 0.f;
#pragma unroll
            for (int w8 = 0; w8 < 8; ++w8) s += red[(w8 * 5 + b) * 64 + ln];
            mod[(size_t)(l * 5 + b) * 6144 + col0 + ln] = s + bmod[(size_t)l * 6144 + col0 + ln]; }
        __syncthreads();
    }
    const float4* src = (const float4*)c.in[2]; float4* dst = (float4*)WSP(float, WS_XCTX);
    for (int i = c.bid * 512 + c.tid; i < 262144; i += c.G * 512) dst[i] = src[i];
    __syncthreads();
    for (int it = c.bid; it < 128; it += c.G)
        tr_tile(c, c.in[15] + (size_t)(it >> 5) * 64 * 2048, 2048, 0, (it & 31) * 64, WSP(bf16_t, WS_W3T) + (size_t)(it >> 5) * 2048 * 64, 64, (it & 31) * 64);
}

template <int WHICH>
DI void norm_row_to_h(const Ctx& c, int l, int r, const float* xlat_src) {
    const float* xr = r < NLAT ? xlat_src + (size_t)r * 1024 : WSP(float, WS_XCTX) + (size_t)(r - NLAT) * 1024;
    const int b = r < NLAT ? (r >> 13) : 4;
    const float* mod = WSP(float, WS_MOD) + (size_t)(l * 5 + b) * 6144 + (WHICH ? 3072 : 0);
    const float* g = c.in[WHICH ? 7 : 6] + (size_t)l * 1024;
    float v[16]; float s = 0.f;
#pragma unroll
    for (int i = 0; i < 2; ++i) { const f32x4 p = *(const f32x4*)(xr + i * 512 + c.lane * 8), q = *(const f32x4*)(xr + i * 512 + c.lane * 8 + 4);
#pragma unroll
        for (int j = 0; j < 4; ++j) { v[i * 8 + j] = p[j]; v[i * 8 + 4 + j] = q[j]; s += p[j] * p[j] + q[j] * q[j]; } }
#pragma unroll
    for (int o = 32; o; o >>= 1) s += __shfl_xor(s, o);
    const float rs = rsqrtf(s * (1.f / 1024.f) + NORM_EPS);
    bf16_t* hr = WSP(bf16_t, WS_H) + (size_t)r * 1024;
#pragma unroll
    for (int i = 0; i < 2; ++i) { const int c0 = i * 512 + c.lane * 8; float o[8];
#pragma unroll
        for (int j = 0; j < 8; ++j) o[j] = v[i * 8 + j] * rs * g[c0 + j] * (1.f + mod[1024 + c0 + j]) + mod[c0 + j];
        u32x4 w; w.x = pk_bf16(o[0], o[1]); w.y = pk_bf16(o[2], o[3]); w.z = pk_bf16(o[4], o[5]); w.w = pk_bf16(o[6], o[7]);
        *(u32x4*)(hr + c0) = w; }
}

DI void norm2_rows(const Ctx& c_, int l, int R, const float* xlat) {
    Ctx c = c_; asm volatile("" : "+v"(c.lane));
    const float* g = c.in[7] + (size_t)l * 1024;
    int it = c.bid; if (it * 8 >= R) return;
    f32x4 nx[4];
    { const int r = it * 8 + c.wid; const float* xr = (r < NLAT ? xlat + (size_t)r * 1024 : WSP(float, WS_XCTX) + (size_t)(r - NLAT) * 1024);
#pragma unroll
      for (int i = 0; i < 2; ++i) { nx[2 * i] = *(const f32x4*)(xr + i * 512 + c.lane * 8); nx[2 * i + 1] = *(const f32x4*)(xr + i * 512 + c.lane * 8 + 4); } }
#pragma unroll 1
    for (; it * 8 < R; it += c.G) {
        const int r = it * 8 + c.wid; const int b = r < NLAT ? (r >> 13) : 4;
        f32x4 x[4];
#pragma unroll
        for (int q = 0; q < 4; ++q) x[q] = nx[q];
        { const int itn = it + c.G < R / 8 ? it + c.G : it; const int rn = itn * 8 + c.wid;
          const float* xr = (rn < NLAT ? xlat + (size_t)rn * 1024 : WSP(float, WS_XCTX) + (size_t)(rn - NLAT) * 1024);
#pragma unroll
          for (int i = 0; i < 2; ++i) { nx[2 * i] = *(const f32x4*)(xr + i * 512 + c.lane * 8); nx[2 * i + 1] = *(const f32x4*)(xr + i * 512 + c.lane * 8 + 4); } }
        const float* mod = WSP(float, WS_MOD) + (size_t)(l * 5 + b) * 6144 + 3072;
        float s = 0.f;
#pragma unroll
        for (int q = 0; q < 4; ++q)
#pragma unroll
            for (int j = 0; j < 4; ++j) s += x[q][j] * x[q][j];
#pragma unroll
        for (int o = 32; o; o >>= 1) s += __shfl_xor(s, o);
        const float rs = rsqrtf(s * (1.f / 1024.f) + NORM_EPS);
        bf16_t* hr = WSP(bf16_t, WS_H) + (size_t)r * 1024;
#pragma unroll
        for (int i = 0; i < 2; ++i) { const int c0 = i * 512 + c.lane * 8; float o[8];
#pragma unroll
            for (int j = 0; j < 8; ++j) { const int q = 2 * i + (j >> 2), e = j & 3; o[j] = x[q][e] * rs * g[c0 + j] * (1.f + mod[1024 + c0 + j]) + mod[c0 + j]; }
            u32x4 w; w.x = pk_bf16(o[0], o[1]); w.y = pk_bf16(o[2], o[3]); w.z = pk_bf16(o[4], o[5]); w.w = pk_bf16(o[6], o[7]);
            *(u32x4*)(hr + c0) = w; }
    }
}

DI void tr_tile(const Ctx& c_, const float* src, int lds_, int k0, int ns0, bf16_t* dst, int ldd, int n0) {
    Ctx c = c_; asm volatile("" : "+v"(c.tid));
    LAS float* t = (LAS float*)c.lds;
    { const int k = c.tid >> 3, nq = (c.tid & 7) * 8;
      const f32x4 a = *(const f32x4*)(src + (size_t)(k0 + k) * lds_ + ns0 + nq), b = *(const f32x4*)(src + (size_t)(k0 + k) * lds_ + ns0 + nq + 4);
#pragma unroll
      for (int j = 0; j < 4; ++j) { t[k * 65 + nq + j] = a[j]; t[k * 65 + nq + 4 + j] = b[j]; } }
    __syncthreads();
    { const int n = c.tid >> 3, kq = (c.tid & 7) * 8; float v[8];
#pragma unroll
      for (int j = 0; j < 8; ++j) v[j] = t[(kq + j) * 65 + n];
      u32x4 w; w.x = pk_bf16(v[0], v[1]); w.y = pk_bf16(v[2], v[3]); w.z = pk_bf16(v[4], v[5]); w.w = pk_bf16(v[6], v[7]);
      *(u32x4*)(dst + (size_t)(n0 + n) * ldd + k0 + kq) = w; }
    __syncthreads();
}
DI void tr_tile128(const Ctx& c_, const float* src, int lds_, int k0, int ns0, bf16_t* dst, int ldd, int n0) {
    Ctx c = c_; asm volatile("" : "+v"(c.tid));
    LAS float* t = (LAS float*)c.lds;
    { const int k = c.tid >> 2, nq = (c.tid & 3) * 32; const float* sp = src + (size_t)(k0 + k) * lds_ + ns0 + nq;
      f32x4 a[8];
#pragma unroll
      for (int j = 0; j < 8; ++j) a[j] = *(const f32x4*)(sp + 4 * j);
#pragma unroll
      for (int j = 0; j < 8; ++j) { t[k * 129 + nq + 4 * j] = a[j][0]; t[k * 129 + nq + 4 * j + 1] = a[j][1]; t[k * 129 + nq + 4 * j + 2] = a[j][2]; t[k * 129 + nq + 4 * j + 3] = a[j][3]; } }
    __syncthreads();
    { const int n = c.tid & 127, kq = (c.tid >> 7) * 32; bf16_t* dp = dst + (size_t)(n0 + n) * ldd + k0 + kq;
#pragma unroll
      for (int q = 0; q < 4; ++q) { float v[8];
#pragma unroll
          for (int j = 0; j < 8; ++j) v[j] = t[(kq + 8 * q + j) * 129 + n];
          u32x4 w; w.x = pk_bf16(v[0], v[1]); w.y = pk_bf16(v[2], v[3]); w.z = pk_bf16(v[4], v[5]); w.w = pk_bf16(v[6], v[7]);
          *(u32x4*)(dp + 8 * q) = w; } }
    __syncthreads();
}
DI void fold_tile(const Ctx& c, const float* win, const float* wlr, int d, int j0, int k0, bf16_t* dst) {
    LAS float* a = (LAS float*)c.lds;
    LAS float* b = a + 64 * 17;
    for (int i = c.tid; i < 1024; i += 512) { const int k = i >> 4, r = i & 15; a[k * 17 + r] = win[(size_t)(k0 + k) * 7200 + 3584 + d * 16 + r]; }
    for (int i = c.tid; i < 1024; i += 512) { const int r = i >> 6, j = i & 63; b[r * 64 + j] = wlr[(size_t)(d * 16 + r) * 256 + j0 + j]; }
    __syncthreads();
    { const int j = c.tid >> 3, kq = (c.tid & 7) * 8; float v[8];
#pragma unroll
      for (int q = 0; q < 8; ++q) { float s = 0.f;
#pragma unroll
          for (int r = 0; r < 16; ++r) s += a[(kq + q) * 17 + r] * b[r * 64 + j];
          v[q] = s; }
      u32x4 w; w.x = pk_bf16(v[0], v[1]); w.y = pk_bf16(v[2], v[3]); w.z = pk_bf16(v[4], v[5]); w.w = pk_bf16(v[6], v[7]);
      *(u32x4*)(dst + (size_t)(3584 + d * 256 + j0 + j) * 1024 + k0 + kq) = w; }
    __syncthreads();
}
DI void cvt_chunk(const Ctx& c, const float* src, bf16_t* dst) {
#pragma unroll
    for (int i = 0; i < 2; ++i) { const int o = (i * 512 + c.tid) * 8; const f32x4 a = *(const f32x4*)(src + o), b = *(const f32x4*)(src + o + 4);
        u32x4 w; w.x = pk_bf16(a[0], a[1]); w.y = pk_bf16(a[2], a[3]); w.z = pk_bf16(b[0], b[1]); w.w = pk_bf16(b[2], b[3]);
        *(u32x4*)(dst + o) = w; }
}

DI void cvt_chunk_fp8(const Ctx& c, const float* src, unsigned char* dst, float scale) {
    const int o = c.tid * 16; u32x4 w;
#pragma unroll
    for (int k = 0; k < 4; ++k) { const f32x4 a = *(const f32x4*)(src + o + 4 * k); int p = 0;
        p = __builtin_amdgcn_cvt_pk_fp8_f32(a[0] * scale, a[1] * scale, p, false); p = __builtin_amdgcn_cvt_pk_fp8_f32(a[2] * scale, a[3] * scale, p, true); w[k] = (unsigned)p; }
    *(u32x4*)(dst + o) = w;
}

DI void cvt_chunk_fp4(const Ctx& c, const float* src, unsigned char* dst, float scale) {
    const int o = c.tid * 16; u32x2 w;
#pragma unroll
    for (int k = 0; k < 2; ++k) { const f32x4 a = *(const f32x4*)(src + o + 8 * k), b = *(const f32x4*)(src + o + 8 * k + 4); unsigned p = 0;
        p = __builtin_amdgcn_cvt_scalef32_pk_fp4_f32(p, a[0] * scale, a[1] * scale, 1.0f, 0); p = __builtin_amdgcn_cvt_scalef32_pk_fp4_f32(p, a[2] * scale, a[3] * scale, 1.0f, 1);
        p = __builtin_amdgcn_cvt_scalef32_pk_fp4_f32(p, b[0] * scale, b[1] * scale, 1.0f, 2); p = __builtin_amdgcn_cvt_scalef32_pk_fp4_f32(p, b[2] * scale, b[3] * scale, 1.0f, 3); w[k] = p; }
    *(u32x2*)(dst + c.tid * 8) = w;
}
DI void cvt_chunk_int4_il(const Ctx& c, const float* src, unsigned char* dst, float scale) {
    const int o = c.tid * 16; u32x2 w;
#pragma unroll
    for (int k = 0; k < 2; ++k) { const f32x4 a = *(const f32x4*)(src + o + 8 * k), b = *(const f32x4*)(src + o + 8 * k + 4); unsigned p = 0;
#pragma unroll
        for (int j = 0; j < 4; ++j) { const int qa = (int)fminf(fmaxf(rintf(a[j] * scale), -8.f), 7.f), qb = (int)fminf(fmaxf(rintf(b[j] * scale), -8.f), 7.f);
            p |= ((unsigned)qa & 15u) << (4 * j); p |= ((unsigned)qb & 15u) << (4 * (4 + j)); }
        w[k] = p; }
    *(u32x2*)(dst + c.tid * 16) = w;
}
DI void cvt_chunk_fp4_il(const Ctx& c, const float* src, unsigned char* dst, float scale, int half) {
    const int o = c.tid * 16; u32x2 w;
#pragma unroll
    for (int k = 0; k < 2; ++k) { const f32x4 a = *(const f32x4*)(src + o + 8 * k), b = *(const f32x4*)(src + o + 8 * k + 4); unsigned p = 0;
        p = __builtin_amdgcn_cvt_scalef32_pk_fp4_f32(p, a[0] * scale, a[1] * scale, 1.0f, 0); p = __builtin_amdgcn_cvt_scalef32_pk_fp4_f32(p, a[2] * scale, a[3] * scale, 1.0f, 1);
        p = __builtin_amdgcn_cvt_scalef32_pk_fp4_f32(p, b[0] * scale, b[1] * scale, 1.0f, 2); p = __builtin_amdgcn_cvt_scalef32_pk_fp4_f32(p, b[2] * scale, b[3] * scale, 1.0f, 3); w[k] = p; }
    *(u32x2*)(dst + c.tid * 16 + half * 8) = w;
}

DI void hy_filter_tile(const Ctx& c_, int l, int pt) {
    Ctx c = c_; asm volatile("" : "+v"(c.tid)); c.lane = c.tid & 63;
    const bool isctx = pt >= 256; const int n = isctx ? 256 : 8192; const int t0 = isctx ? (pt - 256) * 16 : pt * 32; const int nth = isctx ? 1 : 2;
    LAS float* feats = (LAS float*)c.lds;
    LAS float* h1 = feats + 32 * 33;
    LAS float* h2 = h1 + 32 * 64;
    const float* w1 = c.in[11] + (size_t)l * 33 * 64; const float* b1 = c.in[12] + l * 64; const float* w2 = c.in[13] + (size_t)l * 64 * 64; const float* b2 = c.in[14] + l * 64;
    const float* w3 = c.in[15] + (size_t)l * 64 * 2048; const float* fr = c.in[16] + l * 64;
    for (int i = c.tid; i < 32 * 33; i += 512) { const int t = i / 33, f = i % 33; const float pos = (float)(t0 + t); float v;
        if (f == 0) v = pos / (float)(n - 1);
        else { const int bi = (f - 1) & 15; const float band = 1e-4f + (float)bi * ((15.0f - 1e-4f) / 15.0f); const float ang = (6.283185307179586f / (float)n) * pos * band;
            v = f <= 16 ? cosf(ang) : -sinf(ang); }
        feats[i] = v; }
    __syncthreads();
    for (int i = c.tid; i < 32 * 64; i += 512) { const int t = i >> 6, j = i & 63; float s = b1[j];
        for (int f = 0; f < 33; ++f) s += feats[t * 33 + f] * w1[f * 64 + j];
        h1[i] = sinf(fr[j] * s); }
    __syncthreads();
    for (int i = c.tid; i < 32 * 64; i += 512) { const int t = i >> 6, j = i & 63; float s = b2[j];
        for (int k = 0; k < 64; ++k) s += h1[t * 64 + k] * w2[k * 64 + j];
        h2[i] = sinf(fr[j] * s); }
    __syncthreads();
    {
        const bf16_t* w3t = WSP(bf16_t, WS_W3T) + (size_t)l * 2048 * 64;
        const int pos = c.lane & 31, kh = c.lane >> 5;
        bf16x8 bfr[4];
#pragma unroll
        for (int ks = 0; ks < 4; ++ks) { const LAS float* hp = h2 + pos * 64 + 16 * ks + 8 * kh; const f32x4 x0 = *(const LAS f32x4*)hp, x1 = *(const LAS f32x4*)(hp + 4);
            u32x4 w; w.x = pk_bf16(x0[0], x0[1]); w.y = pk_bf16(x0[2], x0[3]); w.z = pk_bf16(x1[0], x1[1]); w.w = pk_bf16(x1[2], x1[3]); bfr[ks] = __builtin_bit_cast(bf16x8, w); }
        const bool pv = pos < (isctx ? 16 : 32);
        const float tn = (float)(t0 + pos) / (float)(n - 1);
        float* hw = isctx ? WSP(float, WS_HWTC) : WSP(float, WS_HWT);
        float* spart = WSP(float, WS_SPART) + (size_t)pt * 2048;
#pragma unroll 1
        for (int nt = 0; nt < 8; ++nt) {
            const int nb = c.wid * 256 + nt * 32;
            f32x16 acc;
#pragma unroll
            for (int r = 0; r < 16; ++r) acc[r] = 0.f;
            bf16x8 af[4];
#pragma unroll
            for (int ks = 0; ks < 4; ++ks) af[ks] = *(const bf16x8*)(w3t + (size_t)(nb + pos) * 64 + 16 * ks + 8 * kh);
#pragma unroll
            for (int ks = 0; ks < 4; ++ks) acc = __builtin_amdgcn_mfma_f32_32x32x16_bf16(af[ks], bfr[ks], acc, 0, 0, 0);
#pragma unroll
            for (int r = 0; r < 16; ++r) {
                const int chn = nb + (r & 3) + 8 * (r >> 2) + 4 * kh;
                const float delta = fabsf(-15.350567286626973f + (float)(chn & 511) * ((-3.0701134573253946f + 15.350567286626973f) / 511.0f));
                const float v = pv ? acc[r] * __expf(-tn * delta) : 0.f;
                if (pv) hw[(size_t)chn * n + t0 + pos] = v;
                float as = fabsf(v);
                as += __int_as_float(__builtin_amdgcn_update_dpp(0, __float_as_int(as), 0xB1, 0xf, 0xf, false));
                as += __int_as_float(__builtin_amdgcn_update_dpp(0, __float_as_int(as), 0x4E, 0xf, 0xf, false));
                as += __int_as_float(__builtin_amdgcn_update_dpp(0, __float_as_int(as), 0x141, 0xf, 0xf, false));
                as += __int_as_float(__builtin_amdgcn_update_dpp(0, __float_as_int(as), 0x140, 0xf, 0xf, false));
                as += __shfl_xor(as, 16);
                if (pos == 0) spart[chn] = as;
            }
        }
    }
    __syncthreads();
}
DI int PADX(int a) { return a + ((a >> 6) << 2); }
DI cf2 cadd(cf2 a, cf2 b) { return mk2(a.x + b.x, a.y + b.y); }
DI cf2 csub(cf2 a, cf2 b) { return mk2(a.x - b.x, a.y - b.y); }
template <bool INV> DI cf2 cmuli(cf2 d) { return INV ? mk2(-d.y, d.x) : mk2(d.y, -d.x); }
template <bool INV> DI cf2 cmulw(cf2 a, float wr, float wi) { return INV ? mk2(a.x * wr + a.y * wi, a.y * wr - a.x * wi) : mk2(a.x * wr - a.y * wi, a.x * wi + a.y * wr); }
template <bool INV> DI void dft4(cf2& a0, cf2& a1, cf2& a2, cf2& a3) {
    const cf2 s0 = cadd(a0, a2), s1 = csub(a0, a2), s2 = cadd(a1, a3), s3 = cmuli<INV>(csub(a1, a3));
    a0 = cadd(s0, s2); a1 = cadd(s1, s3); a2 = csub(s0, s2); a3 = csub(s1, s3);
}
template <bool INV> DI void dft16(cf2 (&x)[16]) {
#pragma unroll
    for (int b = 0; b < 4; ++b) dft4<INV>(x[b], x[4 + b], x[8 + b], x[12 + b]);
    constexpr float C1 = 0.9238795325112867f, S1 = 0.3826834323650898f, C2 = 0.7071067811865476f;
    x[4 + 1] = cmulw<INV>(x[4 + 1], C1, -S1); x[4 + 2] = cmulw<INV>(x[4 + 2], C2, -C2); x[4 + 3] = cmulw<INV>(x[4 + 3], S1, -C1);
    x[8 + 1] = cmulw<INV>(x[8 + 1], C2, -C2); x[8 + 2] = cmulw<INV>(x[8 + 2], 0.f, -1.f); x[8 + 3] = cmulw<INV>(x[8 + 3], -C2, -C2);
    x[12 + 1] = cmulw<INV>(x[12 + 1], S1, -C1); x[12 + 2] = cmulw<INV>(x[12 + 2], -C2, -C2); x[12 + 3] = cmulw<INV>(x[12 + 3], -C1, S1);
#pragma unroll
    for (int cc = 0; cc < 4; ++cc) dft4<INV>(x[4 * cc], x[4 * cc + 1], x[4 * cc + 2], x[4 * cc + 3]);
}
template <bool INV>
DI void fft_pass16(const Ctx& c, int llog) {
    LAS cf2* z = (LAS cf2*)c.lds;
    const LAS cf2* twlo = (const LAS cf2*)(c.lds + LDS_TW);
    const LAS cf2* twhi = twlo + 128;
    const int lq = llog - 4, q = 1 << lq;
#pragma unroll 1
    for (int i = 0; i < 2; ++i) {
        const int b = c.tid + i * 512, j = b & (q - 1), base = ((b >> lq) << llog) + j;
        const int tk = j << (14 - llog);
        const cf2 w1 = cmul(twhi[tk >> 7], twlo[tk & 127]);
        cf2 w[16]; w[1] = w1; w[2] = cmul(w1, w1); w[3] = cmul(w[2], w1); w[4] = cmul(w[2], w[2]); w[5] = cmul(w[4], w1); w[6] = cmul(w[3], w[3]); w[7] = cmul(w[4], w[3]);
        w[8] = cmul(w[4], w[4]); w[9] = cmul(w[8], w1); w[10] = cmul(w[5], w[5]); w[11] = cmul(w[8], w[3]); w[12] = cmul(w[6], w[6]); w[13] = cmul(w[12], w1); w[14] = cmul(w[7], w[7]); w[15] = cmul(w[8], w[7]);
        cf2 x[16];
#pragma unroll
        for (int m = 0; m < 16; ++m) x[m] = z[PADX(base + m * q)];
        if (INV) {
#pragma unroll
            for (int r = 1; r < 16; ++r) x[r] = cmulc(x[r], w[r]);
        }
        dft16<INV>(x);
#pragma unroll
        for (int cc = 0; cc < 4; ++cc)
#pragma unroll
            for (int d = 0; d < 4; ++d) { const int r = cc + 4 * d; cf2 v = x[4 * cc + d]; if (!INV && r > 0) v = cmul(v, w[r]); z[PADX(base + r * q)] = v; }
    }
    __syncthreads();
}
template <bool INV>
DI void fft_pass4(const Ctx& c) {
    LAS cf2* z = (LAS cf2*)c.lds;
#pragma unroll 2
    for (int i = 0; i < 8; ++i) { const int b = c.tid + i * 512; LAS f32x4* p = (LAS f32x4*)(z + PADX(4 * b));
        const f32x4 u = p[0], v = p[1]; cf2 a0 = mk2(u[0], u[1]), a1 = mk2(u[2], u[3]), a2 = mk2(v[0], v[1]), a3 = mk2(v[2], v[3]);
        dft4<INV>(a0, a1, a2, a3);
        p[0] = (f32x4){a0.x, a0.y, a1.x, a1.y}; p[1] = (f32x4){a2.x, a2.y, a3.x, a3.y}; }
    __syncthreads();
}
template <bool INV>
DI void fft16k(const Ctx& c) {
    if (!INV) { fft_pass16<false>(c, 14); fft_pass16<false>(c, 10); fft_pass16<false>(c, 6); fft_pass4<false>(c); }
    else { fft_pass4<true>(c); fft_pass16<true>(c, 6); fft_pass16<true>(c, 10); fft_pass16<true>(c, 14); }
}
DI void tw_init(const Ctx& c) {
    LAS cf2* twlo = (LAS cf2*)(c.lds + LDS_TW);
    if (c.tid < 256) { const int k = c.tid < 128 ? c.tid : (c.tid - 128) * 128; float s, co; sincospif(-(float)k * (1.0f / 8192.0f), &s, &co); twlo[c.tid] = mk2(co, s); }
}
DI unsigned pk_f16(float a, float b) { typedef _Float16 h2 __attribute__((ext_vector_type(2))); h2 v; v.x = (_Float16)a; v.y = (_Float16)b; return __builtin_bit_cast(unsigned, v); }
DI cf2 unpk_f16(unsigned u) { typedef _Float16 h2 __attribute__((ext_vector_type(2))); const h2 v = __builtin_bit_cast(h2, u); return mk2((float)v.x, (float)v.y); }

DI void hy_spec_item(const Ctx& c_, int o, int cch) {
    Ctx c = c_; asm volatile("" : "+v"(c.tid)); c.lane = c.tid & 63;
    LAS cf2* z = (LAS cf2*)c.lds;
    LAS float* red = (LAS float*)(c.lds + LDS_BARW + 64);
    const float* sp = WSP(float, WS_SPART);
    const float* hf = WSP(float, WS_HWT) + (size_t)(o * 1024 + cch) * 8192;
    const float* hb = WSP(float, WS_HWT) + (size_t)(o * 1024 + 512 + cch) * 8192;
    float hfv[16], hbv[16];
#pragma unroll
    for (int i = 0; i < 16; ++i) { const int p = c.tid + i * 512; hfv[i] = hf[p]; hbv[i] = hb[p == 0 ? 0 : 8192 - p]; }
    float s = 0.f;
    if (c.tid < 256) s = sp[(size_t)c.tid * 2048 + o * 1024 + cch] + sp[(size_t)c.tid * 2048 + o * 1024 + 512 + cch];
#pragma unroll
    for (int of = 32; of; of >>= 1) s += __shfl_xor(s, of);
    if (c.lane == 0) red[c.wid] = s;
    __syncthreads();
    float tot = 0.f;
#pragma unroll
    for (int w = 0; w < 8; ++w) tot += red[w];
    const float sc = 1.0f / (tot + 1e-6f);
#pragma unroll
    for (int i = 0; i < 16; ++i) { const int p = c.tid + i * 512;
        float v = hfv[i]; if (p == 0) v += hbv[i];
        z[PADX(p)] = mk2(v * sc, 0.f);
        const int p2 = 8192 + p;
        z[PADX(p2)] = mk2(p == 0 ? 0.f : hbv[i] * sc, 0.f); }
    __syncthreads();
    fft16k<false>(c);
    unsigned* dst = WSP(unsigned, WS_SPEC) + (size_t)(o * 512 + cch) * 16384;
#pragma unroll 8
    for (int i = 0; i < 32; ++i) { const int p = c.tid + i * 512; const cf2 v = z[PADX(p)]; dst[p] = pk_f16(v.x, v.y); }
    __syncthreads();
}

DI void hy_spec_pair_item(const Ctx& c_, int o, int cp) {
    Ctx c = c_; asm volatile("" : "+v"(c.tid)); c.lane = c.tid & 63;
    LAS cf2* z = (LAS cf2*)c.lds;
    LAS float* red = (LAS float*)(c.lds + LDS_BARW + 64);
    const float* sp = WSP(float, WS_SPART);
    const int cA = cp, cB = cp + 256;
    const float* hfA = WSP(float, WS_HWT) + (size_t)(o * 1024 + cA) * 8192; const float* hbA = WSP(float, WS_HWT) + (size_t)(o * 1024 + 512 + cA) * 8192;
    const float* hfB = WSP(float, WS_HWT) + (size_t)(o * 1024 + cB) * 8192; const float* hbB = WSP(float, WS_HWT) + (size_t)(o * 1024 + 512 + cB) * 8192;
    float fa[16], ba[16], fb[16], bb[16];
#pragma unroll
    for (int i = 0; i < 16; ++i) { const int p = c.tid + i * 512, pr = p == 0 ? 0 : 8192 - p; fa[i] = hfA[p]; ba[i] = hbA[pr]; fb[i] = hfB[p]; bb[i] = hbB[pr]; }
    { const int t = c.tid & 255, cc = c.tid < 256 ? cA : cB;
      float s = sp[(size_t)t * 2048 + o * 1024 + cc] + sp[(size_t)t * 2048 + o * 1024 + 512 + cc];
#pragma unroll
      for (int of = 32; of; of >>= 1) s += __shfl_xor(s, of);
      if (c.lane == 0) red[c.wid] = s; }
    __syncthreads();
    const float scA = 1.0f / (red[0] + red[1] + red[2] + red[3] + 1e-6f), scB = 1.0f / (red[4] + red[5] + red[6] + red[7] + 1e-6f);
#pragma unroll
    for (int i = 0; i < 16; ++i) { const int p = c.tid + i * 512;
        float va = fa[i], vb = fb[i]; if (p == 0) { va += ba[i]; vb += bb[i]; }
        z[PADX(p)] = mk2(va * scA, vb * scB);
        z[PADX(8192 + p)] = mk2(p == 0 ? 0.f : ba[i] * scA, p == 0 ? 0.f : bb[i] * scB); }
    __syncthreads();
    fft16k<false>(c);
    unsigned* dA = WSP(unsigned, WS_SPEC) + (size_t)(o * 512 + cA) * 16384; unsigned* dB = WSP(unsigned, WS_SPEC) + (size_t)(o * 512 + cB) * 16384;
#pragma unroll 4
    for (int i = 0; i < 32; ++i) { const int p = c.tid + i * 512;
        const int k = (p >> 10) + 16 * ((p >> 6) & 15) + 256 * ((p >> 2) & 15) + 4096 * (p & 3), kn = (16384 - k) & 16383;
        const int pn = 1024 * (kn & 15) + 64 * ((kn >> 4) & 15) + 4 * ((kn >> 8) & 15) + (kn >> 12);
        const cf2 u = z[PADX(p)], w = z[PADX(pn)];
        dA[p] = pk_f16(0.5f * (u.x + w.x), 0.5f * (u.y - w.y)); dB[p] = pk_f16(0.5f * (u.y + w.y), 0.5f * (w.x - u.x)); }
    __syncthreads();
}

DI void load_conv16(const bf16_t* row, int t0, int n, float w0, float w1, float w2, float cb, float (&o)[16]) {
    asm volatile("" : "+v"(t0));
    const u32x4 a = *(const u32x4*)(row + t0), b = *(const u32x4*)(row + t0 + 8);
    float x[18];
    x[0] = t0 > 0 ? bf2f(row[t0 - 1]) : 0.f; x[17] = t0 + 16 < n ? bf2f(row[t0 + 16]) : 0.f;
    x[1] = bflo(a.x); x[2] = bfhi(a.x); x[3] = bflo(a.y); x[4] = bfhi(a.y); x[5] = bflo(a.z); x[6] = bfhi(a.z); x[7] = bflo(a.w); x[8] = bfhi(a.w);
    x[9] = bflo(b.x); x[10] = bfhi(b.x); x[11] = bflo(b.y); x[12] = bfhi(b.y); x[13] = bflo(b.z); x[14] = bfhi(b.z); x[15] = bflo(b.w); x[16] = bfhi(b.w);
#pragma unroll
    for (int i = 0; i < 16; ++i) o[i] = cb + w0 * x[i] + w1 * x[i + 1] + w2 * x[i + 2];
}
struct RawRow { u32x4 a, b; bf16_t hm, hp; };
DI RawRow load_raw16(const bf16_t* row, int t0, int n) { RawRow r; r.a = *(const u32x4*)(row + t0); r.b = *(const u32x4*)(row + t0 + 8); r.hm = t0 > 0 ? row[t0 - 1] : (bf16_t)0; r.hp = t0 + 16 < n ? row[t0 + 16] : (bf16_t)0; return r; }
DI void conv_raw16(const RawRow& r, float w0, float w1, float w2, float cb, float (&o)[16]) {
    float x[18]; const u32x4 a = r.a, b = r.b;
    x[0] = bf2f(r.hm); x[17] = bf2f(r.hp);
    x[1] = bflo(a.x); x[2] = bfhi(a.x); x[3] = bflo(a.y); x[4] = bfhi(a.y); x[5] = bflo(a.z); x[6] = bfhi(a.z); x[7] = bflo(a.w); x[8] = bfhi(a.w);
    x[9] = bflo(b.x); x[10] = bfhi(b.x); x[11] = bflo(b.y); x[12] = bfhi(b.y); x[13] = bflo(b.z); x[14] = bfhi(b.z); x[15] = bflo(b.w); x[16] = bfhi(b.w);
#pragma unroll
    for (int i = 0; i < 16; ++i) o[i] = cb + w0 * x[i] + w1 * x[i + 1] + w2 * x[i + 2];
}
DI void spec_mul(const Ctx& c, const unsigned* spec) {
    LAS cf2* z = (LAS cf2*)c.lds;
#pragma unroll 1
    for (int hb = 0; hb < 4; ++hb) {
        unsigned sw[8];
#pragma unroll
        for (int i = 0; i < 8; ++i) sw[i] = spec[c.tid + (hb * 8 + i) * 512];
        asm volatile("" : "+v"(sw[0]), "+v"(sw[1]), "+v"(sw[2]), "+v"(sw[3]), "+v"(sw[4]), "+v"(sw[5]), "+v"(sw[6]), "+v"(sw[7]));
#pragma unroll
        for (int i = 0; i < 8; ++i) { const int p = c.tid + (hb * 8 + i) * 512; const cf2 hs = unpk_f16(sw[i]); z[PADX(p)] = cmul(z[PADX(p)], mk2(hs.x * (1.0f / 16384.0f), hs.y * (1.0f / 16384.0f))); }
    }
    __syncthreads();
}
DI void fft_mid_spec(const Ctx& c, const unsigned* spec) {
    LAS cf2* z = (LAS cf2*)c.lds;
    u32x4 sw[8];
#pragma unroll
    for (int i = 0; i < 8; ++i) sw[i] = *(const u32x4*)(spec + 4 * (c.tid + i * 512));
    asm volatile("" : "+v"(sw[0]), "+v"(sw[1]), "+v"(sw[2]), "+v"(sw[3]), "+v"(sw[4]), "+v"(sw[5]), "+v"(sw[6]), "+v"(sw[7]));
#pragma unroll 2
    for (int i = 0; i < 8; ++i) { const int b = c.tid + i * 512; LAS f32x4* p = (LAS f32x4*)(z + PADX(4 * b));
        const f32x4 u = p[0], v = p[1]; cf2 a0 = mk2(u[0], u[1]), a1 = mk2(u[2], u[3]), a2 = mk2(v[0], v[1]), a3 = mk2(v[2], v[3]);
        dft4<false>(a0, a1, a2, a3);
        { const cf2 h0 = unpk_f16(sw[i].x), h1 = unpk_f16(sw[i].y), h2 = unpk_f16(sw[i].z), h3 = unpk_f16(sw[i].w); constexpr float S = 1.0f / 16384.0f;
          a0 = cmul(a0, mk2(h0.x * S, h0.y * S)); a1 = cmul(a1, mk2(h1.x * S, h1.y * S)); a2 = cmul(a2, mk2(h2.x * S, h2.y * S)); a3 = cmul(a3, mk2(h3.x * S, h3.y * S)); }
        dft4<true>(a0, a1, a2, a3);
        p[0] = (f32x4){a0.x, a0.y, a1.x, a1.y}; p[1] = (f32x4){a2.x, a2.y, a3.x, a3.y}; }
    __syncthreads();
}
DI void hy_lat_item(const Ctx& c_, int l, int bp, int cch) {
    Ctx c = c_; asm volatile("" : "+v"(c.tid)); c.lane = c.tid & 63;
    LAS cf2* z = (LAS cf2*)c.lds;
    const float* cw = c.in[9] + (size_t)l * 3 * 1536; const float* cbv = c.in[10] + (size_t)l * 1536; const float* skip = c.in[17] + (size_t)l * 2 * 512;
    const bf16_t* hyt = WSP(bf16_t, WS_HYT);
    const int t0 = c.tid * 16, pt0 = PADX(t0);
    const bf16_t* r0 = hyt + ((size_t)(2 * bp) * 1536) * 8192; const bf16_t* r1 = hyt + ((size_t)(2 * bp + 1) * 1536) * 8192;
    float a0[16], a1[16];
    { const int ch = cch; load_conv16(r0 + (size_t)ch * 8192, t0, 8192, cw[ch], cw[1536 + ch], cw[3072 + ch], cbv[ch], a0);
      load_conv16(r1 + (size_t)ch * 8192, t0, 8192, cw[ch], cw[1536 + ch], cw[3072 + ch], cbv[ch], a1); }
    const int pt1 = PADX(8192 + t0);
#pragma unroll 1
    for (int rd = 0; rd < 2; ++rd) {
        const int ch = 512 * (rd + 1) + cch;
#pragma unroll
        for (int i = 0; i < 16; ++i) { z[pt0 + i] = mk2(a0[i], a1[i]); z[pt1 + i] = mk2(0.f, 0.f); }
        const RawRow rx0 = load_raw16(r0 + (size_t)ch * 8192, t0, 8192), rx1 = load_raw16(r1 + (size_t)ch * 8192, t0, 8192);
        __syncthreads();
        fft_pass16<false>(c, 14); fft_pass16<false>(c, 10); fft_pass16<false>(c, 6);
        fft_mid_spec(c, WSP(unsigned, WS_SPEC) + (size_t)(rd * 512 + cch) * 16384);
        fft_pass16<true>(c, 6); fft_pass16<true>(c, 10); fft_pass16<true>(c, 14);
        float b0[16], b1[16];
        conv_raw16(rx0, cw[ch], cw[1536 + ch], cw[3072 + ch], cbv[ch], b0); conv_raw16(rx1, cw[ch], cw[1536 + ch], cw[3072 + ch], cbv[ch], b1);
        const float sk = skip[rd * 512 + cch];
#pragma unroll
        for (int i = 0; i < 16; ++i) { const cf2 y = z[pt0 + i]; a0[i] = b0[i] * (y.x + sk * a0[i]); a1[i] = b1[i] * (y.y + sk * a1[i]); }
    }
    bf16_t* yo0 = WSP(bf16_t, WS_YHT) + ((size_t)(2 * bp) * 512 + cch) * 8192 + t0; bf16_t* yo1 = WSP(bf16_t, WS_YHT) + ((size_t)(2 * bp + 1) * 512 + cch) * 8192 + t0;
    { u32x4 w; w.x = pk_bf16(a0[0], a0[1]); w.y = pk_bf16(a0[2], a0[3]); w.z = pk_bf16(a0[4], a0[5]); w.w = pk_bf16(a0[6], a0[7]); *(u32x4*)yo0 = w;
      w.x = pk_bf16(a0[8], a0[9]); w.y = pk_bf16(a0[10], a0[11]); w.z = pk_bf16(a0[12], a0[13]); w.w = pk_bf16(a0[14], a0[15]); *(u32x4*)(yo0 + 8) = w;
      w.x = pk_bf16(a1[0], a1[1]); w.y = pk_bf16(a1[2], a1[3]); w.z = pk_bf16(a1[4], a1[5]); w.w = pk_bf16(a1[6], a1[7]); *(u32x4*)yo1 = w;
      w.x = pk_bf16(a1[8], a1[9]); w.y = pk_bf16(a1[10], a1[11]); w.z = pk_bf16(a1[12], a1[13]); w.w = pk_bf16(a1[14], a1[15]); *(u32x4*)(yo1 + 8) = w; }
    __syncthreads();
}
DI void hy_ctx_item(const Ctx& c_, int l, int b, int cch) {
    Ctx c = c_; asm volatile("" : "+v"(c.lane));
    LAS float* wl = (LAS float*)(c.lds + c.wid * 8192);
    LAS float* tp1 = wl; LAS float* tp2 = wl + 512; LAS float* vv = wl + 1024; LAS float* zz = wl + 1280;
    const float* sp = WSP(float, WS_SPART); const float* hw = WSP(float, WS_HWTC);
    float sc[2];
#pragma unroll
    for (int o = 0; o < 2; ++o) { float s = 0.f; if (c.lane < 16) s = sp[(size_t)(256 + c.lane) * 2048 + o * 1024 + cch] + sp[(size_t)(256 + c.lane) * 2048 + o * 1024 + 512 + cch];
#pragma unroll
        for (int of = 8; of; of >>= 1) s += __shfl_xor(s, of);
        sc[o] = 1.0f / (__shfl(s, 0) + 1e-6f); }
#pragma unroll
    for (int o = 0; o < 2; ++o) { LAS float* tp = o ? tp2 : tp1; const float* hf = hw + (size_t)(o * 1024 + cch) * 256; const float* hb = hw + (size_t)(o * 1024 + 512 + cch) * 256;
        for (int i = c.lane; i < 511; i += 64) { const int d = i - 255; float v = d > 0 ? hf[d] : (d < 0 ? hb[-d] : hf[0] + hb[0]); tp[i] = v * sc[o]; } }
    const float* cw = c.in[9] + (size_t)l * 3 * 1536; const float* cbv = c.in[10] + (size_t)l * 1536; const float* skip = c.in[17] + (size_t)l * 2 * 512;
    const bf16_t* base = WSP(bf16_t, WS_HYTC) + (size_t)b * 1536 * 256;
    float xv[3][4];
#pragma unroll 1
    for (int g = 0; g < 3; ++g) { const int ch = g * 512 + cch; const bf16_t* r = base + (size_t)ch * 256; const float w0 = cw[ch], w1 = cw[1536 + ch], w2 = cw[3072 + ch], cb = cbv[ch];
        unsigned xr[12];
#pragma unroll
        for (int i = 0; i < 4; ++i) { const int t = c.lane + 64 * i; xr[3 * i] = r[t > 0 ? t - 1 : 0]; xr[3 * i + 1] = r[t]; xr[3 * i + 2] = r[t < 255 ? t + 1 : 255]; }
        asm volatile("" : "+v"(xr[0]), "+v"(xr[1]), "+v"(xr[2]), "+v"(xr[3]), "+v"(xr[4]), "+v"(xr[5]), "+v"(xr[6]), "+v"(xr[7]), "+v"(xr[8]), "+v"(xr[9]), "+v"(xr[10]), "+v"(xr[11]));
        float xg[4];
#pragma unroll
        for (int i = 0; i < 4; ++i) { const int t = c.lane + 64 * i; const float xm = t > 0 ? bf2f((bf16_t)xr[3 * i]) : 0.f, x0 = bf2f((bf16_t)xr[3 * i + 1]), xp = t < 255 ? bf2f((bf16_t)xr[3 * i + 2]) : 0.f; xg[i] = cb + w0 * xm + w1 * x0 + w2 * xp; }
#pragma unroll
        for (int i = 0; i < 4; ++i) { if (g == 0) xv[0][i] = xg[i]; else if (g == 1) xv[1][i] = xg[i]; else xv[2][i] = xg[i]; } }
#pragma unroll
    for (int i = 0; i < 4; ++i) vv[c.lane + 64 * i] = xv[0][i];
    LDS_FENCE();
    const float sk1 = skip[cch], sk2 = skip[512 + cch];
    float y[4]; const int lane = c.lane;
    { float s0 = 0.f, s1 = 0.f, s2 = 0.f, s3 = 0.f; const LAS float* t1 = tp1 + lane + 255;
#pragma unroll 4
      for (int k = 0; k < 256; k += 4) { const f32x4 v4 = *(const LAS f32x4*)(vv + k);
#pragma unroll
          for (int j = 0; j < 4; ++j) { const float vk = v4[j]; s0 += t1[-(k + j)] * vk; s1 += t1[64 - (k + j)] * vk; s2 += t1[128 - (k + j)] * vk; s3 += t1[192 - (k + j)] * vk; } }
      y[0] = xv[1][0] * (s0 + sk1 * xv[0][0]); y[1] = xv[1][1] * (s1 + sk1 * xv[0][1]); y[2] = xv[1][2] * (s2 + sk1 * xv[0][2]); y[3] = xv[1][3] * (s3 + sk1 * xv[0][3]); }
#pragma unroll
    for (int i = 0; i < 4; ++i) zz[lane + 64 * i] = y[i];
    LDS_FENCE();
    bf16_t* yo = WSP(bf16_t, WS_YHY) + (size_t)(NLAT + b * 256) * 512 + cch;
    { float s0 = 0.f, s1 = 0.f, s2 = 0.f, s3 = 0.f; const LAS float* t2 = tp2 + lane + 255;
#pragma unroll 4
      for (int k = 0; k < 256; k += 4) { const f32x4 v4 = *(const LAS f32x4*)(zz + k);
#pragma unroll
          for (int j = 0; j < 4; ++j) { const float vk = v4[j]; s0 += t2[-(k + j)] * vk; s1 += t2[64 - (k + j)] * vk; s2 += t2[128 - (k + j)] * vk; s3 += t2[192 - (k + j)] * vk; } }
      const float sv[4] = {s0, s1, s2, s3};
#pragma unroll
      for (int i = 0; i < 4; ++i) { const int t = lane + 64 * i; yo[(size_t)t * 512] = (ABL & 1) ? (bf16_t)0 : f2bf(xv[2][i] * (sv[i] + sk2 * y[i])); } }
    LDS_FENCE();
}
DI void yhy_tr_tile2(const Ctx& c_, int pair) {
    Ctx c = c_; asm volatile("" : "+v"(c.tid));
    LAS bf16_t* t = (LAS bf16_t*)c.lds;
    u32x4 a[2];
#pragma unroll
    for (int k = 0; k < 2; ++k) { const int it = pair * 2 + k, b = it >> 10, c0 = ((it >> 7) & 7) * 64, t0 = (it & 127) * 64; const int ch = c.tid >> 3, tq = (c.tid & 7) * 8;
        a[k] = *(const u32x4*)(WSP(bf16_t, WS_YHT) + ((size_t)b * 512 + c0 + ch) * 8192 + t0 + tq); }
#pragma unroll
    for (int k = 0; k < 2; ++k) { const int ch = c.tid >> 3, tq = (c.tid & 7) * 8; LAS unsigned* d = (LAS unsigned*)(t + k * 64 * 66 + ch * 66 + tq); d[0] = a[k].x; d[1] = a[k].y; d[2] = a[k].z; d[3] = a[k].w; }
    __syncthreads();
#pragma unroll
    for (int k = 0; k < 2; ++k) { const int it = pair * 2 + k, b = it >> 10, c0 = ((it >> 7) & 7) * 64, t0 = (it & 127) * 64; const int tk = c.tid >> 3, cq = (c.tid & 7) * 8; bf16_t v[8];
#pragma unroll
        for (int j = 0; j < 8; ++j) v[j] = t[k * 64 * 66 + (cq + j) * 66 + tk];
        u32x4 w; w.x = v[0] | ((unsigned)v[1] << 16); w.y = v[2] | ((unsigned)v[3] << 16); w.z = v[4] | ((unsigned)v[5] << 16); w.w = v[6] | ((unsigned)v[7] << 16);
        if (ABL & 1) w = (u32x4){0u, 0u, 0u, 0u};
        *(u32x4*)(WSP(bf16_t, WS_YHY) + (size_t)(b * 8192 + t0 + tk) * 512 + c0 + cq) = w; }
    __syncthreads();
}
template <bool FINAL, int D>
DI void rg_dir(const Ctx& c, int l, int b, int chunk) {
    int lane = c.lane; asm volatile("" : "+v"(lane));
    const int g = c.wid, ch = g * 64 + lane, fr = lane & 15, fq = lane >> 4;
    LAS unsigned char* wl = c.lds + c.wid * 16384;
    LAS bf16_t* xcs = (LAS bf16_t*)wl;
    LAS cf2* stg = (LAS cf2*)(wl + 2304);
    const bool isctx = chunk < 4;
    const int rowbase = isctx ? NLAT + b * 256 : b * 8192, seglen = isctx ? 256 : 8192, tbase = isctx ? chunk * 64 : (chunk - 4) * 64;
    const bf16_t* P2 = WSP(bf16_t, WS_P2);
    const int pd = (l * 2 + D) * 512 + ch;
    const float* cwp = c.in[18] + (size_t)(l * 2 + D) * 4 * 512 + ch;
    const float cw0 = cwp[0], cw1 = cwp[512], cw2 = cwp[1024], cw3 = cwp[1536], cb = c.in[19][pd], ba = c.in[21][pd], bx = c.in[23][pd];
    const float lam = c.in[24][pd]; const float cneg = -8.0f * log1pf(expf(-lam));
    bf16x8 wa[4][2], wx[4][2];
    { const bf16_t* wb = WSP(bf16_t, WS_RGW) + (size_t)((D * 2 + 0) * 8 + g) * 4096; const bf16_t* xb = WSP(bf16_t, WS_RGW) + (size_t)((D * 2 + 1) * 8 + g) * 4096;
#pragma unroll
      for (int nt = 0; nt < 4; ++nt)
#pragma unroll
          for (int ks = 0; ks < 2; ++ks) { wa[nt][ks] = *(const bf16x8*)(wb + (nt * 16 + fr) * 64 + fq * 8 + 32 * ks); wx[nt][ks] = *(const bf16x8*)(xb + (nt * 16 + fr) * 64 + fq * 8 + 32 * ks); } }
    float h = 0.f, Aagg = 1.f, Bagg = 0.f;
    if (FINAL) h = WSP(float, WS_RGCAR)[(size_t)((b * 2 + D) * NCHK + chunk) * 512 + ch];
    float* HF = WSP(float, WS_HF);
    float um3, um2, um1;
    { const int t3 = tbase + (D ? 66 : -3), t2 = tbase + (D ? 65 : -2), t1 = tbase + (D ? 64 : -1);
      um3 = (t3 >= 0 && t3 < seglen) ? bf2f(P2[(size_t)(rowbase + t3) * P2W + PC_RGX + ch]) : 0.f;
      um2 = (t2 >= 0 && t2 < seglen) ? bf2f(P2[(size_t)(rowbase + t2) * P2W + PC_RGX + ch]) : 0.f;
      um1 = (t1 >= 0 && t1 < seglen) ? bf2f(P2[(size_t)(rowbase + t1) * P2W + PC_RGX + ch]) : 0.f; }
    bf16_t uall[64];
#pragma unroll
    for (int s = 0; s < 64; ++s) { const int tok = tbase + (D ? 63 - s : s); uall[s] = P2[(size_t)(rowbase + tok) * P2W + PC_RGX + ch]; }
    asm volatile("" ::: "memory");
#pragma unroll
    for (int mt = 0; mt < 4; ++mt) {
        bf16_t uc[16], gc[16]; float hc[16];
#pragma unroll
        for (int q = 0; q < 16; ++q) { uc[q] = uall[mt * 16 + q]; gc[q] = 0; hc[q] = 0.f; }
        float xcf[16];
#pragma unroll
        for (int q = 0; q < 16; ++q) {
            const float u0 = bf2f(uc[q]);
            const float xc = cb + cw0 * um3 + cw1 * um2 + cw2 * um1 + cw3 * u0;
            xcf[q] = xc; xcs[q * 72 + lane] = f2bf(xc); um3 = um2; um2 = um1; um1 = u0; }
        LDS_FENCE();
        bf16x8 af[2];
#pragma unroll
        for (int ks = 0; ks < 2; ++ks) af[ks] = *(const LAS bf16x8*)(xcs + fr * 72 + fq * 8 + 32 * ks);
        f32x4 ar[4], ai[4];
#pragma unroll
        for (int nt = 0; nt < 4; ++nt) { ar[nt] = (f32x4){0.f, 0.f, 0.f, 0.f}; ai[nt] = (f32x4){0.f, 0.f, 0.f, 0.f};
#pragma unroll
            for (int ks = 0; ks < 2; ++ks) { ar[nt] = __builtin_amdgcn_mfma_f32_16x16x32_bf16(af[ks], wa[nt][ks], ar[nt], 0, 0, 0); ai[nt] = __builtin_amdgcn_mfma_f32_16x16x32_bf16(af[ks], wx[nt][ks], ai[nt], 0, 0, 0); } }
#pragma unroll
        for (int nt = 0; nt < 4; ++nt)
#pragma unroll
            for (int jj = 0; jj < 4; ++jj) stg[(fq * 4 + jj) * 64 + nt * 16 + fr] = mk2(ar[nt][jj], ai[nt][jj]);
        LDS_FENCE();
#pragma unroll
        for (int q = 0; q < 16; ++q) { const int s = mt * 16 + q, tokl = D ? 63 - s : s;
            const cf2 pre = stg[q * 64 + lane];
            const float r = sigmoidf_(pre.x + ba), ii = sigmoidf_(pre.y + bx);
            const float a = __expf(r * cneg);
            const float bb = sqrtf(fmaxf(1.0f - a * a, 0.f)) * ii * xcf[q];
            if (FINAL) { h = a * h + bb;
                const size_t row = (size_t)(rowbase + tbase + tokl);
                if (D == 0) HF[row * 512 + ch] = h;
                else WSP(bf16_t, WS_YRG)[row * 512 + ch] = (ABL & 2) ? (bf16_t)0 : f2bf((hc[q] + h) * geluf_(bf2f(gc[q]))); }
            else { const unsigned w = pk_bf16(r * cneg, bb);
                WSP(unsigned, WS_RGAB)[((size_t)(rowbase + tbase + tokl) * 2 + D) * 512 + ch] = w;
                const float a2 = __expf(bflo(w)), b2 = bfhi(w); Bagg = a2 * Bagg + b2; Aagg *= a2; } }
        LDS_FENCE();
    }
    if (!FINAL) WSP(cf2, WS_RGAGG)[(size_t)((b * 2 + D) * NCHK + chunk) * 512 + ch] = mk2(Aagg, Bagg);
}
template <bool FINAL>
DI void rg_item(const Ctx& c, int l, int item) {
    const int b = item / NCHK, chunk = item % NCHK;
    rg_dir<FINAL, 0>(c, l, b, chunk);
    rg_dir<FINAL, 1>(c, l, b, chunk);
}
DI void rg_c_item(const Ctx& c, int item) {
    int lane = c.lane; asm volatile("" : "+v"(lane));
    const int b = item / NCHK, chunk = item % NCHK, ch = c.wid * 64 + lane;
    LAS float* hb = (LAS float*)(c.lds + c.wid * 16384) + lane;
    const bool isctx = chunk < 4;
    const size_t r0 = (size_t)(isctx ? NLAT + b * 256 + chunk * 64 : b * 8192 + (chunk - 4) * 64);
    const unsigned* AB = WSP(unsigned, WS_RGAB) + ch; const bf16_t* GP = WSP(bf16_t, WS_P2) + PC_RGG + ch; bf16_t* YP = WSP(bf16_t, WS_YRG) + ch;
    const float* car = WSP(float, WS_RGCAR) + ch;
    {
        float h = car[(size_t)((b * 2 + 1) * NCHK + chunk) * 512];
        unsigned w[64];
#pragma unroll
        for (int q = 0; q < 64; ++q) w[q] = AB[((r0 + q) * 2 + 1) * 512];
        asm volatile("" ::: "memory");
#pragma unroll
        for (int s2 = 0; s2 < 64; ++s2) { const int tok = 63 - s2; h = __builtin_fmaf(__expf(bflo(w[tok])), h, bfhi(w[tok])); hb[tok * 64] = h; }
    }
    {
        float h = car[(size_t)((b * 2 + 0) * NCHK + chunk) * 512];
        unsigned w[64]; bf16_t g[64];
#pragma unroll
        for (int q = 0; q < 64; ++q) { w[q] = AB[((r0 + q) * 2 + 0) * 512]; g[q] = GP[(r0 + q) * P2W]; }
        asm volatile("" ::: "memory");
#pragma unroll
        for (int tok = 0; tok < 64; ++tok) { h = __builtin_fmaf(__expf(bflo(w[tok])), h, bfhi(w[tok]));
            YP[(r0 + tok) * 512] = (ABL & 2) ? (bf16_t)0 : f2bf((h + hb[tok * 64]) * geluf_(bf2f(g[tok]))); }
    }
}
DI int scan_order(int d, int i) { return d == 0 ? i : (i < 4 ? 3 - i : 135 - i); }
DI void rg_carry_scan(const Ctx& c) {
    for (int idx = c.bid * 512 + c.tid; idx < 4096; idx += c.G * 512) {
    const int bd = idx >> 9, ch = idx & 511, d = bd & 1;
    const cf2* agg = WSP(cf2, WS_RGAGG) + (size_t)bd * NCHK * 512 + ch; float* car = WSP(float, WS_RGCAR) + (size_t)bd * NCHK * 512 + ch;
    float cv = 0.f;
#pragma unroll 1
    for (int i0 = 0; i0 < NCHK; i0 += 12) {
        cf2 ab[12];
#pragma unroll
        for (int u = 0; u < 12; ++u) ab[u] = agg[(size_t)scan_order(d, i0 + u) * 512];
        asm volatile("" ::: "memory");
#pragma unroll
        for (int u = 0; u < 12; ++u) { car[(size_t)scan_order(d, i0 + u) * 512] = cv; cv = ab[u].x * cv + ab[u].y; }
    }
    }
}

DI int gla_row(int b, int chunk, int i) {
    if (chunk < 4) return NLAT + b * 256 + chunk * 64 + i;
    const int jl = chunk - 4; return b * 8192 + ((jl & 1) * 64 + i) * 64 + (jl >> 1);
}
DI void gla_a_item(const Ctx& c, int item) {
    const int h = item & 3, bc = item >> 2, b = bc / NCHK, chunk = bc % NCHK;
    int lane = c.lane; asm volatile("" : "+v"(lane));
    const int fr = lane & 15, fq = lane >> 4, tid = c.wid * 64 + lane;
    LAS bf16_t* vT = (LAS bf16_t*)c.lds;
    LAS bf16_t* kdT = vT + 128 * 68;
    const bf16_t* P2 = WSP(bf16_t, WS_P2);
    { const int s = tid >> 3, ec = (tid & 7) * 16; const bf16_t* vp = P2 + (size_t)gla_row(b, chunk, s) * P2W + PC_V + h * 128 + ec;
      const u32x4 a = *(const u32x4*)vp, bq = *(const u32x4*)(vp + 8);
      const unsigned w[8] = {a.x, a.y, a.z, a.w, bq.x, bq.y, bq.z, bq.w};
#pragma unroll
      for (int j = 0; j < 8; ++j) { vT[(ec + 2 * j) * 68 + s] = (bf16_t)(w[j] & 0xffffu); vT[(ec + 2 * j + 1) * 68 + s] = (bf16_t)(w[j] >> 16); } }
    {
        const int d = c.wid >> 2, qt = c.wid & 3, dk = lane;
        unsigned short lar[64]; unsigned short kr[16];
#pragma unroll
        for (int i = 0; i < 64; ++i) lar[i] = P2[(size_t)gla_row(b, chunk, i) * P2W + (d ? PC_LAB : PC_LAF) + h * 64 + dk];
#pragma unroll
        for (int j = 0; j < 16; ++j) kr[j] = P2[(size_t)gla_row(b, chunk, qt * 16 + j) * P2W + PC_K + h * 64 + dk];
        asm volatile("" ::: "memory");
        float tot = 0.f, before = 0.f;
#pragma unroll
        for (int i = 0; i < 64; ++i) { const float v = bf2f(lar[i]); tot += v; if (i < qt * 16) before += v; }
        LAS bf16_t* kd = kdT + d * 64 * 68 + dk * 68;
        if (d == 0) { float rem = tot - before;
#pragma unroll
            for (int q4 = 0; q4 < 4; ++q4) if (q4 == qt) {
#pragma unroll
                for (int j = 0; j < 16; ++j) { const int i = q4 * 16 + j; rem -= bf2f(lar[i]); kd[i] = f2bf(bf2f(kr[j]) * __expf(rem)); } }
        } else { float pre = before;
#pragma unroll
            for (int q4 = 0; q4 < 4; ++q4) if (q4 == qt) {
#pragma unroll
                for (int j = 0; j < 16; ++j) { const int i = q4 * 16 + j; kd[i] = f2bf(bf2f(kr[j]) * __expf(pre)); pre += bf2f(lar[i]); } }
        }
        if (qt == 0) WSP(float, WS_GDEC)[(size_t)((((b * 4 + h) * 2 + d) * NCHK) + chunk) * 64 + dk] = __expf(tot);
    }
    __syncthreads();
    {
        const int d = c.wid >> 2, eq = c.wid & 3;
        f32x4 acc[2][4];
#pragma unroll
        for (int et = 0; et < 2; ++et)
#pragma unroll
            for (int dt = 0; dt < 4; ++dt) acc[et][dt] = (f32x4){0.f, 0.f, 0.f, 0.f};
#pragma unroll
        for (int ks = 0; ks < 2; ++ks) {
            bf16x8 af[2], bfr[4];
#pragma unroll
            for (int et = 0; et < 2; ++et) { const LAS u32x2* p = (const LAS u32x2*)(vT + ((eq * 2 + et) * 16 + fr) * 68 + fq * 8 + 32 * ks); const u32x2 lo = p[0], hi = p[1]; u32x4 w = {lo.x, lo.y, hi.x, hi.y}; af[et] = __builtin_bit_cast(bf16x8, w); }
#pragma unroll
            for (int dt = 0; dt < 4; ++dt) { const LAS u32x2* p = (const LAS u32x2*)(kdT + d * 64 * 68 + (dt * 16 + fr) * 68 + fq * 8 + 32 * ks); const u32x2 lo = p[0], hi = p[1]; u32x4 w = {lo.x, lo.y, hi.x, hi.y}; bfr[dt] = __builtin_bit_cast(bf16x8, w); }
#pragma unroll
            for (int et = 0; et < 2; ++et)
#pragma unroll
                for (int dt = 0; dt < 4; ++dt) acc[et][dt] = __builtin_amdgcn_mfma_f32_16x16x32_bf16(af[et], bfr[dt], acc[et][dt], 0, 0, 0);
        }
        float* st = WSP(float, WS_GST) + (size_t)((((b * 4 + h) * 2 + d) * NCHK) + chunk) * 8192;
#pragma unroll
        for (int et = 0; et < 2; ++et)
#pragma unroll
            for (int dt = 0; dt < 4; ++dt)
#pragma unroll
                for (int jj = 0; jj < 4; ++jj) st[((eq * 2 + et) * 16 + fq * 4 + jj) * 64 + dt * 16 + fr] = acc[et][dt][jj];
    }
    __syncthreads();
}
DI void gla_state_scan(const Ctx& c) {
    for (int idx = c.bid * 512 + c.tid; idx < 131072; idx += c.G * 512) {
    const int chain = idx >> 12, e2 = idx & 4095, d = chain & 1, dk2 = (e2 & 31) * 2;
    cf2* st = (cf2*)(WSP(float, WS_GST) + (size_t)chain * NCHK * 8192) + e2;
    const cf2* dc = (const cf2*)(WSP(float, WS_GDEC) + (size_t)chain * NCHK * 64 + dk2);
    cf2 S = mk2(0.f, 0.f);
#pragma unroll 1
    for (int i0 = 0; i0 < NCHK; i0 += 4) {
        cf2 ds[4], de[4];
#pragma unroll
        for (int u = 0; u < 4; ++u) { const int ck = scan_order(d, i0 + u); ds[u] = st[(size_t)ck * 4096]; de[u] = dc[(size_t)ck * 32]; }
#pragma unroll
        for (int u = 0; u < 4; ++u) { const int ck = scan_order(d, i0 + u); st[(size_t)ck * 4096] = S; S = mk2(de[u].x * S.x + ds[u].x, de[u].y * S.y + ds[u].y); }
    }
    }
}
DI void gla_c_item(const Ctx& c, int l, int item) {
    const int hp = item & 1, bc = item >> 1, b = bc / NCHK, chunk = bc % NCHK;
    int lane = c.lane; asm volatile("" : "+v"(lane));
    const int hl = c.wid >> 2, it = c.wid & 3, h = hp * 2 + hl, fr = lane & 15, fq = lane >> 4;
    LAS unsigned char* hb = c.lds + hl * 63488;
    LAS bf16_t* qg = (LAS bf16_t*)hb;
    LAS bf16_t* kg = qg + 2 * 64 * 72;
    LAS bf16_t* vT = kg + 2 * 64 * 72;
    LAS bf16_t* Pw = vT + 128 * 68 + it * 16 * 72;
    const bf16_t* P2 = WSP(bf16_t, WS_P2);
    if (it < 2) {
        const int d = it, dk = lane; float cum = 0.f;
        LAS bf16_t* qd = qg + d * 64 * 72 + dk; LAS bf16_t* kd = kg + d * 64 * 72 + dk;
#pragma unroll 1
        for (int s0 = 0; s0 < 64; s0 += 16) {
            unsigned la[16], qq[16], kk[16];
#pragma unroll
            for (int j = 0; j < 16; ++j) { const int i = d ? 63 - (s0 + j) : s0 + j; const bf16_t* rp = P2 + (size_t)gla_row(b, chunk, i) * P2W;
                la[j] = rp[(d ? PC_LAB : PC_LAF) + h * 64 + dk]; qq[j] = rp[PC_Q + h * 64 + dk]; kk[j] = rp[PC_K + h * 64 + dk]; }
            asm volatile("" : "+v"(la[0]), "+v"(la[1]), "+v"(la[2]), "+v"(la[3]), "+v"(la[4]), "+v"(la[5]), "+v"(la[6]), "+v"(la[7]), "+v"(qq[0]), "+v"(qq[1]), "+v"(qq[2]), "+v"(qq[3]), "+v"(qq[4]), "+v"(qq[5]), "+v"(qq[6]), "+v"(qq[7]),
                         "+v"(kk[0]), "+v"(kk[1]), "+v"(kk[2]), "+v"(kk[3]), "+v"(kk[4]), "+v"(kk[5]), "+v"(kk[6]), "+v"(kk[7]));
            asm volatile("" : "+v"(la[8]), "+v"(la[9]), "+v"(la[10]), "+v"(la[11]), "+v"(la[12]), "+v"(la[13]), "+v"(la[14]), "+v"(la[15]), "+v"(qq[8]), "+v"(qq[9]), "+v"(qq[10]), "+v"(qq[11]), "+v"(qq[12]), "+v"(qq[13]), "+v"(qq[14]), "+v"(qq[15]),
                         "+v"(kk[8]), "+v"(kk[9]), "+v"(kk[10]), "+v"(kk[11]), "+v"(kk[12]), "+v"(kk[13]), "+v"(kk[14]), "+v"(kk[15]));
#pragma unroll
            for (int j = 0; j < 16; ++j) { const int i = d ? 63 - (s0 + j) : s0 + j;
                cum += bf2f((bf16_t)la[j]);
                const float qv = bf2f((bf16_t)qq[j]), kv = bf2f((bf16_t)kk[j]);
                qd[i * 72] = f2bf(qv * 0.125f * __expf(cum)); kd[i * 72] = f2bf(kv * __expf(-cum)); }
        }
    } else {
        const int t = (it - 2) * 64 + lane, s = t >> 1, e0 = (t & 1) * 64; const bf16_t* vp = P2 + (size_t)gla_row(b, chunk, s) * P2W + PC_V + h * 128 + e0;
#pragma unroll
        for (int q8 = 0; q8 < 8; ++q8) { const u32x4 a = *(const u32x4*)(vp + q8 * 8); const unsigned w[4] = {a.x, a.y, a.z, a.w};
#pragma unroll
            for (int j = 0; j < 4; ++j) { vT[(e0 + q8 * 8 + 2 * j) * 68 + s] = (bf16_t)(w[j] & 0xffffu); vT[(e0 + q8 * 8 + 2 * j + 1) * 68 + s] = (bf16_t)(w[j] >> 16); } }
    }
    __syncthreads();
#ifdef DEBUG_DET
    if (hp == 0) {
        const size_t slot = (size_t)(bc * 2 + hl);
        unsigned* dq = (unsigned*)(c.ws + WS_END) + slot * 9216; const LAS unsigned* sq = (const LAS unsigned*)hb;
        for (int i = it * 64 + lane; i < 256 * 32; i += 256) dq[i] = sq[(i >> 5) * 36 + (i & 31)];
        unsigned* dv = (unsigned*)(c.ws + WS_END + 40000000) + slot * 4352; const LAS unsigned* sv = (const LAS unsigned*)vT;
        for (int i = it * 64 + lane; i < 128 * 32; i += 256) dv[i] = sv[(i >> 5) * 34 + (i & 31)];
    }
#endif
    f32x4 o[8];
#pragma unroll
    for (int et = 0; et < 8; ++et) o[et] = (f32x4){0.f, 0.f, 0.f, 0.f};
#pragma unroll
    for (int d = 0; d < 2; ++d) {
        bf16x8 qf[2];
#pragma unroll
        for (int ks = 0; ks < 2; ++ks) qf[ks] = *(const LAS bf16x8*)(qg + d * 64 * 72 + (it * 16 + fr) * 72 + fq * 8 + 32 * ks);
        f32x4 sc[4];
#pragma unroll
        for (int st = 0; st < 4; ++st) { sc[st] = (f32x4){0.f, 0.f, 0.f, 0.f};
#pragma unroll
            for (int ks = 0; ks < 2; ++ks) { const bf16x8 kf = *(const LAS bf16x8*)(kg + d * 64 * 72 + (st * 16 + fr) * 72 + fq * 8 + 32 * ks); sc[st] = __builtin_amdgcn_mfma_f32_16x16x32_bf16(qf[ks], kf, sc[st], 0, 0, 0); } }
#pragma unroll
        for (int st = 0; st < 4; ++st)
#pragma unroll
            for (int jj = 0; jj < 4; ++jj) { const int ig = it * 16 + fq * 4 + jj, sg = st * 16 + fr; const bool keep = d == 0 ? (sg <= ig) : (sg > ig);
                Pw[(fq * 4 + jj) * 72 + st * 16 + fr] = f2bf(keep ? sc[st][jj] : 0.f); }
        __syncthreads();
#ifdef DEBUG_DET
        if (hp == 0) { const size_t slot = (size_t)(((bc * 2 + hl) * 2 + d) * 4 + it);
            unsigned* dp = (unsigned*)(c.ws + WS_END + 60000000) + slot * 576; const LAS unsigned* sp = (const LAS unsigned*)Pw;
            for (int i = lane; i < 16 * 32; i += 64) dp[i] = sp[(i >> 5) * 36 + (i & 31)]; }
#endif
        bf16x8 pf[2];
#pragma unroll
        for (int ks = 0; ks < 2; ++ks) pf[ks] = *(const LAS bf16x8*)(Pw + fr * 72 + fq * 8 + 32 * ks);
        const float* stp = WSP(float, WS_GST) + (size_t)((((b * 4 + h) * 2 + d) * NCHK) + chunk) * 8192;
#pragma unroll
        for (int eh = 0; eh < 2; ++eh) {
            f32x4 sv[4][2][2];
#pragma unroll
            for (int e4 = 0; e4 < 4; ++e4)
#pragma unroll
                for (int ks = 0; ks < 2; ++ks) { const float* sp_ = stp + ((eh * 4 + e4) * 16 + fr) * 64 + fq * 8 + 32 * ks; sv[e4][ks][0] = *(const f32x4*)sp_; sv[e4][ks][1] = *(const f32x4*)(sp_ + 4); }
            asm volatile("" : "+v"(sv[0][0][0]), "+v"(sv[0][0][1]), "+v"(sv[0][1][0]), "+v"(sv[0][1][1]), "+v"(sv[1][0][0]), "+v"(sv[1][0][1]), "+v"(sv[1][1][0]), "+v"(sv[1][1][1]),
                         "+v"(sv[2][0][0]), "+v"(sv[2][0][1]), "+v"(sv[2][1][0]), "+v"(sv[2][1][1]), "+v"(sv[3][0][0]), "+v"(sv[3][0][1]), "+v"(sv[3][1][0]), "+v"(sv[3][1][1]));
#pragma unroll
            for (int e4 = 0; e4 < 4; ++e4) { const int et = eh * 4 + e4;
#pragma unroll
                for (int ks = 0; ks < 2; ++ks) {
                    const LAS u32x2* p = (const LAS u32x2*)(vT + (et * 16 + fr) * 68 + fq * 8 + 32 * ks); const u32x2 lo = p[0], hi = p[1]; u32x4 w = {lo.x, lo.y, hi.x, hi.y};
                    o[et] = __builtin_amdgcn_mfma_f32_16x16x32_bf16(pf[ks], __builtin_bit_cast(bf16x8, w), o[et], 0, 0, 0);
                    const f32x4 s0 = sv[e4][ks][0], s1 = sv[e4][ks][1];
                    u32x4 sw; sw.x = pk_bf16(s0[0], s0[1]); sw.y = pk_bf16(s0[2], s0[3]); sw.z = pk_bf16(s1[0], s1[1]); sw.w = pk_bf16(s1[2], s1[3]);
                    o[et] = __builtin_amdgcn_mfma_f32_16x16x32_bf16(qf[ks], __builtin_bit_cast(bf16x8, sw), o[et], 0, 0, 0);
                }
            }
        }
        __syncthreads();
#ifdef DEBUG_DET
        if (hp == 0 && b == 0) { const size_t slot = (size_t)(((chunk * 2 + hl) * 2 + d) * 4 + it);
            float* dp = (float*)(c.ws + WS_END + 80000000) + slot * 2048 + lane * 32;
#pragma unroll
            for (int et = 0; et < 8; ++et) *(f32x4*)(dp + et * 4) = o[et]; }
#endif
    }
    float ss[4];
#pragma unroll
    for (int jj = 0; jj < 4; ++jj) { float s = 0.f;
#pragma unroll
        for (int et = 0; et < 8; ++et) s += o[et][jj] * o[et][jj];
        s += __shfl_xor(s, 1); s += __shfl_xor(s, 2); s += __shfl_xor(s, 4); s += __shfl_xor(s, 8);
        ss[jj] = rsqrtf(s * (1.0f / 128.0f) + NORM_EPS); }
    const float* ng = c.in[27] + (size_t)l * 128;
    unsigned gv[4][8]; float ngv[8];
#pragma unroll
    for (int et = 0; et < 8; ++et) ngv[et] = ng[et * 16 + fr];
#pragma unroll
    for (int jj = 0; jj < 4; ++jj) { const bf16_t* gp = P2 + (size_t)gla_row(b, chunk, it * 16 + fq * 4 + jj) * P2W + PC_GG + h * 128;
#pragma unroll
        for (int et = 0; et < 8; ++et) gv[jj][et] = gp[et * 16 + fr]; }
#pragma unroll
    for (int jj = 0; jj < 4; ++jj) asm volatile("" : "+v"(gv[jj][0]), "+v"(gv[jj][1]), "+v"(gv[jj][2]), "+v"(gv[jj][3]), "+v"(gv[jj][4]), "+v"(gv[jj][5]), "+v"(gv[jj][6]), "+v"(gv[jj][7]));
#pragma unroll
    for (int jj = 0; jj < 4; ++jj) { const size_t row = (size_t)gla_row(b, chunk, it * 16 + fq * 4 + jj);
        bf16_t* yp = WSP(bf16_t, WS_YGLA) + row * 512 + h * 128;
#pragma unroll
        for (int et = 0; et < 8; ++et) { const int e = et * 16 + fr; yp[e] = (ABL & 4) ? (bf16_t)0 : f2bf(o[et][jj] * ss[jj] * ngv[et] * siluf_(bf2f((bf16_t)gv[jj][et]))); } }
    __syncthreads();
}
DI void ce(float& a, float& b) { const float t = fmaxf(a, b); b = fminf(a, b); a = t; }
DI void ce2(float& va, unsigned& pa, float& vb, unsigned& pb) { const bool s = va >= vb; const float hv = s ? va : vb, lv = s ? vb : va; const unsigned hp = s ? pa : pb, lp = s ? pb : pa; va = hv; vb = lv; pa = hp; pb = lp; }
DI void sort16(float (&x)[16]) {
#pragma unroll
    for (int kk = 1; kk <= 4; ++kk)
#pragma unroll
        for (int jj = kk - 1; jj >= 0; --jj)
#pragma unroll
            for (int i = 0; i < 16; ++i) { const int k = 1 << kk, j = 1 << jj, l = i ^ j; if (l > i) { if ((i & k) == 0) ce(x[i], x[l]); else ce(x[l], x[i]); } }
}
DI void merge16(float (&x)[16], const float (&y)[16]) {
#pragma unroll
    for (int i = 0; i < 16; ++i) x[i] = fmaxf(x[i], y[15 - i]);
#pragma unroll
    for (int jj = 3; jj >= 0; --jj)
#pragma unroll
        for (int i = 0; i < 16; ++i) { const int j = 1 << jj, l = i ^ j; if (l > i) ce(x[i], x[l]); }
}
DI void sort16p(float (&x)[16], unsigned (&p)[16]) {
#pragma unroll
    for (int kk = 1; kk <= 4; ++kk)
#pragma unroll
        for (int jj = kk - 1; jj >= 0; --jj)
#pragma unroll
            for (int i = 0; i < 16; ++i) { const int k = 1 << kk, j = 1 << jj, l = i ^ j; if (l > i) { if ((i & k) == 0) ce2(x[i], p[i], x[l], p[l]); else ce2(x[l], p[l], x[i], p[i]); } }
}
DI void merge16p(float (&x)[16], unsigned (&p)[16], const float (&y)[16], const unsigned (&q)[16]) {
#pragma unroll
    for (int i = 0; i < 16; ++i) { const bool s = x[i] >= y[15 - i]; p[i] = s ? p[i] : q[15 - i]; x[i] = s ? x[i] : y[15 - i]; }
#pragma unroll
    for (int jj = 3; jj >= 0; --jj)
#pragma unroll
        for (int i = 0; i < 16; ++i) { const int j = 1 << jj, l = i ^ j; if (l > i) ce2(x[i], p[i], x[l], p[l]); }
}
DI void peer_half_top16(const bf16_t* qrow, const bf16_t* keys, int lane, float (&res)[16]) {
    const int tl = lane & 31, hf = lane >> 5;
    f32x16 acc[4];
#pragma unroll
    for (int t4 = 0; t4 < 4; ++t4)
#pragma unroll
        for (int r = 0; r < 16; ++r) acc[t4][r] = 0.f;
    bf16x8 bq[8];
#pragma unroll
    for (int ks = 0; ks < 8; ++ks) bq[ks] = *(const bf16x8*)(qrow + 8 * hf + 16 * ks);
#pragma unroll
    for (int kp = 0; kp < 4; ++kp) {
        bf16x8 ak[2][4];
#pragma unroll
        for (int k4 = 0; k4 < 2; ++k4)
#pragma unroll
            for (int t4 = 0; t4 < 4; ++t4) ak[k4][t4] = *(const bf16x8*)(keys + (size_t)(t4 * 32 + tl) * 128 + 8 * hf + 16 * (kp * 2 + k4));
        asm volatile("" ::: "memory");
#pragma unroll
        for (int k4 = 0; k4 < 2; ++k4)
#pragma unroll
            for (int t4 = 0; t4 < 4; ++t4) acc[t4] = __builtin_amdgcn_mfma_f32_32x32x16_bf16(ak[k4][t4], bq[kp * 2 + k4], acc[t4], 0, 0, 0);
    }
    float L0[16], L1[16], L2[16], L3[16];
#pragma unroll
    for (int r = 0; r < 16; ++r) { const unsigned n = (unsigned)((r & 3) + 8 * (r >> 2) + 4 * hf);
        L0[r] = __uint_as_float((__float_as_uint(acc[0][r]) & ~127u) | n); L1[r] = __uint_as_float((__float_as_uint(acc[1][r]) & ~127u) | (32u + n));
        L2[r] = __uint_as_float((__float_as_uint(acc[2][r]) & ~127u) | (64u + n)); L3[r] = __uint_as_float((__float_as_uint(acc[3][r]) & ~127u) | (96u + n)); }
    sort16(L0); sort16(L1); sort16(L2); sort16(L3);
    merge16(L0, L1); merge16(L2, L3); merge16(L0, L2);
#pragma unroll
    for (int i = 0; i < 16; ++i) L1[i] = __shfl_xor(L0[i], 32);
    merge16(L0, L1);
#pragma unroll
    for (int i = 0; i < 16; ++i) res[i] = L0[i];
}
DI void peer_topk_wave(const Ctx& c, int tile, int h) {
    int lane = c.lane; asm volatile("" : "+v"(lane));
    const int tl = lane & 31, hf = lane >> 5; const size_t row = (size_t)tile * 32 + tl;
    const bf16_t* qrow = WSP(bf16_t, WS_Q) + row * 2048 + h * 256; const bf16_t* keys = WSP(bf16_t, WS_KEYS) + (size_t)h * 2 * 128 * 128;
    float A[16], B[16];
    peer_half_top16(qrow, keys, lane, A);
    peer_half_top16(qrow + 128, keys + 128 * 128, lane, B);
    LAS unsigned* tab = (LAS unsigned*)(c.lds + c.wid * 8192);
    float sa[16], sb[16];
#pragma unroll
    for (int i = 0; i < 16; ++i) { const unsigned ua = __float_as_uint(A[i]), ub = __float_as_uint(B[i]); sa[i] = __uint_as_float(ua & ~127u); sb[i] = __uint_as_float(ub & ~127u);
        tab[i * 64 + lane] = (ua & 127u) << 7; tab[(16 + i) * 64 + lane] = ub & 127u; }
#define PK2(i, j) __uint_as_float((__float_as_uint(sa[i] + sb[j]) & ~255u) | (unsigned)(((i) << 4) | (j)))
    float G0[16], G1[16];
#pragma unroll
    for (int j = 0; j < 16; ++j) G0[j] = PK2(0, j);
#pragma unroll
    for (int j = 0; j < 8; ++j) G1[j] = PK2(1, j);
#pragma unroll
    for (int j = 0; j < 5; ++j) G1[8 + j] = PK2(2, j);
#pragma unroll
    for (int j = 0; j < 3; ++j) G1[13 + j] = PK2(4, j);
    sort16(G1); merge16(G0, G1);
#pragma unroll
    for (int j = 0; j < 4; ++j) G1[j] = PK2(3, j);
#pragma unroll
    for (int i = 0; i < 3; ++i)
#pragma unroll
        for (int j = 0; j < 2; ++j) G1[4 + i * 2 + j] = PK2(5 + i, j);
#pragma unroll
    for (int i = 0; i < 6; ++i) G1[10 + i] = PK2(8 + i, 0);
    sort16(G1); merge16(G0, G1);
#pragma unroll
    for (int j = 0; j < 16; ++j) G1[j] = -3.0e38f;
    G1[0] = PK2(14, 0); G1[1] = PK2(15, 0); ce(G1[0], G1[1]);
    merge16(G0, G1);
#undef PK2
    LDS_FENCE();
    unsigned P0[16]; float den = 0.f; const float vmax = __uint_as_float(__float_as_uint(G0[0]) & ~255u);
#pragma unroll
    for (int i = 0; i < 16; ++i) { const unsigned u = __float_as_uint(G0[i]); const unsigned ci = (u >> 4) & 15u, cj = u & 15u;
        P0[i] = tab[ci * 64 + lane] | tab[(16 + cj) * 64 + lane];
        G0[i] = __expf(__uint_as_float(u & ~255u) - vmax); den += G0[i]; }
    const float inv = 1.0f / den;
    if (hf == 0) { unsigned* dp = WSP(unsigned, WS_SELI) + row * 128 + h * 16;
#pragma unroll
        for (int i = 0; i < 4; ++i) *(u32x4*)(dp + 4 * i) = (u32x4){P0[4 * i], P0[4 * i + 1], P0[4 * i + 2], P0[4 * i + 3]}; }
    else { float* dp = WSP(float, WS_SELW) + row * 128 + h * 16;
#pragma unroll
        for (int i = 0; i < 4; ++i) *(f32x4*)(dp + 4 * i) = (f32x4){G0[4 * i] * inv, G0[4 * i + 1] * inv, G0[4 * i + 2] * inv, G0[4 * i + 3] * inv}; }
    LDS_FENCE();
}

typedef float f32x2v __attribute__((ext_vector_type(2)));
DI float dot16_fp8(const u32x4 u, const float (&h)[16]) {
    f32x2v a0 = {0.f, 0.f}, a1 = {0.f, 0.f};
#pragma unroll
    for (int k = 0; k < 4; ++k) { const f32x2v lo = __builtin_amdgcn_cvt_pk_f32_fp8((int)u[k], false), hi = __builtin_amdgcn_cvt_pk_f32_fp8((int)u[k], true);
        const f32x2v h0 = {h[4 * k], h[4 * k + 1]}, h1 = {h[4 * k + 2], h[4 * k + 3]};
        a0 = __builtin_elementwise_fma(lo, h0, a0); a1 = __builtin_elementwise_fma(hi, h1, a1); }
    const f32x2v t = a0 + a1; return t.x + t.y;
}
DI void fma16_fp8(float (&acc)[16], const u32x4 v, float cf) {
#pragma unroll
    for (int k = 0; k < 4; ++k) { const f32x2v lo = __builtin_amdgcn_cvt_pk_f32_fp8((int)v[k], false), hi = __builtin_amdgcn_cvt_pk_f32_fp8((int)v[k], true);
        acc[4 * k] += cf * lo.x; acc[4 * k + 1] += cf * lo.y; acc[4 * k + 2] += cf * hi.x; acc[4 * k + 3] += cf * hi.y; }
}
#define FP4X(w, sel) __builtin_amdgcn_cvt_scalef32_pk_f32_fp4((w), 1.0f, (sel))
DI float dot16_fp4(const u32x2 u, const float (&h)[16]) {
    f32x2v a0 = {0.f, 0.f}, a1 = {0.f, 0.f};
#pragma unroll
    for (int k = 0; k < 2; ++k) { const unsigned w = u[k]; const f32x2v v0 = FP4X(w, 0), v1 = FP4X(w, 1), v2 = FP4X(w, 2), v3 = FP4X(w, 3);
        const f32x2v h0 = {h[8 * k], h[8 * k + 1]}, h1 = {h[8 * k + 2], h[8 * k + 3]}, h2 = {h[8 * k + 4], h[8 * k + 5]}, h3 = {h[8 * k + 6], h[8 * k + 7]};
        a0 = __builtin_elementwise_fma(v0, h0, a0); a1 = __builtin_elementwise_fma(v1, h1, a1); a0 = __builtin_elementwise_fma(v2, h2, a0); a1 = __builtin_elementwise_fma(v3, h3, a1); }
    const f32x2v t = a0 + a1; return t.x + t.y;
}
DI void fma16_fp4(float (&acc)[16], const u32x2 v, float cf) {
#pragma unroll
    for (int k = 0; k < 2; ++k) { const unsigned w = v[k]; const f32x2v v0 = FP4X(w, 0), v1 = FP4X(w, 1), v2 = FP4X(w, 2), v3 = FP4X(w, 3);
        acc[8 * k] += cf * v0.x; acc[8 * k + 1] += cf * v0.y; acc[8 * k + 2] += cf * v1.x; acc[8 * k + 3] += cf * v1.y; acc[8 * k + 4] += cf * v2.x; acc[8 * k + 5] += cf * v2.y; acc[8 * k + 6] += cf * v3.x; acc[8 * k + 7] += cf * v3.y; }
}
template <bool FINAL, bool SPLIT = false>
DI void peer_expert_token(const Ctx& c, int l, int r, const float* xsrc_lat) {
    int lane = c.lane; asm volatile("" : "+v"(lane));
    const int half = SPLIT ? (c.wid & 1) : 0;
    const bf16_t* hr = WSP(bf16_t, WS_H) + (size_t)r * 1024 + lane * 16;
    float h[16];
    { const u32x4 ha = *(const u32x4*)hr, hb = *(const u32x4*)(hr + 8);
      h[0] = bflo(ha.x); h[1] = bfhi(ha.x); h[2] = bflo(ha.y); h[3] = bfhi(ha.y); h[4] = bflo(ha.z); h[5] = bfhi(ha.z); h[6] = bflo(ha.w); h[7] = bfhi(ha.w);
      h[8] = bflo(hb.x); h[9] = bfhi(hb.x); h[10] = bflo(hb.y); h[11] = bfhi(hb.y); h[12] = bflo(hb.z); h[13] = bfhi(hb.z); h[14] = bflo(hb.w); h[15] = bfhi(hb.w); }
    const unsigned* si = WSP(unsigned, WS_SELI) + (size_t)r * 128; const float* sw = WSP(float, WS_SELW) + (size_t)r * 128;
    const unsigned idx_lo = si[lane], idx_hi = si[64 + lane]; const float w_lo = sw[lane], w_hi = sw[64 + lane];
    const __attribute__((address_space(1))) unsigned char* PUV = (const __attribute__((address_space(1))) unsigned char*)(c.ws + WS_PU); const unsigned lo16 = (unsigned)lane * 16u;
    unsigned hd[2][2] = {{0u, 0u}, {0u, 0u}};
#pragma unroll
    for (int i = 0; i < 16; ++i) { const int q = (int)fminf(fmaxf(rintf(h[i] * PH_ISCALE), -119.f), 119.f);
        const int d0 = ((q + 8) & 15) - 8, d1 = (q - d0) >> 4; const int sh = 4 * (i & 7);
        hd[0][i >> 3] |= ((unsigned)d0 & 15u) << sh; hd[1][i >> 3] |= ((unsigned)d1 & 15u) << sh; }
    float acc[16];
#pragma unroll
    for (int i = 0; i < 16; ++i) acc[i] = 0.f;
    const int myr = ((lane >> 5) & 1) * 4 + ((lane >> 4) & 1) * 2 + ((lane >> 3) & 1);
#pragma unroll 1
    for (int g2 = SPLIT ? half * 4 : 0; g2 < (SPLIT ? half * 4 + 4 : 8); ++g2) {
        const unsigned idxv = g2 < 4 ? idx_lo : idx_hi; const float wv = g2 < 4 ? w_lo : w_hi; const int l0 = (g2 * 16) & 63;
        unsigned e[16];
#pragma unroll
        for (int rr = 0; rr < 16; ++rr) e[rr] = (unsigned)__builtin_amdgcn_readlane((int)idxv, l0 + rr);
        u32x4 uv[16];
#pragma unroll
        for (int rr = 0; rr < 16; ++rr) uv[rr] = *(const __attribute__((address_space(1))) u32x4*)(PUV + (e[rr] * 1024u + lo16));
#pragma unroll
        for (int hf = 0; hf < 2; ++hf) {
            int p[8];
#pragma unroll
            for (int rr = 0; rr < 8; ++rr) { const int ux = (int)uv[hf * 8 + rr].x, uy = (int)uv[hf * 8 + rr].y;
                int t = __builtin_amdgcn_sdot8(uy, (int)hd[1][1], __builtin_amdgcn_sdot8(ux, (int)hd[1][0], 0, false), false);
                t = __builtin_amdgcn_sdot8(uy, (int)hd[0][1], __builtin_amdgcn_sdot8(ux, (int)hd[0][0], t * 16, false), false);
                p[rr] = t; }
            int q4[4], q2[2], q1i;
#pragma unroll
            for (int i = 0; i < 4; ++i) { const auto r = __builtin_amdgcn_permlane32_swap((unsigned)p[i], (unsigned)p[i + 4], false, false); q4[i] = (int)r[0] + (int)r[1]; }
#pragma unroll
            for (int i = 0; i < 2; ++i) { const auto r = __builtin_amdgcn_permlane16_swap((unsigned)q4[i], (unsigned)q4[i + 2], false, false); q2[i] = (int)r[0] + (int)r[1]; }
            { const bool up = (lane & 8) != 0; const int send = up ? q2[0] : q2[1]; const int keep = up ? q2[1] : q2[0];
              q1i = keep + __builtin_amdgcn_update_dpp(0, send, 0x128, 0xf, 0xf, false); }
            q1i += __builtin_amdgcn_update_dpp(0, q1i, 0xB1, 0xf, 0xf, false);
            q1i += __builtin_amdgcn_update_dpp(0, q1i, 0x4E, 0xf, 0xf, false);
            q1i += __builtin_amdgcn_update_dpp(0, q1i, 0x141, 0xf, 0xf, false);
            const float q1 = (float)q1i;
            const float wsel = __shfl(wv, l0 + hf * 8 + myr);
            const float coef = wsel * geluf_(q1 * (1.0f / (PU_ISCALE * PH_ISCALE))) * (1.0f / PV_SCALE);
#pragma unroll
            for (int rr = 0; rr < 8; ++rr) { const float cf = __int_as_float(__builtin_amdgcn_readlane(__float_as_int(coef), ((rr & 4) ? 32 : 0) + ((rr & 2) ? 16 : 0) + ((rr & 1) ? 8 : 0))); fma16_fp4(acc, (u32x2){uv[hf * 8 + rr].z, uv[hf * 8 + rr].w}, cf); }
        }
    }
    if (SPLIT) {
        LAS float* xb = (LAS float*)c.lds + (c.wid >> 1) * 1024 + lane;
        if (half) {
#pragma unroll
            for (int i = 0; i < 16; ++i) xb[i * 64] = acc[i];
        }
        __syncthreads();
        if (half) return;
#pragma unroll
        for (int i = 0; i < 16; ++i) acc[i] += xb[i * 64];
    }
    const int b = r < NLAT ? (r >> 13) : 4;
    const float* gt = WSP(float, WS_MOD) + (size_t)(l * 5 + b) * 6144 + 5120 + lane * 16;
    const float* xr = (r < NLAT ? xsrc_lat + (size_t)r * 1024 : WSP(float, WS_XCTX) + (size_t)(r - NLAT) * 1024) + lane * 16;
    float* xw = (r < NLAT ? c.out + (size_t)r * 1024 : WSP(float, WS_XCTX) + (size_t)(r - NLAT) * 1024) + lane * 16;
    float xn[16]; float s = 0.f;
#pragma unroll
    for (int k = 0; k < 4; ++k) { const f32x4 xa = *(const f32x4*)(xr + 4 * k), ga = *(const f32x4*)(gt + 4 * k);
#pragma unroll
        for (int j = 0; j < 4; ++j) xn[4 * k + j] = xa[j] + ((ABL & 8) ? 0.f : ga[j] * acc[4 * k + j]); }
    if (FINAL) {
#pragma unroll
        for (int i = 0; i < 16; ++i) s += xn[i] * xn[i];
#pragma unroll
        for (int o = 32; o; o >>= 1) s += __shfl_xor(s, o);
        const float rs = rsqrtf(s * (1.f / 1024.f) + NORM_EPS); const float* gf = c.in[37] + lane * 16;
#pragma unroll
        for (int i = 0; i < 16; ++i) xn[i] *= rs * gf[i];
    }
#pragma unroll
    for (int k = 0; k < 4; ++k) *(f32x4*)(xw + 4 * k) = (f32x4){xn[4 * k], xn[4 * k + 1], xn[4 * k + 2], xn[4 * k + 3]};
    if (!FINAL) {
        float s2 = 0.f;
#pragma unroll
        for (int i = 0; i < 16; ++i) s2 += xn[i] * xn[i];
#pragma unroll
        for (int o = 32; o; o >>= 1) s2 += __shfl_xor(s2, o);
        const float rs = rsqrtf(s2 * (1.f / 1024.f) + NORM_EPS);
        const float* g1 = c.in[6] + (size_t)(l + 1) * 1024 + lane * 16; const float* m1 = WSP(float, WS_MOD) + (size_t)((l + 1) * 5 + b) * 6144 + lane * 16;
        float o[16];
#pragma unroll
        for (int k = 0; k < 4; ++k) { const f32x4 ga = *(const f32x4*)(g1 + 4 * k), sh = *(const f32x4*)(m1 + 4 * k), sc = *(const f32x4*)(m1 + 1024 + 4 * k);
#pragma unroll
            for (int j = 0; j < 4; ++j) o[4 * k + j] = xn[4 * k + j] * rs * ga[j] * (1.f + sc[j]) + sh[j]; }
        bf16_t* hw = WSP(bf16_t, WS_H) + (size_t)r * 1024 + lane * 16;
        u32x4 w0, w1; w0.x = pk_bf16(o[0], o[1]); w0.y = pk_bf16(o[2], o[3]); w0.z = pk_bf16(o[4], o[5]); w0.w = pk_bf16(o[6], o[7]);
        w1.x = pk_bf16(o[8], o[9]); w1.y = pk_bf16(o[10], o[11]); w1.z = pk_bf16(o[12], o[13]); w1.w = pk_bf16(o[14], o[15]);
        *(u32x4*)hw = w0; *(u32x4*)(hw + 8) = w1;
    }
}
constexpr int PH_PER_LAYER = 11, N_PHASES = 1 + 4 * PH_PER_LAYER;

DI void prep_item(const Ctx& c, int l, int it) {
    if (it < 448) { int ng = (it >> 3) * 2; const int kg = it & 7; if (ng >= 56) ng += 8;
        const int n0 = ng * 64, ns0 = n0 < 3584 ? n0 : n0 - 480;
        tr_tile128(c, c.in[8] + (size_t)l * 1024 * 7200, 7200, kg * 128, ns0, WSP(bf16_t, WS_BTIN), 1024, n0); return; }
    it -= 448;
    if (it < 128) { const int d = it >> 6, jg = (it >> 4) & 3, kg = it & 15; fold_tile(c, c.in[8] + (size_t)l * 1024 * 7200, c.in[25] + (size_t)l * 2 * 16 * 256, d, jg * 64, kg * 64, WSP(bf16_t, WS_BTIN)); return; }
    it -= 128;
    if (it < 96) { const int w = it >> 5, r = it & 31, ng = r >> 2, kg = r & 3;
        tr_tile128(c, c.in[28 + w] + (size_t)l * 512 * 1024, 1024, kg * 128, ng * 128, WSP(bf16_t, w == 0 ? WS_BTHY : (w == 1 ? WS_BTRG : WS_BTGLA)), 512, ng * 128); return; }
    it -= 96;
    if (it < 64) { const int ng = it >> 3, kg = it & 7; tr_tile128(c, c.in[32] + (size_t)l * 1024 * 1024, 1024, kg * 128, ng * 128, WSP(bf16_t, WS_BTOUT), 1024, ng * 128); return; }
    it -= 64;
    if (it < 128) { const int ng = it >> 3, kg = it & 7; tr_tile128(c, c.in[33] + (size_t)l * 1024 * 2048, 2048, kg * 128, ng * 128, WSP(bf16_t, WS_BTWQ), 1024, ng * 128); return; }
    it -= 128;
    if (it < 32) { const int d = it >> 4, mat = (it >> 3) & 1, g = it & 7;
        tr_tile(c, c.in[mat ? 22 : 20] + (size_t)((l * 2 + d) * 8 + g) * 4096, 64, 0, 0, WSP(bf16_t, WS_RGW) + (size_t)((d * 2 + mat) * 8 + g) * 4096, 64, 0); return; }
    it -= 32;
    if (it < 32) { cvt_chunk(c, c.in[34] + (size_t)l * 262144 + (size_t)it * 8192, WSP(bf16_t, WS_KEYS) + (size_t)it * 8192); return; }
    it -= 32;
    if (it < 2048) { cvt_chunk_int4_il(c, c.in[35] + (size_t)l * 16777216 + (size_t)it * 8192, c.ws + WS_PU + (size_t)it * 8192, PU_ISCALE); return; }
    it -= 2048;
    cvt_chunk_fp4_il(c, c.in[36] + (size_t)l * 16777216 + (size_t)it * 8192, c.ws + WS_PU + (size_t)it * 8192, PV_SCALE, 1);
}
constexpr int N_PREP = 448 + 128 + 96 + 64 + 128 + 32 + 32 + 2048 + 2048;

__global__ void __launch_bounds__(512, 2) fwd_kernel(Args a) {
    extern __shared__ __attribute__((aligned(16))) unsigned char shm[];
    Ctx c0; c0.in = a.in; c0.out = a.out; c0.ws = a.ws; c0.lds = (LAS unsigned char*)shm;
    c0.tid = threadIdx.x; c0.lane = c0.tid & 63; c0.wid = __builtin_amdgcn_readfirstlane(c0.tid >> 6); c0.G = gridDim.x; c0.bid = blockIdx.x;
    const Ctx& c = c0;
    volatile LAS unsigned* barw = (volatile LAS unsigned*)(c.lds + LDS_BARW);
    if (c.tid < 4) barw[c.tid] = 0u;
    tw_init(c);
    __syncthreads();
    const int lo = a.ph_lo, hi = a.ph_hi;
    XcdBarrier bar; bar.bar = (unsigned*)(c.ws + WS_CTL); bar.x = 0; bar.st = barw;
    if (hi - lo > 1) bar = xcd_barrier_post((unsigned*)(c.ws + WS_CTL), barw);
#ifdef ONLY_PHASE
#define PHON(j) ((j) == ONLY_PHASE)
#else
#define PHON(j) 1
#endif
#ifdef ONLY_SUB
#define SUB(j) ((j) == ONLY_SUB)
#else
#define SUB(j) 1
#endif
#define PH_BEGIN() Ctx cc = c0; int ll = l0; asm volatile("" : "+s"(ll)); asm volatile("" : "+v"(cc.tid)); cc.lane = cc.tid & 63; cc.wid = __builtin_amdgcn_readfirstlane(cc.tid >> 6); asm volatile("" : "+s"(cc.bid)); const Ctx& c = cc; const int l = ll; (void)l;
#define IN(k) (lo <= (k) && (k) < hi)
#ifdef DEBUG_TIME
#define STAMP(k) do { if (c0.bid == 0 && c0.tid == 0) ((unsigned long long*)(c0.ws + WS_CTL + 40000))[(k)] = wall_clock64(); } while (0)
#else
#define STAMP(k) do {} while (0)
#endif
#define SEAM(k) do { if (IN(k) && IN((k) + 1)) xcd_barrier(bar); STAMP((k) + 1); } while (0)
    int ph = 0;
    STAMP(0);
    if (PHON(0) && IN(ph)) p0_prologue(c);
    SEAM(ph); ++ph;
#pragma unroll 1
    for (int l0 = 0; l0 < 4; ++l0) {
        if (PHON(1) && IN(ph)) { PH_BEGIN(); const float* xlat_in = l == 0 ? c.in[0] : c.out; const float* modl = WSP(float, WS_MOD) + (size_t)l * 5 * 6144; (void)xlat_in; (void)modl;
            for (int it = c.bid; it < 272; it += c.G) hy_filter_tile(c, l, it);
            const int NL = N_PREP + (l == 0 ? NTOK / 8 : 0);
#pragma unroll 1
            for (int k = 0; ; ++k) {
                int j;
                const int R = c.G > 16 ? 36 : 0, Gr = c.G - 16;
                if (k < R) { if (c.bid < 16) continue; j = k * Gr + c.bid - 16; if (j >= NL) continue; }
                else { j = R * Gr + (k - R) * c.G + c.bid; if (j >= NL) break; }
                if (j < N_PREP) prep_item(c, l, j);
                else norm_row_to_h<0>(c, l, (j - N_PREP) * 8 + c.wid, xlat_in);
            }
        }
        SEAM(ph); ++ph;
        if (PHON(2) && IN(ph)) { PH_BEGIN(); const float* xlat_in = l == 0 ? c.in[0] : c.out; const float* modl = WSP(float, WS_MOD) + (size_t)l * 5 * 6144; (void)xlat_in; (void)modl;
            SchedIn S; S.so.init(NTOK, 7680, c.G, c.bid); S.H = (const char*)WSP(bf16_t, WS_H); S.Bt = (const char*)WSP(bf16_t, WS_BTIN);
            EpiIn E{WSP(bf16_t, WS_P2), WSP(bf16_t, WS_HYT), WSP(bf16_t, WS_HYTC), c.in[26] + (size_t)l * 512, c.in[31] + (size_t)l * 3072, WSP(bf16_t, WS_GF)};
            if (SUB(0)) pg8::gemm_phase<EpiIn, SchedIn>(c.lds, 1024, S, E);
            __syncthreads();
            if (SUB(1)) for (int it = c.bid; it < 512; it += c.G) hy_spec_pair_item(c, it >> 8, it & 255);
        }
        SEAM(ph); ++ph;
        if (PHON(3) && IN(ph)) { PH_BEGIN(); const float* xlat_in = l == 0 ? c.in[0] : c.out; const float* modl = WSP(float, WS_MOD) + (size_t)l * 5 * 6144; (void)xlat_in; (void)modl;
#ifdef DEBUG_SUB
            for (int it = c.bid; it < 1024; it += c.G) hy_lat_item(c, l, it >> 9, it & 511);
            xcd_barrier(bar); if (c0.bid == 0 && c0.tid == 0) ((unsigned long long*)(c0.ws + WS_CTL + 48000))[l * 8 + 0] = wall_clock64();
            for (int it = c.bid; it < 256; it += c.G) { if (l < 3) { const int w = it * 8 + c.wid; hy_ctx_item(c, l, w >> 9, w & 511); } __syncthreads(); }
            xcd_barrier(bar); if (c0.bid == 0 && c0.tid == 0) ((unsigned long long*)(c0.ws + WS_CTL + 48000))[l * 8 + 1] = wall_clock64();
            for (int it = c.bid; it < 4 * NCHK; it += c.G) { rg_item<false>(c, l, it); __syncthreads(); }
            xcd_barrier(bar); if (c0.bid == 0 && c0.tid == 0) ((unsigned long long*)(c0.ws + WS_CTL + 48000))[l * 8 + 2] = wall_clock64();
            for (int it = c.bid; it < 16 * NCHK; it += c.G) gla_a_item(c, it);
#else
            const int n_items = 1024 + 256 + 4 * NCHK;
            for (int it = c.bid; it < n_items; it += c.G) {
                if (it < 1024) { if (SUB(0)) hy_lat_item(c, l, it >> 9, it & 511); }
                else if (it < 1280) { if (SUB(1) && l < 3) { const int w = (it - 1024) * 8 + c.wid; hy_ctx_item(c, l, w >> 9, w & 511); } __syncthreads(); }
                else { if (SUB(2)) { rg_item<false>(c, l, it - 1280); __syncthreads(); } }
            }
#pragma unroll 1
            for (int k = 0; ; ++k) {
                const int R = c.G > 16 ? 4 : 0, Gr = c.G - 16; int j;
                if (k < R) { if (c.bid < 16) continue; j = k * Gr + c.bid - 16; }
                else { j = R * Gr + (k - R) * c.G + c.bid; if (j >= 16 * NCHK) break; }
                if (SUB(3)) gla_a_item(c, j);
            }
#endif
        }
        SEAM(ph); ++ph;
        if (PHON(4) && IN(ph)) { PH_BEGIN(); const float* xlat_in = l == 0 ? c.in[0] : c.out; const float* modl = WSP(float, WS_MOD) + (size_t)l * 5 * 6144; (void)xlat_in; (void)modl;
            rg_carry_scan(c);
            gla_state_scan(c);
            for (int it = c.bid; it < 2048; it += c.G) yhy_tr_tile2(c, it);
        }
        SEAM(ph); ++ph;
        if (PHON(5) && IN(ph)) { PH_BEGIN(); const float* xlat_in = l == 0 ? c.in[0] : c.out; const float* modl = WSP(float, WS_MOD) + (size_t)l * 5 * 6144; (void)xlat_in; (void)modl;
#ifdef DEBUG_SUB
            for (int it = c.bid; it < 4 * NCHK; it += c.G) { rg_c_item(c, it); __syncthreads(); }
            xcd_barrier(bar); if (c0.bid == 0 && c0.tid == 0) ((unsigned long long*)(c0.ws + WS_CTL + 48000))[l * 8 + 4] = wall_clock64();
            for (int it = c.bid; it < 8 * NCHK; it += c.G) gla_c_item(c, l, it);
        }
#else
            const bool lat = l == 3; const int n_rg = lat ? 512 : 4 * NCHK, n_items = lat ? 512 + 1024 : 4 * NCHK + 8 * NCHK;
            for (int it = c.bid; it < n_items; it += c.G) {
                if (it < n_rg) { if (SUB(0)) { rg_c_item(c, lat ? (it >> 7) * NCHK + 4 + (it & 127) : it); __syncthreads(); } }
                else { const int j = it - n_rg, bc = j >> 1; if (SUB(1)) gla_c_item(c, l, lat ? ((((bc >> 7) * NCHK + 4 + (bc & 127)) << 1) | (j & 1)) : j); }
            }
        }
#endif
        SEAM(ph); ++ph;
        if (PHON(6) && IN(ph)) { PH_BEGIN(); const float* xlat_in = l == 0 ? c.in[0] : c.out; const float* modl = WSP(float, WS_MOD) + (size_t)l * 5 * 6144; (void)xlat_in; (void)modl;
            SchedMg S; S.so.init(l == 3 ? NLAT : NTOK, 1024, c.G, c.bid); S.ws = (const char*)c.ws;
            EpiMg E{c.ws};
            pg8::gemm_phase<EpiMg, SchedMg>(c.lds, 512, S, E);
        }
        SEAM(ph); ++ph;
        if (PHON(7) && IN(ph)) { PH_BEGIN(); const float* xlat_in = l == 0 ? c.in[0] : c.out; const float* modl = WSP(float, WS_MOD) + (size_t)l * 5 * 6144; (void)xlat_in; (void)modl;
            SchedPlain S; S.so.init(l == 3 ? NLAT : NTOK, 1024, c.G, c.bid); S.A0 = (const char*)WSP(bf16_t, WS_M); S.B0 = (const char*)WSP(bf16_t, WS_BTOUT); S.ts = (size_t)256 * 1024 * 2;
            EpiOut E{xlat_in, c.out, WSP(float, WS_XCTX), modl};
            pg8::gemm_phase<EpiOut, SchedPlain>(c.lds, 1024, S, E);
        }
        SEAM(ph); ++ph;
        if (PHON(8) && IN(ph)) { PH_BEGIN(); const float* xlat_in = l == 0 ? c.in[0] : c.out; const float* modl = WSP(float, WS_MOD) + (size_t)l * 5 * 6144; (void)xlat_in; (void)modl;
            norm2_rows(c, l, l == 3 ? NLAT : NTOK, c.out);
        }
        SEAM(ph); ++ph;
        if (PHON(9) && IN(ph)) { PH_BEGIN(); const float* xlat_in = l == 0 ? c.in[0] : c.out; const float* modl = WSP(float, WS_MOD) + (size_t)l * 5 * 6144; (void)xlat_in; (void)modl;
            SchedPlain S; S.so.init(l == 3 ? NLAT : NTOK, 2048, c.G, c.bid); S.A0 = (const char*)WSP(bf16_t, WS_H); S.B0 = (const char*)WSP(bf16_t, WS_BTWQ); S.ts = (size_t)256 * 1024 * 2;
            EpiQ E{WSP(bf16_t, WS_Q)};
            pg8::gemm_phase<EpiQ, SchedPlain>(c.lds, 1024, S, E);
        }
        SEAM(ph); ++ph;
        if (PHON(10) && IN(ph)) { PH_BEGIN(); const float* xlat_in = l == 0 ? c.in[0] : c.out; const float* modl = WSP(float, WS_MOD) + (size_t)l * 5 * 6144; (void)xlat_in; (void)modl;
            for (int it = c.bid; it < (l == 3 ? NLAT : NTOK) / 32; it += c.G) peer_topk_wave(c, it, c.wid);
        }
        SEAM(ph); ++ph;
        if (PHON(11) && IN(ph)) { PH_BEGIN(); const float* xlat_in = l == 0 ? c.in[0] : c.out; const float* modl = WSP(float, WS_MOD) + (size_t)l * 5 * 6144; (void)xlat_in; (void)modl;
            if (l < 3) { for (int it = c.bid; it < NLAT / 8; it += c.G) peer_expert_token<false>(c, l, it * 8 + c.wid, c.out);
                for (int it = c.bid; it < (NTOK - NLAT) / 4; it += c.G) peer_expert_token<false, true>(c, l, NLAT + it * 4 + (c.wid >> 1), c.out); }
            else { for (int it = c.bid; it < NLAT / 8; it += c.G) peer_expert_token<true>(c, l, it * 8 + c.wid, c.out); }
        }
        SEAM(ph); ++ph;
    }
#undef IN
#undef SEAM
}

#if !defined(DEBUG_DET) && !defined(DEBUG_PEER) && !defined(DEBUG_TIME)
#ifndef N_LAUNCH_MODE
#define N_LAUNCH_MODE 0
#endif
extern "C" void kernel_launch(void* const* d_in, const int* in_sizes, int n_in, void* d_out, int out_size, void* d_ws, size_t ws_size, hipStream_t stream) {
    static int grid = 0;
    if (grid == 0) {
        if (n_in != 38 || ws_size < WS_END) { fprintf(stderr, "kernel_launch: need 38 inputs and %zu bytes of workspace (got %d, %zu)\n", (size_t)WS_END, n_in, ws_size); grid = -1; return; }
        int dev = 0, cus = 0, per_cu = 0;
        if (hipGetDevice(&dev) != hipSuccess || hipDeviceGetAttribute(&cus, hipDeviceAttributeMultiprocessorCount, dev) != hipSuccess) { grid = -1; return; }
        if (hipFuncSetAttribute((const void*)fwd_kernel, hipFuncAttributeMaxDynamicSharedMemorySize, LDS_BYTES) != hipSuccess) { fprintf(stderr, "kernel_launch: hipFuncSetAttribute failed\n"); grid = -1; return; }
        if (hipOccupancyMaxActiveBlocksPerMultiprocessor(&per_cu, (const void*)fwd_kernel, 512, LDS_BYTES) != hipSuccess || per_cu < 1) { fprintf(stderr, "kernel_launch: occupancy query says %d\n", per_cu); }
        (void)hipGetLastError();
        grid = cus;
    }
    if (grid < 0) return;
    (void)hipMemsetAsync((char*)d_ws + WS_CTL, 0, 65536, stream);
    Args a; memset(&a, 0, sizeof(a));
    for (int i = 0; i < 38; ++i) a.in[i] = (const float*)d_in[i];
    a.out = (float*)d_out; a.ws = (unsigned char*)d_ws;
#if N_LAUNCH_MODE == 1
    a.ph_lo = 0; a.ph_hi = N_PHASES;
    hipLaunchKernelGGL(fwd_kernel, dim3(grid), dim3(512), LDS_BYTES, stream, a);
#else
    for (int p = 0; p < N_PHASES; ++p) { a.ph_lo = p; a.ph_hi = p + 1; hipLaunchKernelGGL(fwd_kernel, dim3(grid), dim3(512), LDS_BYTES, stream, a); }
#endif
}
#endif
```

```cpp
#define N_LAUNCH_MODE 1
#include <hip/hip_runtime.h>
#include <stdint.h>
#include <cstdio>
#include <cstring>

typedef unsigned short bf16_t;
typedef float cf2 __attribute__((ext_vector_type(2)));
typedef short bf16x8 __attribute__((ext_vector_type(8)));
typedef float f32x4 __attribute__((ext_vector_type(4)));
typedef float f32x16 __attribute__((ext_vector_type(16)));
typedef unsigned u32x4 __attribute__((ext_vector_type(4)));
typedef unsigned u32x2 __attribute__((ext_vector_type(2)));
#define LAS __attribute__((address_space(3)))

#define DI __device__ __forceinline__

constexpr int NTOK = 33792, NLAT = 32768, DM = 1024, SEQ = 8192, CTXL = 256, NCHK = 132;
constexpr int P2W = 3072;
constexpr int PC_RGX = 0, PC_RGG = 512, PC_Q = 1024, PC_K = 1280, PC_V = 1536, PC_LAF = 2048, PC_LAB = 2304, PC_GG = 2560, PC_MG = 3072;
constexpr float NORM_EPS = 1e-6f;
constexpr size_t WS_CTL = 0;
constexpr size_t WS_MOD = 65536;
constexpr size_t WS_XCTX = WS_MOD + 491520;
constexpr size_t WS_H = WS_XCTX + 4194304;
constexpr size_t WS_YHT = WS_H, WS_YHY = WS_H + 33554432;
constexpr size_t WS_P2 = WS_H + 69206016;
constexpr size_t WS_Q = WS_P2, WS_SELI = WS_P2 + 138412032, WS_SELW = WS_SELI + 17301504;
constexpr size_t WS_GF = WS_P2 + 207618048;
constexpr size_t WS_HYT = WS_GF + 207618048;
constexpr size_t WS_HYTC = WS_HYT + 100663296;
constexpr size_t WS_M = WS_HYT;
constexpr size_t WS_HF = WS_HYT;
constexpr size_t WS_YRG = WS_HYT + 103809024;
constexpr size_t WS_YGLA = WS_YRG + 34603008;
constexpr size_t WS_SPEC = WS_YGLA + 34603008;
constexpr size_t WS_GST = WS_SPEC + 67108864;
constexpr size_t WS_HWT = WS_GST;
constexpr size_t WS_GDEC = WS_GST + 138412032;
constexpr size_t WS_RGAGG = WS_GDEC + 1081344;
constexpr size_t WS_RGCAR = WS_RGAGG + 4325376;
constexpr size_t WS_BTIN = WS_RGCAR + 2162688;
constexpr size_t WS_BTHY = WS_BTIN + 15728640;
constexpr size_t WS_BTRG = WS_BTHY + 1048576, WS_BTGLA = WS_BTRG + 1048576;
constexpr size_t WS_BTOUT = WS_BTGLA + 1048576;
constexpr size_t WS_BTWQ = WS_BTOUT + 2097152;
constexpr size_t WS_KEYS = WS_BTWQ + 4194304;
constexpr size_t WS_RGW = WS_KEYS + 524288;
constexpr size_t WS_PU = WS_RGW + 262144;
constexpr size_t WS_PV = WS_PU + 16777216;
constexpr size_t WS_RGAB = WS_PV + 8388608;
constexpr size_t WS_HWTC = WS_RGAB + 138412032;
constexpr size_t WS_SPART = WS_HWTC + 2097152;
constexpr size_t WS_W3T = WS_SPART + 272 * 2048 * 4;
constexpr size_t WS_END = WS_W3T + 4 * 2048 * 64 * 2;

constexpr int LDS_BIG = 131072, LDS_TW = 139264, LDS_BARW = 141312, LDS_BYTES = 147456;

#ifndef ABL
#define ABL 0
#endif
#ifndef PU_FP4
#define PU_FP4 1
#endif
#ifndef PV_FP4
#define PV_FP4 1
#endif
constexpr float PU_ISCALE = 96.0f, PH_ISCALE = 8.0f;
constexpr float PU_SCALE = PU_FP4 ? 54.4f : 1024.0f, PV_SCALE = PV_FP4 ? 3.4f : 64.0f;
struct Args {
    const float* in[38];
    float* out;
    unsigned char* ws;
    int ph_lo, ph_hi;
};

typedef __bf16 bfv2_t __attribute__((ext_vector_type(2)));
DI unsigned pk_bf16(float lo, float hi) { cf2 f; f.x = lo; f.y = hi; const bfv2_t r = __builtin_convertvector(f, bfv2_t); return __builtin_bit_cast(unsigned, r); }
DI bf16_t f2bf(float x) { return (bf16_t)(pk_bf16(x, 0.f) & 0xffffu); }
DI float bf2f(bf16_t u) { return __uint_as_float(((unsigned)u) << 16); }
DI float bflo(unsigned u) { return __uint_as_float(u << 16); }
DI float bfhi(unsigned u) { return __uint_as_float(u & 0xffff0000u); }
DI float sigmoidf_(float x) { return __builtin_amdgcn_rcpf(1.0f + __expf(-x)); }
DI float siluf_(float x) { return x * sigmoidf_(x); }
DI float geluf_(float x) { const float z = 1.5957691216057308f * (x + 0.044715f * x * x * x); return x * sigmoidf_(z); }
DI float logsigmoidf_(float x) { return -(fmaxf(-x, 0.f) + __logf(1.0f + __expf(-fabsf(x)))); }
DI cf2 mk2(float a, float b) { cf2 r; r.x = a; r.y = b; return r; }
DI cf2 cmul(cf2 a, cf2 b) { return mk2(a.x * b.x - a.y * b.y, a.x * b.y + a.y * b.x); }
DI cf2 cmulc(cf2 a, cf2 b) { return mk2(a.x * b.x + a.y * b.y, a.y * b.x - a.x * b.y); }
#define LDS_FENCE() asm volatile("s_waitcnt lgkmcnt(0)" ::: "memory")

#define XB_TMO      128
#define XB_XCNT(j)  (256  + 64 * (j))
#define XB_XSUB(j)  (1280 + 64 * (j))
#define XB_XGEN(j)  (2304 + 64 * (j))
#define XB_TOP      3328
#define XB_TOPGEN   3392
#define XCD_BAR_WORDS 3456
#define XB_SPIN_CAP (1u << 18)
__device__ __forceinline__ unsigned xb_ld(unsigned* p)              { return __hip_atomic_load(p, __ATOMIC_RELAXED, __HIP_MEMORY_SCOPE_AGENT); }
__device__ __forceinline__ unsigned xb_add(unsigned* p, unsigned v) { return __hip_atomic_fetch_add(p, v, __ATOMIC_RELAXED, __HIP_MEMORY_SCOPE_AGENT); }
__device__ __forceinline__ unsigned xb_xcc_id() { return (unsigned)__builtin_amdgcn_s_getreg((3 << 11) | 20) & 0xFu; }
#define XB_SPIN(cond, bar) do { unsigned _sp = 0; while (cond) { __builtin_amdgcn_s_sleep(1); \
    if ((++_sp & 255u) == 0u) { if (xb_ld(&(bar)[XB_TMO])) break; if (_sp > XB_SPIN_CAP) { atomicAdd(&(bar)[XB_TMO], 1u); break; } } } } while (0)
struct XcdBarrier { unsigned* bar; unsigned x; volatile LAS unsigned* st; };
__device__ __forceinline__ XcdBarrier xcd_barrier_post(unsigned* bar, volatile LAS unsigned* st) {
    XcdBarrier b; b.bar = bar; b.x = xb_xcc_id(); b.st = st;
    if (threadIdx.x == 0) (void)xb_add(&bar[XB_XCNT(b.x)], 1u);
    return b;
}
__device__ __forceinline__ void xcd_barrier_complete(unsigned* bar, unsigned x, unsigned& nloc, unsigned& nx) {
    const unsigned G = gridDim.x * gridDim.y * gridDim.z;
    unsigned sum, cnt, mine, sp = 0u;
    for (;;) {
        sum = 0u; cnt = 0u; mine = 0u;
#pragma unroll
        for (unsigned j = 0; j < 16; ++j) { const unsigned c = xb_ld(&bar[XB_XCNT(j)]); sum += c; cnt += (c > 0u) ? 1u : 0u; mine = (j == x) ? c : mine; }
        if (sum == G) break;
        __builtin_amdgcn_s_sleep(1);
        if ((++sp & 255u) == 0u) { if (xb_ld(&bar[XB_TMO])) break; if (sp > XB_SPIN_CAP) { atomicAdd(&bar[XB_TMO], 1u); break; } }
    }
    nloc = mine > 0u ? mine : 1u; nx = cnt > 0u ? cnt : 1u;
}
__device__ __forceinline__ void xcd_barrier(const XcdBarrier& b) {
    asm volatile("s_waitcnt vmcnt(0)" ::: "memory");
    __syncthreads();
    if (threadIdx.x == 0) {
        unsigned* bar = b.bar;
        __builtin_amdgcn_s_waitcnt(0);
        unsigned nloc = b.st[0], nx = b.st[1];
        if (nloc == 0u) { xcd_barrier_complete(bar, b.x, nloc, nx); b.st[0] = nloc; b.st[1] = nx; }
        const unsigned old = xb_add(&bar[XB_XSUB(b.x)], 1u);
        const unsigned gen = old / nloc;
        if (old + 1u == (gen + 1u) * nloc) {
            __builtin_amdgcn_fence(__ATOMIC_RELEASE, "agent");
            asm volatile("s_waitcnt vmcnt(0)" ::: "memory");
            const unsigned og = xb_add(&bar[XB_TOP], 1u);
            const unsigned tg = og / nx;
            if (og + 1u == (tg + 1u) * nx) xb_add(&bar[XB_TOPGEN], 1u);
            else XB_SPIN(xb_ld(&bar[XB_TOPGEN]) == tg, bar);
            __builtin_amdgcn_fence(__ATOMIC_ACQUIRE, "agent");
            xb_add(&bar[XB_XGEN(b.x)], 1u);
            asm volatile("s_waitcnt vmcnt(0)" ::: "memory");
        } else {
            XB_SPIN(xb_ld(&bar[XB_XGEN(b.x)]) == gen, bar);
            __builtin_amdgcn_fence(__ATOMIC_ACQUIRE, "agent");
            asm volatile("s_waitcnt vmcnt(0)" ::: "memory");
        }
    }
    __syncthreads();
}

namespace pg8 {
constexpr int BM = 256, BK = 64, HALF = 128, HTB = HALF * BK * 2, STAGE_BYTES = 8 * HTB, NXCD = 8, WGM = 8;
__host__ __device__ __forceinline__ int lds_byte(int r, int c) { const int st = (r >> 4) * 2 + (c >> 5), rr = r & 15, cc = c & 31, ob = rr * 64 + cc * 2; return st * 1024 + (ob ^ (((ob >> 9) & 1) << 5)); }
__host__ __device__ __forceinline__ void stage_rc(int b, int& R, int& C) { const int st = b / 1024, sb = b % 1024, swz = sb ^ (((sb >> 9) & 1) << 5); R = (st >> 1) * 16 + swz / 64; C = (st & 1) * 32 + (swz % 64) / 2; }
__host__ __device__ __forceinline__ int perm32(int rho) { const int n = rho >> 4, i = rho & 15; return 8 * (i >> 2) + 4 * n + (i & 3); }
struct Unit { int pm, pn, seg; };
struct StaticOrder {
    int nM, nN, nwg, G, c;
    __device__ void init(int M, int N, int G_, int c_) { nM = M / BM; nN = N / BM; nwg = nM * nN; G = G_; c = c_; }
    __device__ bool next(int i, Unit& u) const {
        const long L = (long)i * G + c; if (L >= nwg) return false;
        int wgid = (int)L; { const int q = nwg / NXCD, r = nwg % NXCD, xcd = wgid % NXCD, off = wgid / NXCD; wgid = (xcd < r ? xcd * (q + 1) : r * (q + 1) + (xcd - r) * q) + off; }
        const int nig = WGM * nN, gid = wgid / nig, fm = gid * WGM, gsz = (nM - fm) < WGM ? (nM - fm) : WGM;
        u.pm = fm + ((wgid % nig) % gsz); u.pn = (wgid % nig) / gsz; u.seg = 0; return true;
    }
};
template <class Epi, class Sched>
__device__ __forceinline__ void gemm_phase(LAS unsigned char* lds, const int K, const Sched& S, const Epi& E) {
    int tid_ = threadIdx.x; asm volatile("" : "+v"(tid_));
    const int tid = tid_, wid = __builtin_amdgcn_readfirstlane(tid >> 6), lane = tid & 63, wr = wid >> 2, wc = wid & 3, fr = lane & 15, fq = lane >> 4;
    const int nt = K / BK;
    unsigned voffA[2], voffB[2];
#pragma unroll
    for (int i = 0; i < 2; ++i) { int R, C; stage_rc(tid * 16 + i * 8192, R, C); const int Rb = Epi::PERM ? ((R & ~31) + perm32(R & 31)) : R;
        voffA[i] = (unsigned)(R * K + C) * 2u; voffB[i] = (unsigned)(Rb * K + C) * 2u; }
    const size_t kstep = (size_t)(BK * 2);
    const size_t hstep = (size_t)HALF * K * 2;
    const unsigned ldsw = (unsigned)wid * 1024u;
    const int aoff = lds_byte(wr * 64 + fr, fq * 8), boff = lds_byte(wc * 32 + fr, fq * 8);
#define PG8_SA(b, h) (((b) * 2 + (h)) * HTB)
#define PG8_SB(b, h) ((4 + (b) * 2 + (h)) * HTB)
#define PG8_STAGE(bufoff, gbase, voff) do { _Pragma("unroll") for (int _i = 0; _i < 2; ++_i) \
        __builtin_amdgcn_global_load_lds((const unsigned*)((const char*)(gbase) + (voff)[_i]), (LAS unsigned*)(lds + (bufoff) + ldsw + _i * 8192), 16, 0, 0); } while (0)
#define PG8_LDA(dst, b, h) do { _Pragma("unroll") for (int m = 0; m < 4; ++m) _Pragma("unroll") for (int k = 0; k < 2; ++k) dst[m][k] = *(const LAS bf16x8*)(lds + PG8_SA(b, h) + aoff + m * 2048 + k * 1024); } while (0)
#define PG8_LDB(dst, b, h) do { _Pragma("unroll") for (int n = 0; n < 2; ++n) _Pragma("unroll") for (int k = 0; k < 2; ++k) dst[n][k] = *(const LAS bf16x8*)(lds + PG8_SB(b, h) + boff + n * 2048 + k * 1024); } while (0)
#define PG8_MMA(ai, bj, At, Bt) do { __builtin_amdgcn_s_setprio(1); _Pragma("unroll") for (int m = 0; m < 4; ++m) _Pragma("unroll") for (int n = 0; n < 2; ++n) _Pragma("unroll") for (int k = 0; k < 2; ++k) \
        acc[ai][bj][m][n] = __builtin_amdgcn_mfma_f32_16x16x32_bf16(Bt[n][k], At[m][k], acc[ai][bj][m][n], 0, 0, 0); __builtin_amdgcn_s_setprio(0); } while (0)
#define PG8_WAIT_V(n) asm volatile("s_waitcnt vmcnt(" #n ")" ::: "memory")
#define PG8_WAIT_L(n) asm volatile("s_waitcnt lgkmcnt(" #n ")" ::: "memory")
#define PG8_BAR __builtin_amdgcn_s_barrier()
#define PG8_SCHED __builtin_amdgcn_sched_barrier(0)
    Unit cur, nxt; int ui = 0;
    if (!S.next(0, cur)) return;
    f32x4 acc[2][2][4][2];
#pragma unroll
    for (int a = 0; a < 2; ++a)
#pragma unroll
        for (int b = 0; b < 2; ++b)
#pragma unroll
            for (int m = 0; m < 4; ++m)
#pragma unroll
                for (int n = 0; n < 2; ++n) acc[a][b][m][n] = (f32x4){0.f, 0.f, 0.f, 0.f};
    bf16x8 At[4][2], B0[2][2], B1[2][2];
    const char* cA; const char* cB; S.ptrs(cur, cA, cB);
    PG8_STAGE(PG8_SB(0, 0), cB, voffB); PG8_STAGE(PG8_SA(0, 0), cA, voffA); PG8_STAGE(PG8_SB(0, 1), cB + hstep, voffB); PG8_STAGE(PG8_SA(0, 1), cA + hstep, voffA);
    if (wr == 1) PG8_BAR;
    PG8_WAIT_V(4); PG8_BAR;
    PG8_STAGE(PG8_SB(1, 0), cB + kstep, voffB); PG8_STAGE(PG8_SA(1, 0), cA + kstep, voffA); PG8_STAGE(PG8_SB(1, 1), cB + hstep + kstep, voffB);
    PG8_WAIT_V(6); PG8_BAR;
    for (;;) {
        const bool has_next = S.next(ui + 1, nxt);
        const char* nA = cA; const char* nB = cB; if (has_next) S.ptrs(nxt, nA, nB);
        for (int t = 0; t < nt; t += 2) {
            const bool last = (t == nt - 2);
            const char* a1 = cA + (size_t)(t + 1) * kstep;
            const char* a2 = last ? nA : cA + (size_t)(t + 2) * kstep; const char* b2 = last ? nB : cB + (size_t)(t + 2) * kstep;
            const char* a3 = a2 + kstep; const char* b3 = b2 + kstep;
            PG8_LDB(B0, 0, 0); PG8_SCHED; PG8_LDA(At, 0, 0); PG8_STAGE(PG8_SA(1, 1), a1 + hstep, voffA);
            PG8_WAIT_L(8); PG8_BAR; PG8_WAIT_L(0); PG8_MMA(0, 0, At, B0); PG8_BAR; PG8_SCHED;
            PG8_LDB(B1, 0, 1); PG8_STAGE(PG8_SB(0, 0), b2, voffB);
            PG8_BAR; PG8_WAIT_L(0); PG8_MMA(0, 1, At, B1); PG8_BAR;
            PG8_LDA(At, 0, 1); PG8_STAGE(PG8_SA(0, 0), a2, voffA);
            PG8_BAR; PG8_WAIT_L(0); PG8_MMA(1, 0, At, B0); PG8_BAR; PG8_SCHED;
            PG8_STAGE(PG8_SB(0, 1), b2 + hstep, voffB);
            PG8_WAIT_V(6); PG8_BAR; PG8_MMA(1, 1, At, B1); PG8_BAR;
            PG8_LDB(B0, 1, 0); PG8_SCHED; PG8_LDA(At, 1, 0); PG8_STAGE(PG8_SA(0, 1), a2 + hstep, voffA);
            PG8_WAIT_L(8); PG8_BAR; PG8_WAIT_L(0); PG8_MMA(0, 0, At, B0); PG8_BAR; PG8_SCHED;
            PG8_LDB(B1, 1, 1); PG8_STAGE(PG8_SB(1, 0), b3, voffB);
            PG8_BAR; PG8_WAIT_L(0); PG8_MMA(0, 1, At, B1); PG8_BAR;
            PG8_LDA(At, 1, 1); PG8_STAGE(PG8_SA(1, 0), a3, voffA);
            PG8_BAR; PG8_WAIT_L(0); PG8_MMA(1, 0, At, B0); PG8_BAR; PG8_SCHED;
            PG8_STAGE(PG8_SB(1, 1), b3 + hstep, voffB);
            PG8_WAIT_V(6); PG8_BAR; PG8_MMA(1, 1, At, B1); PG8_BAR;
        }
        const bool keep = E(acc, cur, wr, wc, fr, fq);
        if (!has_next) break;
        if (!keep) {
#pragma unroll
        for (int a = 0; a < 2; ++a)
#pragma unroll
            for (int b = 0; b < 2; ++b)
#pragma unroll
                for (int m = 0; m < 4; ++m)
#pragma unroll
                    for (int n = 0; n < 2; ++n) acc[a][b][m][n] = (f32x4){0.f, 0.f, 0.f, 0.f};
        }
        cur = nxt; cA = nA; cB = nB; ++ui;
    }
    PG8_WAIT_V(0);
    if (wr == 0) PG8_BAR;
    PG8_BAR;
#undef PG8_SA
#undef PG8_SB
#undef PG8_STAGE
#undef PG8_LDA
#undef PG8_LDB
#undef PG8_MMA
#undef PG8_WAIT_V
#undef PG8_WAIT_L
#undef PG8_BAR
#undef PG8_SCHED
}
}
struct Ctx {
    const float* const* in;
    float* out; unsigned char* ws; LAS unsigned char* lds;
    int tid, lane, wid, G, bid;
};
#define WSP(T, off) ((T*)(c.ws + (off)))

struct SchedIn {
    pg8::StaticOrder so; const char* H; const char* Bt;
    DI bool next(int i, pg8::Unit& u) const { return so.next(i, u); }
    DI void ptrs(const pg8::Unit& u, const char*& A, const char*& B) const { const size_t ts = (size_t)256 * 1024 * 2;
        if (u.pn < 6) { A = Bt + (size_t)u.pn * ts; B = H + (size_t)u.pm * ts; } else { A = H + (size_t)u.pm * ts; B = Bt + (size_t)u.pn * ts; } }
};
struct EpiIn {
    static constexpr bool PERM = true;
    bf16_t* P2; bf16_t* HYT; bf16_t* HYTC; const float* b_lr; const float* b_merge; bf16_t* GF;
    DI bool operator()(f32x4 (&acc)[2][2][4][2], const pg8::Unit& u, int wr, int wc, int fr, int fq) const {
        if (u.pn < 6) {
            bf16_t* base; size_t ld;
            if (u.pm < 128) { const int b = u.pm >> 5, t0 = (u.pm & 31) * 256; base = HYT + (size_t)b * 1536 * 8192 + t0; ld = 8192; }
            else { const int b = u.pm - 128; base = HYTC + (size_t)b * 1536 * 256; ld = 256; }
#pragma unroll
            for (int ai = 0; ai < 2; ++ai)
#pragma unroll
                for (int m = 0; m < 4; ++m) {
                    const int ch = 256 * u.pn + 128 * ai + 64 * wr + 16 * m + fr;
                    bf16_t* rowp = base + (size_t)ch * ld;
#pragma unroll
                    for (int bj = 0; bj < 2; ++bj) { const int tk = 128 * bj + 32 * wc + 8 * fq; const f32x4 v0 = acc[ai][bj][m][0], v1 = acc[ai][bj][m][1];
                        u32x4 w; w.x = pk_bf16(v0[0], v0[1]); w.y = pk_bf16(v0[2], v0[3]); w.z = pk_bf16(v1[0], v1[1]); w.w = pk_bf16(v1[2], v1[3]);
                        *(u32x4*)(rowp + tk) = w; }
                }
        } else {
            const int kind = (u.pn == 14 || u.pn == 15) ? 1 : (u.pn >= 18 ? 2 : 0);
            const int pc0 = 256 * (u.pn - 6);
#pragma unroll
            for (int bj = 0; bj < 2; ++bj) {
                const int cl = 128 * bj + 32 * wc + 8 * fq;
                float bias[8];
#pragma unroll
                for (int j = 0; j < 8; ++j) bias[j] = 0.f;
                if (kind == 1) { const float* bp = b_lr + (u.pn - 14) * 256 + cl;
#pragma unroll
                    for (int j = 0; j < 8; ++j) bias[j] = bp[j]; }
                if (kind == 2) { const float* bp = b_merge + (u.pn - 18) * 256 + cl;
#pragma unroll
                    for (int j = 0; j < 8; ++j) bias[j] = bp[j]; }
#pragma unroll
                for (int ai = 0; ai < 2; ++ai)
#pragma unroll
                    for (int m = 0; m < 4; ++m) {
                        const int row = 256 * u.pm + 128 * ai + 64 * wr + 16 * m + fr;
                        float v[8];
#pragma unroll
                        for (int j = 0; j < 4; ++j) { v[j] = acc[ai][bj][m][0][j] + bias[j]; v[4 + j] = acc[ai][bj][m][1][j] + bias[4 + j]; }
                        if (kind == 1) {
#pragma unroll
                            for (int j = 0; j < 8; ++j) v[j] = logsigmoidf_(v[j]) * 0.0625f; }
                        if (kind == 2) {
#pragma unroll
                            for (int j = 0; j < 8; ++j) v[j] = sigmoidf_(v[j]); }
                        u32x4 w; w.x = pk_bf16(v[0], v[1]); w.y = pk_bf16(v[2], v[3]); w.z = pk_bf16(v[4], v[5]); w.w = pk_bf16(v[6], v[7]);
                        if (kind == 2) *(u32x4*)(GF + ((((size_t)u.pm * 12 + (u.pn - 18)) * 8 + (wr * 4 + wc)) * 16 + (ai * 8 + m * 2 + bj)) * 512 + (fq * 16 + fr) * 8) = w;
                        else *(u32x4*)(P2 + (size_t)row * P2W + pc0 + cl) = w;
                    }
            }
        }
        return false;
    }
};
struct SchedMg {
    pg8::StaticOrder so; const char* ws;
    DI bool next(int i, pg8::Unit& u) const { if (!so.next(i / 3, u)) return false; u.seg = i % 3; return true; }
    DI void ptrs(const pg8::Unit& u, const char*& A, const char*& B) const { const size_t ts = (size_t)256 * 512 * 2;
        const size_t yo = u.seg == 0 ? WS_YHY : (u.seg == 1 ? WS_YRG : WS_YGLA); const size_t bo = u.seg == 0 ? WS_BTHY : (u.seg == 1 ? WS_BTRG : WS_BTGLA);
        A = ws + yo + (size_t)u.pm * ts; B = ws + bo + (size_t)u.pn * ts; }
};
struct EpiMg {
    static constexpr bool PERM = true;
    unsigned char* ws;
    DI bool operator()(f32x4 (&acc)[2][2][4][2], const pg8::Unit& u, int wr, int wc, int fr, int fq) const {
        const bf16_t* GF = (const bf16_t*)(ws + WS_GF); bf16_t* M = (bf16_t*)(ws + WS_M);
        const bf16_t* g0 = GF + (((size_t)u.pm * 12 + (u.seg * 4 + u.pn)) * 8 + (wr * 4 + wc)) * 16 * 512 + (fq * 16 + fr) * 8;
        const bf16_t* g1 = g0 + (size_t)4 * 8 * 16 * 512;
#pragma unroll
        for (int ai = 0; ai < 2; ++ai) {
            u32x4 ga[4][2], gb[4][2];
#pragma unroll
            for (int m = 0; m < 4; ++m)
#pragma unroll
                for (int bj = 0; bj < 2; ++bj) { const int fi = (ai * 8 + m * 2 + bj) * 512; ga[m][bj] = *(const u32x4*)(g0 + fi); gb[m][bj] = u.seg < 2 ? *(const u32x4*)(g1 + fi) : (u32x4){0x3f803f80u, 0x3f803f80u, 0x3f803f80u, 0x3f803f80u}; }
            asm volatile("" ::: "memory");
#pragma unroll
            for (int m = 0; m < 4; ++m) {
                const int row = 256 * u.pm + 128 * ai + 64 * wr + 16 * m + fr;
#pragma unroll
                for (int bj = 0; bj < 2; ++bj) {
                    const int col = 256 * u.pn + 128 * bj + 32 * wc + 8 * fq;
                    const u32x4 a4 = ga[m][bj], b4 = gb[m][bj];
                    float f[8] = {bflo(a4.x), bfhi(a4.x), bflo(a4.y), bfhi(a4.y), bflo(a4.z), bfhi(a4.z), bflo(a4.w), bfhi(a4.w)};
                    if (u.seg < 2) {
                        f[0] *= __builtin_amdgcn_rcpf(bflo(b4.x)); f[1] *= __builtin_amdgcn_rcpf(bfhi(b4.x)); f[2] *= __builtin_amdgcn_rcpf(bflo(b4.y)); f[3] *= __builtin_amdgcn_rcpf(bfhi(b4.y));
                        f[4] *= __builtin_amdgcn_rcpf(bflo(b4.z)); f[5] *= __builtin_amdgcn_rcpf(bfhi(b4.z)); f[6] *= __builtin_amdgcn_rcpf(bflo(b4.w)); f[7] *= __builtin_amdgcn_rcpf(bfhi(b4.w)); }
#pragma unroll
                    for (int j = 0; j < 4; ++j) { acc[ai][bj][m][0][j] *= f[j]; acc[ai][bj][m][1][j] *= f[4 + j]; }
                    if (u.seg == 2) { const f32x4 v0 = acc[ai][bj][m][0], v1 = acc[ai][bj][m][1];
                        u32x4 w; w.x = pk_bf16(v0[0], v0[1]); w.y = pk_bf16(v0[2], v0[3]); w.z = pk_bf16(v1[0], v1[1]); w.w = pk_bf16(v1[2], v1[3]);
                        *(u32x4*)(M + (size_t)row * 1024 + col) = w; }
                }
            }
        }
        return u.seg != 2;
    }
};
struct SchedPlain {
    pg8::StaticOrder so; const char* A0; const char* B0; size_t ts;
    DI bool next(int i, pg8::Unit& u) const { return so.next(i, u); }
    DI void ptrs(const pg8::Unit& u, const char*& A, const char*& B) const { A = A0 + (size_t)u.pm * ts; B = B0 + (size_t)u.pn * ts; }
};
struct EpiOut {
    static constexpr bool PERM = false;
    const float* xsrc_lat; float* xdst_lat; float* xctx; const float* mod;
    DI bool operator()(f32x4 (&acc)[2][2][4][2], const pg8::Unit& u, int wr, int wc, int fr, int fq) const {
        const int b = u.pm < 128 ? (u.pm >> 5) : 4;
        const float* gt = mod + b * 6144 + 2048;
        f32x4 g[2][2];
#pragma unroll
        for (int bj = 0; bj < 2; ++bj)
#pragma unroll
            for (int n = 0; n < 2; ++n) g[bj][n] = *(const f32x4*)(gt + 256 * u.pn + 128 * bj + 32 * wc + 16 * n + 4 * fq);
#pragma unroll
        for (int ai = 0; ai < 2; ++ai)
#pragma unroll
        for (int mh = 0; mh < 2; ++mh) {
            f32x4 xv[2][2][2];
#pragma unroll
            for (int m2 = 0; m2 < 2; ++m2) { const int row = 256 * u.pm + 128 * ai + 64 * wr + 16 * (mh * 2 + m2) + fr;
                const float* sp = row < NLAT ? xsrc_lat + (size_t)row * 1024 : xctx + (size_t)(row - NLAT) * 1024;
#pragma unroll
                for (int bj = 0; bj < 2; ++bj)
#pragma unroll
                    for (int n = 0; n < 2; ++n) xv[m2][bj][n] = *(const f32x4*)(sp + 256 * u.pn + 128 * bj + 32 * wc + 16 * n + 4 * fq); }
            asm volatile("" ::: "memory");
#pragma unroll
            for (int m2 = 0; m2 < 2; ++m2) { const int m = mh * 2 + m2, row = 256 * u.pm + 128 * ai + 64 * wr + 16 * m + fr;
                float* dp = row < NLAT ? xdst_lat + (size_t)row * 1024 : xctx + (size_t)(row - NLAT) * 1024;
#pragma unroll
                for (int bj = 0; bj < 2; ++bj)
#pragma unroll
                    for (int n = 0; n < 2; ++n) { const int col = 256 * u.pn + 128 * bj + 32 * wc + 16 * n + 4 * fq; const f32x4 x = xv[m2][bj][n];
                        *(f32x4*)(dp + col) = (ABL & 16) ? x : x + g[bj][n] * acc[ai][bj][m][n]; } }
        }
        return false;
    }
};
struct EpiQ {
    static constexpr bool PERM = true;
    bf16_t* Q;
    DI bool operator()(f32x4 (&acc)[2][2][4][2], const pg8::Unit& u, int wr, int wc, int fr, int fq) const {
#pragma unroll
        for (int ai = 0; ai < 2; ++ai)
#pragma unroll
            for (int m = 0; m < 4; ++m) {
                const int row = 256 * u.pm + 128 * ai + 64 * wr + 16 * m + fr;
#pragma unroll
                for (int bj = 0; bj < 2; ++bj) { const int col = 256 * u.pn + 128 * bj + 32 * wc + 8 * fq; const f32x4 v0 = acc[ai][bj][m][0], v1 = acc[ai][bj][m][1];
                    u32x4 w; w.x = pk_bf16(v0[0], v0[1]); w.y = pk_bf16(v0[2], v0[3]); w.z = pk_bf16(v1[0], v1[1]); w.w = pk_bf16(v1[2], v1[3]);
                    *(u32x4*)(Q + (size_t)row * 2048 + col) = w; }
            }
        return false;
    }
};

DI void tr_tile(const Ctx& c_, const float* src, int lds_, int k0, int ns0, bf16_t* dst, int ldd, int n0);
DI void p0_prologue(const Ctx& c) {
    LAS float* cond = (LAS float*)c.lds;
    LAS float* red = cond + 5 * 1024;
    const float* cin = c.in[1]; const float* cctx = c.in[3]; const float* wmod = c.in[4]; const float* bmod = c.in[5];
    for (int i = c.tid; i < 5 * 1024; i += 512) { const int b = i >> 10, k = i & 1023; const float v = b < 4 ? cin[b * 1024 + k] : cctx[k]; cond[i] = siluf_(v); }
    __syncthreads();
    float* mod = WSP(float, WS_MOD);
    for (int item = c.bid; item < 384; item += c.G) {
        const int l = item / 96, col0 = (item % 96) * 64, col = col0 + c.lane, ks = c.wid;
        float a0 = 0.f, a1 = 0.f, a2 = 0.f, a3 = 0.f, a4 = 0.f;
        const float* w = wmod + ((size_t)l * 1024 + ks * 128) * 6144 + col;
#pragma unroll 8
        for (int k = 0; k < 128; ++k) { const float wv = w[(size_t)k * 6144]; const int kk = ks * 128 + k;
            a0 += cond[kk] * wv; a1 += cond[1024 + kk] * wv; a2 += cond[2048 + kk] * wv; a3 += cond[3072 + kk] * wv; a4 += cond[4096 + kk] * wv; }
        red[(c.wid * 5 + 0) * 64 + c.lane] = a0; red[(c.wid * 5 + 1) * 64 + c.lane] = a1; red[(c.wid * 5 + 2) * 64 + c.lane] = a2;
        red[(c.wid * 5 + 3) * 64 + c.lane] = a3; red[(c.wid * 5 + 4) * 64 + c.lane] = a4;
        __syncthreads();
        if (c.tid < 320) { const int b = c.tid >> 6, ln = c.tid & 63; float s = 0.f;
#pragma unroll
            for (int w8 = 0; w8 < 8; ++w8) s += red[(w8 * 5 + b) * 64 + ln];
            mod[(size_t)(l * 5 + b) * 6144 + col0 + ln] = s + bmod[(size_t)l * 6144 + col0 + ln]; }
        __syncthreads();
    }
    const float4* src = (const float4*)c.in[2]; float4* dst = (float4*)WSP(float, WS_XCTX);
    for (int i = c.bid * 512 + c.tid; i < 262144; i += c.G * 512) dst[i] = src[i];
    __syncthreads();
    for (int it = c.bid; it < 128; it += c.G)
        tr_tile(c, c.in[15] + (size_t)(it >> 5) * 64 * 2048, 2048, 0, (it & 31) * 64, WSP(bf16_t, WS_W3T) + (size_t)(it >> 5) * 2048 * 64, 64, (it & 31) * 64);
}

template <int WHICH>
DI void norm_row_to_h(const Ctx& c, int l, int r, const float* xlat_src) {
    const float* xr = r < NLAT ? xlat_src + (size_t)r * 1024 : WSP(float, WS_XCTX) + (size_t)(r - NLAT) * 1024;
    const int b = r < NLAT ? (r >> 13) : 4;
    const float* mod = WSP(float, WS_MOD) + (size_t)(l * 5 + b) * 6144 + (WHICH ? 3072 : 0);
    const float* g = c.in[WHICH ? 7 : 6] + (size_t)l * 1024;
    float v[16]; float s = 0.f;
#pragma unroll
    for (int i = 0; i < 2; ++i) { const f32x4 p = *(const f32x4*)(xr + i * 512 + c.lane * 8), q = *(const f32x4*)(xr + i * 512 + c.lane * 8 + 4);
#pragma unroll
        for (int j = 0; j < 4; ++j) { v[i * 8 + j] = p[j]; v[i * 8 + 4 + j] = q[j]; s += p[j] * p[j] + q[j] * q[j]; } }
#pragma unroll
    for (int o = 32; o; o >>= 1) s += __shfl_xor(s, o);
    const float rs = rsqrtf(s * (1.f / 1024.f) + NORM_EPS);
    bf16_t* hr = WSP(bf16_t, WS_H) + (size_t)r * 1024;
#pragma unroll
    for (int i = 0; i < 2; ++i) { const int c0 = i * 512 + c.lane * 8; float o[8];
#pragma unroll
        for (int j = 0; j < 8; ++j) o[j] = v[i * 8 + j] * rs * g[c0 + j] * (1.f + mod[1024 + c0 + j]) + mod[c0 + j];
        u32x4 w; w.x = pk_bf16(o[0], o[1]); w.y = pk_bf16(o[2], o[3]); w.z = pk_bf16(o[4], o[5]); w.w = pk_bf16(o[6], o[7]);
        *(u32x4*)(hr + c0) = w; }
}

DI void tr_tile(const Ctx& c_, const float* src, int lds_, int k0, int ns0, bf16_t* dst, int ldd, int n0) {
    Ctx c = c_; asm volatile("" : "+v"(c.tid));
    LAS float* t = (LAS float*)c.lds;
    { const int k = c.tid >> 3, nq = (c.tid & 7) * 8;
      const f32x4 a = *(const f32x4*)(src + (size_t)(k0 + k) * lds_ + ns0 + nq), b = *(const f32x4*)(src + (size_t)(k0 + k) * lds_ + ns0 + nq + 4);
#pragma unroll
      for (int j = 0; j < 4; ++j) { t[k * 65 + nq + j] = a[j]; t[k * 65 + nq + 4 + j] = b[j]; } }
    __syncthreads();
    { const int n = c.tid >> 3, kq = (c.tid & 7) * 8; float v[8];
#pragma unroll
      for (int j = 0; j < 8; ++j) v[j] = t[(kq + j) * 65 + n];
      u32x4 w; w.x = pk_bf16(v[0], v[1]); w.y = pk_bf16(v[2], v[3]); w.z = pk_bf16(v[4], v[5]); w.w = pk_bf16(v[6], v[7]);
      *(u32x4*)(dst + (size_t)(n0 + n) * ldd + k0 + kq) = w; }
    __syncthreads();
}
DI void tr_tile128(const Ctx& c_, const float* src, int lds_, int k0, int ns0, bf16_t* dst, int ldd, int n0) {
    Ctx c = c_; asm volatile("" : "+v"(c.tid));
    LAS float* t = (LAS float*)c.lds;
    { const int k = c.tid >> 2, nq = (c.tid & 3) * 32; const float* sp = src + (size_t)(k0 + k) * lds_ + ns0 + nq;
      f32x4 a[8];
#pragma unroll
      for (int j = 0; j < 8; ++j) a[j] = *(const f32x4*)(sp + 4 * j);
#pragma unroll
      for (int j = 0; j < 8; ++j) { t[k * 129 + nq + 4 * j] = a[j][0]; t[k * 129 + nq + 4 * j + 1] = a[j][1]; t[k * 129 + nq + 4 * j + 2] = a[j][2]; t[k * 129 + nq + 4 * j + 3] = a[j][3]; } }
    __syncthreads();
    { const int n = c.tid & 127, kq = (c.tid >> 7) * 32; bf16_t* dp = dst + (size_t)(n0 + n) * ldd + k0 + kq;
#pragma unroll
      for (int q = 0; q < 4; ++q) { float v[8];
#pragma unroll
          for (int j = 0; j < 8; ++j) v[j] = t[(kq + 8 * q + j) * 129 + n];
          u32x4 w; w.x = pk_bf16(v[0], v[1]); w.y = pk_bf16(v[2], v[3]); w.z = pk_bf16(v[4], v[5]); w.w = pk_bf16(v[6], v[7]);
          *(u32x4*)(dp + 8 * q) = w; } }
    __syncthreads();
}
DI void fold_tile(const Ctx& c, const float* win, const float* wlr, int d, int j0, int k0, bf16_t* dst) {
    LAS float* a = (LAS float*)c.lds;
    LAS float* b = a + 64 * 17;
    for (int i = c.tid; i < 1024; i += 512) { const int k = i >> 4, r = i & 15; a[k * 17 + r] = win[(size_t)(k0 + k) * 7200 + 3584 + d * 16 + r]; }
    for (int i = c.tid; i < 1024; i += 512) { const int r = i >> 6, j = i & 63; b[r * 64 + j] = wlr[(size_t)(d * 16 + r) * 256 + j0 + j]; }
    __syncthreads();
    { const int j = c.tid >> 3, kq = (c.tid & 7) * 8; float v[8];
#pragma unroll
      for (int q = 0; q < 8; ++q) { float s = 0.f;
#pragma unroll
          for (int r = 0; r < 16; ++r) s += a[(kq + q) * 17 + r] * b[r * 64 + j];
          v[q] = s; }
      u32x4 w; w.x = pk_bf16(v[0], v[1]); w.y = pk_bf16(v[2], v[3]); w.z = pk_bf16(v[4], v[5]); w.w = pk_bf16(v[6], v[7]);
      *(u32x4*)(dst + (size_t)(3584 + d * 256 + j0 + j) * 1024 + k0 + kq) = w; }
    __syncthreads();
}
DI void cvt_chunk(const Ctx& c, const float* src, bf16_t* dst) {
#pragma unroll
    for (int i = 0; i < 2; ++i) { const int o = (i * 512 + c.tid) * 8; const f32x4 a = *(const f32x4*)(src + o), b = *(const f32x4*)(src + o + 4);
        u32x4 w; w.x = pk_bf16(a[0], a[1]); w.y = pk_bf16(a[2], a[3]); w.z = pk_bf16(b[0], b[1]); w.w = pk_bf16(b[2], b[3]);
        *(u32x4*)(dst + o) = w; }
}

DI void cvt_chunk_fp8(const Ctx& c, const float* src, unsigned char* dst, float scale) {
    const int o = c.tid * 16; u32x4 w;
#pragma unroll
    for (int k = 0; k < 4; ++k) { const f32x4 a = *(const f32x4*)(src + o + 4 * k); int p = 0;
        p = __builtin_amdgcn_cvt_pk_fp8_f32(a[0] * scale, a[1] * scale, p, false); p = __builtin_amdgcn_cvt_pk_fp8_f32(a[2] * scale, a[3] * scale, p, true); w[k] = (unsigned)p; }
    *(u32x4*)(dst + o) = w;
}

DI void cvt_chunk_fp4(const Ctx& c, const float* src, unsigned char* dst, float scale) {
    const int o = c.tid * 16; u32x2 w;
#pragma unroll
    for (int k = 0; k < 2; ++k) { const f32x4 a = *(const f32x4*)(src + o + 8 * k), b = *(const f32x4*)(src + o + 8 * k + 4); unsigned p = 0;
        p = __builtin_amdgcn_cvt_scalef32_pk_fp4_f32(p, a[0] * scale, a[1] * scale, 1.0f, 0); p = __builtin_amdgcn_cvt_scalef32_pk_fp4_f32(p, a[2] * scale, a[3] * scale, 1.0f, 1);
        p = __builtin_amdgcn_cvt_scalef32_pk_fp4_f32(p, b[0] * scale, b[1] * scale, 1.0f, 2); p = __builtin_amdgcn_cvt_scalef32_pk_fp4_f32(p, b[2] * scale, b[3] * scale, 1.0f, 3); w[k] = p; }
    *(u32x2*)(dst + c.tid * 8) = w;
}
DI void cvt_chunk_int4_il(const Ctx& c, const float* src, unsigned char* dst, float scale) {
    const int o = c.tid * 16; u32x2 w;
#pragma unroll
    for (int k = 0; k < 2; ++k) { const f32x4 a = *(const f32x4*)(src + o + 8 * k), b = *(const f32x4*)(src + o + 8 * k + 4); unsigned p = 0;
#pragma unroll
        for (int j = 0; j < 4; ++j) { const int qa = (int)fminf(fmaxf(rintf(a[j] * scale), -8.f), 7.f), qb = (int)fminf(fmaxf(rintf(b[j] * scale), -8.f), 7.f);
            p |= ((unsigned)qa & 15u) << (4 * j); p |= ((unsigned)qb & 15u) << (4 * (4 + j)); }
        w[k] = p; }
    *(u32x2*)(dst + c.tid * 16) = w;
}
DI void cvt_chunk_fp4_il(const Ctx& c, const float* src, unsigned char* dst, float scale, int half) {
    const int o = c.tid * 16; u32x2 w;
#pragma unroll
    for (int k = 0; k < 2; ++k) { const f32x4 a = *(const f32x4*)(src + o + 8 * k), b = *(const f32x4*)(src + o + 8 * k + 4); unsigned p = 0;
        p = __builtin_amdgcn_cvt_scalef32_pk_fp4_f32(p, a[0] * scale, a[1] * scale, 1.0f, 0); p = __builtin_amdgcn_cvt_scalef32_pk_fp4_f32(p, a[2] * scale, a[3] * scale, 1.0f, 1);
        p = __builtin_amdgcn_cvt_scalef32_pk_fp4_f32(p, b[0] * scale, b[1] * scale, 1.0f, 2); p = __builtin_amdgcn_cvt_scalef32_pk_fp4_f32(p, b[2] * scale, b[3] * scale, 1.0f, 3); w[k] = p; }
    *(u32x2*)(dst + c.tid * 16 + half * 8) = w;
}

DI void hy_filter_tile(const Ctx& c_, int l, int pt) {
    Ctx c = c_; asm volatile("" : "+v"(c.tid)); c.lane = c.tid & 63;
    const bool isctx = pt >= 256; const int n = isctx ? 256 : 8192; const int t0 = isctx ? (pt - 256) * 16 : pt * 32; const int nth = isctx ? 1 : 2;
    LAS float* feats = (LAS float*)c.lds;
    LAS float* h1 = feats + 32 * 33;
    LAS float* h2 = h1 + 32 * 64;
    const float* w1 = c.in[11] + (size_t)l * 33 * 64; const float* b1 = c.in[12] + l * 64; const float* w2 = c.in[13] + (size_t)l * 64 * 64; const float* b2 = c.in[14] + l * 64;
    const float* w3 = c.in[15] + (size_t)l * 64 * 2048; const float* fr = c.in[16] + l * 64;
    for (int i = c.tid; i < 32 * 33; i += 512) { const int t = i / 33, f = i % 33; const float pos = (float)(t0 + t); float v;
        if (f == 0) v = pos / (float)(n - 1);
        else { const int bi = (f - 1) & 15; const float band = 1e-4f + (float)bi * ((15.0f - 1e-4f) / 15.0f); const float ang = (6.283185307179586f / (float)n) * pos * band;
            v = f <= 16 ? cosf(ang) : -sinf(ang); }
        feats[i] = v; }
    __syncthreads();
    for (int i = c.tid; i < 32 * 64; i += 512) { const int t = i >> 6, j = i & 63; float s = b1[j];
        for (int f = 0; f < 33; ++f) s += feats[t * 33 + f] * w1[f * 64 + j];
        h1[i] = sinf(fr[j] * s); }
    __syncthreads();
    for (int i = c.tid; i < 32 * 64; i += 512) { const int t = i >> 6, j = i & 63; float s = b2[j];
        for (int k = 0; k < 64; ++k) s += h1[t * 64 + k] * w2[k * 64 + j];
        h2[i] = sinf(fr[j] * s); }
    __syncthreads();
    {
        const bf16_t* w3t = WSP(bf16_t, WS_W3T) + (size_t)l * 2048 * 64;
        const int pos = c.lane & 31, kh = c.lane >> 5;
        bf16x8 bfr[4];
#pragma unroll
        for (int ks = 0; ks < 4; ++ks) { const LAS float* hp = h2 + pos * 64 + 16 * ks + 8 * kh; const f32x4 x0 = *(const LAS f32x4*)hp, x1 = *(const LAS f32x4*)(hp + 4);
            u32x4 w; w.x = pk_bf16(x0[0], x0[1]); w.y = pk_bf16(x0[2], x0[3]); w.z = pk_bf16(x1[0], x1[1]); w.w = pk_bf16(x1[2], x1[3]); bfr[ks] = __builtin_bit_cast(bf16x8, w); }
        const bool pv = pos < (isctx ? 16 : 32);
        const float tn = (float)(t0 + pos) / (float)(n - 1);
        float* hw = isctx ? WSP(float, WS_HWTC) : WSP(float, WS_HWT);
        float* spart = WSP(float, WS_SPART) + (size_t)pt * 2048;
#pragma unroll 1
        for (int nt = 0; nt < 8; ++nt) {
            const int nb = c.wid * 256 + nt * 32;
            f32x16 acc;
#pragma unroll
            for (int r = 0; r < 16; ++r) acc[r] = 0.f;
            bf16x8 af[4];
#pragma unroll
            for (int ks = 0; ks < 4; ++ks) af[ks] = *(const bf16x8*)(w3t + (size_t)(nb + pos) * 64 + 16 * ks + 8 * kh);
#pragma unroll
            for (int ks = 0; ks < 4; ++ks) acc = __builtin_amdgcn_mfma_f32_32x32x16_bf16(af[ks], bfr[ks], acc, 0, 0, 0);
#pragma unroll
            for (int r = 0; r < 16; ++r) {
                const int chn = nb + (r & 3) + 8 * (r >> 2) + 4 * kh;
                const float delta = fabsf(-15.350567286626973f + (float)(chn & 511) * ((-3.0701134573253946f + 15.350567286626973f) / 511.0f));
                const float v = pv ? acc[r] * __expf(-tn * delta) : 0.f;
                if (pv) hw[(size_t)chn * n + t0 + pos] = v;
                float as = fabsf(v);
                as += __int_as_float(__builtin_amdgcn_update_dpp(0, __float_as_int(as), 0xB1, 0xf, 0xf, false));
                as += __int_as_float(__builtin_amdgcn_update_dpp(0, __float_as_int(as), 0x4E, 0xf, 0xf, false));
                as += __int_as_float(__builtin_amdgcn_update_dpp(0, __float_as_int(as), 0x141, 0xf, 0xf, false));
                as += __int_as_float(__builtin_amdgcn_update_dpp(0, __float_as_int(as), 0x140, 0xf, 0xf, false));
                as += __shfl_xor(as, 16);
                if (pos == 0) spart[chn] = as;
            }
        }
    }
    __syncthreads();
}
DI int PADX(int a) { return a + ((a >> 6) << 2); }
DI cf2 cadd(cf2 a, cf2 b) { return mk2(a.x + b.x, a.y + b.y); }
DI cf2 csub(cf2 a, cf2 b) { return mk2(a.x - b.x, a.y - b.y); }
template <bool INV> DI cf2 cmuli(cf2 d) { return INV ? mk2(-d.y, d.x) : mk2(d.y, -d.x); }
template <bool INV> DI cf2 cmulw(cf2 a, float wr, float wi) { return INV ? mk2(a.x * wr + a.y * wi, a.y * wr - a.x * wi) : mk2(a.x * wr - a.y * wi, a.x * wi + a.y * wr); }
template <bool INV> DI void dft4(cf2& a0, cf2& a1, cf2& a2, cf2& a3) {
    const cf2 s0 = cadd(a0, a2), s1 = csub(a0, a2), s2 = cadd(a1, a3), s3 = cmuli<INV>(csub(a1, a3));
    a0 = cadd(s0, s2); a1 = cadd(s1, s3); a2 = csub(s0, s2); a3 = csub(s1, s3);
}
template <bool INV> DI void dft16(cf2 (&x)[16]) {
#pragma unroll
    for (int b = 0; b < 4; ++b) dft4<INV>(x[b], x[4 + b], x[8 + b], x[12 + b]);
    constexpr float C1 = 0.9238795325112867f, S1 = 0.3826834323650898f, C2 = 0.7071067811865476f;
    x[4 + 1] = cmulw<INV>(x[4 + 1], C1, -S1); x[4 + 2] = cmulw<INV>(x[4 + 2], C2, -C2); x[4 + 3] = cmulw<INV>(x[4 + 3], S1, -C1);
    x[8 + 1] = cmulw<INV>(x[8 + 1], C2, -C2); x[8 + 2] = cmulw<INV>(x[8 + 2], 0.f, -1.f); x[8 + 3] = cmulw<INV>(x[8 + 3], -C2, -C2);
    x[12 + 1] = cmulw<INV>(x[12 + 1], S1, -C1); x[12 + 2] = cmulw<INV>(x[12 + 2], -C2, -C2); x[12 + 3] = cmulw<INV>(x[12 + 3], -C1, S1);
#pragma unroll
    for (int cc = 0; cc < 4; ++cc) dft4<INV>(x[4 * cc], x[4 * cc + 1], x[4 * cc + 2], x[4 * cc + 3]);
}
template <bool INV>
DI void fft_pass16(const Ctx& c, int llog) {
    LAS cf2* z = (LAS cf2*)c.lds;
    const LAS cf2* twlo = (const LAS cf2*)(c.lds + LDS_TW);
    const LAS cf2* twhi = twlo + 128;
    const int lq = llog - 4, q = 1 << lq;
#pragma unroll 1
    for (int i = 0; i < 2; ++i) {
        const int b = c.tid + i * 512, j = b & (q - 1), base = ((b >> lq) << llog) + j;
        const int tk = j << (14 - llog);
        const cf2 w1 = cmul(twhi[tk >> 7], twlo[tk & 127]);
        cf2 w[16]; w[1] = w1; w[2] = cmul(w1, w1); w[3] = cmul(w[2], w1); w[4] = cmul(w[2], w[2]); w[5] = cmul(w[4], w1); w[6] = cmul(w[3], w[3]); w[7] = cmul(w[4], w[3]);
        w[8] = cmul(w[4], w[4]); w[9] = cmul(w[8], w1); w[10] = cmul(w[5], w[5]); w[11] = cmul(w[8], w[3]); w[12] = cmul(w[6], w[6]); w[13] = cmul(w[12], w1); w[14] = cmul(w[7], w[7]); w[15] = cmul(w[8], w[7]);
        cf2 x[16];
#pragma unroll
        for (int m = 0; m < 16; ++m) x[m] = z[PADX(base + m * q)];
        if (INV) {
#pragma unroll
            for (int r = 1; r < 16; ++r) x[r] = cmulc(x[r], w[r]);
        }
        dft16<INV>(x);
#pragma unroll
        for (int cc = 0; cc < 4; ++cc)
#pragma unroll
            for (int d = 0; d < 4; ++d) { const int r = cc + 4 * d; cf2 v = x[4 * cc + d]; if (!INV && r > 0) v = cmul(v, w[r]); z[PADX(base + r * q)] = v; }
    }
    __syncthreads();
}
template <bool INV>
DI void fft_pass4(const Ctx& c) {
    LAS cf2* z = (LAS cf2*)c.lds;
#pragma unroll 2
    for (int i = 0; i < 8; ++i) { const int b = c.tid + i * 512; LAS f32x4* p = (LAS f32x4*)(z + PADX(4 * b));
        const f32x4 u = p[0], v = p[1]; cf2 a0 = mk2(u[0], u[1]), a1 = mk2(u[2], u[3]), a2 = mk2(v[0], v[1]), a3 = mk2(v[2], v[3]);
        dft4<INV>(a0, a1, a2, a3);
        p[0] = (f32x4){a0.x, a0.y, a1.x, a1.y}; p[1] = (f32x4){a2.x, a2.y, a3.x, a3.y}; }
    __syncthreads();
}
template <bool INV>
DI void fft16k(const Ctx& c) {
    if (!INV) { fft_pass16<false>(c, 14); fft_pass16<false>(c, 10); fft_pass16<false>(c, 6); fft_pass4<false>(c); }
    else { fft_pass4<true>(c); fft_pass16<true>(c, 6); fft_pass16<true>(c, 10); fft_pass16<true>(c, 14); }
}
DI void tw_init(const Ctx& c) {
    LAS cf2* twlo = (LAS cf2*)(c.lds + LDS_TW);
    if (c.tid < 256) { const int k = c.tid < 128 ? c.tid : (c.tid - 128) * 128; float s, co; sincospif(-(float)k * (1.0f / 8192.0f), &s, &co); twlo[c.tid] = mk2(co, s); }
}
DI unsigned pk_f16(float a, float b) { typedef _Float16 h2 __attribute__((ext_vector_type(2))); h2 v; v.x = (_Float16)a; v.y = (_Float16)b; return __builtin_bit_cast(unsigned, v); }
DI cf2 unpk_f16(unsigned u) { typedef _Float16 h2 __attribute__((ext_vector_type(2))); const h2 v = __builtin_bit_cast(h2, u); return mk2((float)v.x, (float)v.y); }

DI void hy_spec_item(const Ctx& c_, int o, int cch) {
    Ctx c = c_; asm volatile("" : "+v"(c.tid)); c.lane = c.tid & 63;
    LAS cf2* z = (LAS cf2*)c.lds;
    LAS float* red = (LAS float*)(c.lds + LDS_BARW + 64);
    const float* sp = WSP(float, WS_SPART);
    const float* hf = WSP(float, WS_HWT) + (size_t)(o * 1024 + cch) * 8192;
    const float* hb = WSP(float, WS_HWT) + (size_t)(o * 1024 + 512 + cch) * 8192;
    float hfv[16], hbv[16];
#pragma unroll
    for (int i = 0; i < 16; ++i) { const int p = c.tid + i * 512; hfv[i] = hf[p]; hbv[i] = hb[p == 0 ? 0 : 8192 - p]; }
    float s = 0.f;
    if (c.tid < 256) s = sp[(size_t)c.tid * 2048 + o * 1024 + cch] + sp[(size_t)c.tid * 2048 + o * 1024 + 512 + cch];
#pragma unroll
    for (int of = 32; of; of >>= 1) s += __shfl_xor(s, of);
    if (c.lane == 0) red[c.wid] = s;
    __syncthreads();
    float tot = 0.f;
#pragma unroll
    for (int w = 0; w < 8; ++w) tot += red[w];
    const float sc = 1.0f / (tot + 1e-6f);
#pragma unroll
    for (int i = 0; i < 16; ++i) { const int p = c.tid + i * 512;
        float v = hfv[i]; if (p == 0) v += hbv[i];
        z[PADX(p)] = mk2(v * sc, 0.f);
        const int p2 = 8192 + p;
        z[PADX(p2)] = mk2(p == 0 ? 0.f : hbv[i] * sc, 0.f); }
    __syncthreads();
    fft16k<false>(c);
    unsigned* dst = WSP(unsigned, WS_SPEC) + (size_t)(o * 512 + cch) * 16384;
#pragma unroll 8
    for (int i = 0; i < 32; ++i) { const int p = c.tid + i * 512; const cf2 v = z[PADX(p)]; dst[p] = pk_f16(v.x, v.y); }
    __syncthreads();
}

DI void hy_spec_pair_item(const Ctx& c_, int o, int cp) {
    Ctx c = c_; asm volatile("" : "+v"(c.tid)); c.lane = c.tid & 63;
    LAS cf2* z = (LAS cf2*)c.lds;
    LAS float* red = (LAS float*)(c.lds + LDS_BARW + 64);
    const float* sp = WSP(float, WS_SPART);
    const int cA = cp, cB = cp + 256;
    const float* hfA = WSP(float, WS_HWT) + (size_t)(o * 1024 + cA) * 8192; const float* hbA = WSP(float, WS_HWT) + (size_t)(o * 1024 + 512 + cA) * 8192;
    const float* hfB = WSP(float, WS_HWT) + (size_t)(o * 1024 + cB) * 8192; const float* hbB = WSP(float, WS_HWT) + (size_t)(o * 1024 + 512 + cB) * 8192;
    float fa[16], ba[16], fb[16], bb[16];
#pragma unroll
    for (int i = 0; i < 16; ++i) { const int p = c.tid + i * 512, pr = p == 0 ? 0 : 8192 - p; fa[i] = hfA[p]; ba[i] = hbA[pr]; fb[i] = hfB[p]; bb[i] = hbB[pr]; }
    { const int t = c.tid & 255, cc = c.tid < 256 ? cA : cB;
      float s = sp[(size_t)t * 2048 + o * 1024 + cc] + sp[(size_t)t * 2048 + o * 1024 + 512 + cc];
#pragma unroll
      for (int of = 32; of; of >>= 1) s += __shfl_xor(s, of);
      if (c.lane == 0) red[c.wid] = s; }
    __syncthreads();
    const float scA = 1.0f / (red[0] + red[1] + red[2] + red[3] + 1e-6f), scB = 1.0f / (red[4] + red[5] + red[6] + red[7] + 1e-6f);
#pragma unroll
    for (int i = 0; i < 16; ++i) { const int p = c.tid + i * 512;
        float va = fa[i], vb = fb[i]; if (p == 0) { va += ba[i]; vb += bb[i]; }
        z[PADX(p)] = mk2(va * scA, vb * scB);
        z[PADX(8192 + p)] = mk2(p == 0 ? 0.f : ba[i] * scA, p == 0 ? 0.f : bb[i] * scB); }
    __syncthreads();
    fft16k<false>(c);
    unsigned* dA = WSP(unsigned, WS_SPEC) + (size_t)(o * 512 + cA) * 16384; unsigned* dB = WSP(unsigned, WS_SPEC) + (size_t)(o * 512 + cB) * 16384;
#pragma unroll 4
    for (int i = 0; i < 32; ++i) { const int p = c.tid + i * 512;
        const int k = (p >> 10) + 16 * ((p >> 6) & 15) + 256 * ((p >> 2) & 15) + 4096 * (p & 3), kn = (16384 - k) & 16383;
        const int pn = 1024 * (kn & 15) + 64 * ((kn >> 4) & 15) + 4 * ((kn >> 8) & 15) + (kn >> 12);
        const cf2 u = z[PADX(p)], w = z[PADX(pn)];
        dA[p] = pk_f16(0.5f * (u.x + w.x), 0.5f * (u.y - w.y)); dB[p] = pk_f16(0.5f * (u.y + w.y), 0.5f * (w.x - u.x)); }
    __syncthreads();
}

DI void load_conv16(const bf16_t* row, int t0, int n, float w0, float w1, float w2, float cb, float (&o)[16]) {
    asm volatile("" : "+v"(t0));
    const u32x4 a = *(const u32x4*)(row + t0), b = *(const u32x4*)(row + t0 + 8);
    float x[18];
    x[0] = t0 > 0 ? bf2f(row[t0 - 1]) : 0.f; x[17] = t0 + 16 < n ? bf2f(row[t0 + 16]) : 0.f;
    x[1] = bflo(a.x); x[2] = bfhi(a.x); x[3] = bflo(a.y); x[4] = bfhi(a.y); x[5] = bflo(a.z); x[6] = bfhi(a.z); x[7] = bflo(a.w); x[8] = bfhi(a.w);
    x[9] = bflo(b.x); x[10] = bfhi(b.x); x[11] = bflo(b.y); x[12] = bfhi(b.y); x[13] = bflo(b.z); x[14] = bfhi(b.z); x[15] = bflo(b.w); x[16] = bfhi(b.w);
#pragma unroll
    for (int i = 0; i < 16; ++i) o[i] = cb + w0 * x[i] + w1 * x[i + 1] + w2 * x[i + 2];
}
struct RawRow { u32x4 a, b; bf16_t hm, hp; };
DI RawRow load_raw16(const bf16_t* row, int t0, int n) { RawRow r; r.a = *(const u32x4*)(row + t0); r.b = *(const u32x4*)(row + t0 + 8); r.hm = t0 > 0 ? row[t0 - 1] : (bf16_t)0; r.hp = t0 + 16 < n ? row[t0 + 16] : (bf16_t)0; return r; }
DI void conv_raw16(const RawRow& r, float w0, float w1, float w2, float cb, float (&o)[16]) {
    float x[18]; const u32x4 a = r.a, b = r.b;
    x[0] = bf2f(r.hm); x[17] = bf2f(r.hp);
    x[1] = bflo(a.x); x[2] = bfhi(a.x); x[3] = bflo(a.y); x[4] = bfhi(a.y); x[5] = bflo(a.z); x[6] = bfhi(a.z); x[7] = bflo(a.w); x[8] = bfhi(a.w);
    x[9] = bflo(b.x); x[10] = bfhi(b.x); x[11] = bflo(b.y); x[12] = bfhi(b.y); x[13] = bflo(b.z); x[14] = bfhi(b.z); x[15] = bflo(b.w); x[16] = bfhi(b.w);
#pragma unroll
    for (int i = 0; i < 16; ++i) o[i] = cb + w0 * x[i] + w1 * x[i + 1] + w2 * x[i + 2];
}
DI void spec_mul(const Ctx& c, const unsigned* spec) {
    LAS cf2* z = (LAS cf2*)c.lds;
#pragma unroll 1
    for (int hb = 0; hb < 4; ++hb) {
        unsigned sw[8];
#pragma unroll
        for (int i = 0; i < 8; ++i) sw[i] = spec[c.tid + (hb * 8 + i) * 512];
        asm volatile("" : "+v"(sw[0]), "+v"(sw[1]), "+v"(sw[2]), "+v"(sw[3]), "+v"(sw[4]), "+v"(sw[5]), "+v"(sw[6]), "+v"(sw[7]));
#pragma unroll
        for (int i = 0; i < 8; ++i) { const int p = c.tid + (hb * 8 + i) * 512; const cf2 hs = unpk_f16(sw[i]); z[PADX(p)] = cmul(z[PADX(p)], mk2(hs.x * (1.0f / 16384.0f), hs.y * (1.0f / 16384.0f))); }
    }
    __syncthreads();
}
DI void fft_mid_spec(const Ctx& c, const unsigned* spec) {
    LAS cf2* z = (LAS cf2*)c.lds;
    u32x4 sw[8];
#pragma unroll
    for (int i = 0; i < 8; ++i) sw[i] = *(const u32x4*)(spec + 4 * (c.tid + i * 512));
    asm volatile("" : "+v"(sw[0]), "+v"(sw[1]), "+v"(sw[2]), "+v"(sw[3]), "+v"(sw[4]), "+v"(sw[5]), "+v"(sw[6]), "+v"(sw[7]));
#pragma unroll 2
    for (int i = 0; i < 8; ++i) { const int b = c.tid + i * 512; LAS f32x4* p = (LAS f32x4*)(z + PADX(4 * b));
        const f32x4 u = p[0], v = p[1]; cf2 a0 = mk2(u[0], u[1]), a1 = mk2(u[2], u[3]), a2 = mk2(v[0], v[1]), a3 = mk2(v[2], v[3]);
        dft4<false>(a0, a1, a2, a3);
        { const cf2 h0 = unpk_f16(sw[i].x), h1 = unpk_f16(sw[i].y), h2 = unpk_f16(sw[i].z), h3 = unpk_f16(sw[i].w); constexpr float S = 1.0f / 16384.0f;
          a0 = cmul(a0, mk2(h0.x * S, h0.y * S)); a1 = cmul(a1, mk2(h1.x * S, h1.y * S)); a2 = cmul(a2, mk2(h2.x * S, h2.y * S)); a3 = cmul(a3, mk2(h3.x * S, h3.y * S)); }
        dft4<true>(a0, a1, a2, a3);
        p[0] = (f32x4){a0.x, a0.y, a1.x, a1.y}; p[1] = (f32x4){a2.x, a2.y, a3.x, a3.y}; }
    __syncthreads();
}
DI void hy_lat_item(const Ctx& c_, int l, int bp, int cch) {
    Ctx c = c_; asm volatile("" : "+v"(c.tid)); c.lane = c.tid & 63;
    LAS cf2* z = (LAS cf2*)c.lds;
    const float* cw = c.in[9] + (size_t)l * 3 * 1536; const float* cbv = c.in[10] + (size_t)l * 1536; const float* skip = c.in[17] + (size_t)l * 2 * 512;
    const bf16_t* hyt = WSP(bf16_t, WS_HYT);
    const int t0 = c.tid * 16, pt0 = PADX(t0);
    const bf16_t* r0 = hyt + ((size_t)(2 * bp) * 1536) * 8192; const bf16_t* r1 = hyt + ((size_t)(2 * bp + 1) * 1536) * 8192;
    float a0[16], a1[16];
    { const int ch = cch; load_conv16(r0 + (size_t)ch * 8192, t0, 8192, cw[ch], cw[1536 + ch], cw[3072 + ch], cbv[ch], a0);
      load_conv16(r1 + (size_t)ch * 8192, t0, 8192, cw[ch], cw[1536 + ch], cw[3072 + ch], cbv[ch], a1); }
    const int pt1 = PADX(8192 + t0);
#pragma unroll 1
    for (int rd = 0; rd < 2; ++rd) {
        const int ch = 512 * (rd + 1) + cch;
#pragma unroll
        for (int i = 0; i < 16; ++i) { z[pt0 + i] = mk2(a0[i], a1[i]); z[pt1 + i] = mk2(0.f, 0.f); }
        const RawRow rx0 = load_raw16(r0 + (size_t)ch * 8192, t0, 8192), rx1 = load_raw16(r1 + (size_t)ch * 8192, t0, 8192);
        __syncthreads();
        fft_pass16<false>(c, 14); fft_pass16<false>(c, 10); fft_pass16<false>(c, 6);
        fft_mid_spec(c, WSP(unsigned, WS_SPEC) + (size_t)(rd * 512 + cch) * 16384);
        fft_pass16<true>(c, 6); fft_pass16<true>(c, 10); fft_pass16<true>(c, 14);
        float b0[16], b1[16];
        conv_raw16(rx0, cw[ch], cw[1536 + ch], cw[3072 + ch], cbv[ch], b0); conv_raw16(rx1, cw[ch], cw[1536 + ch], cw[3072 + ch], cbv[ch], b1);
        const float sk = skip[rd * 512 + cch];
#pragma unroll
        for (int i = 0; i < 16; ++i) { const cf2 y = z[pt0 + i]; a0[i] = b0[i] * (y.x + sk * a0[i]); a1[i] = b1[i] * (y.y + sk * a1[i]); }
    }
    bf16_t* yo0 = WSP(bf16_t, WS_YHT) + ((size_t)(2 * bp) * 512 + cch) * 8192 + t0; bf16_t* yo1 = WSP(bf16_t, WS_YHT) + ((size_t)(2 * bp + 1) * 512 + cch) * 8192 + t0;
    { u32x4 w; w.x = pk_bf16(a0[0], a0[1]); w.y = pk_bf16(a0[2], a0[3]); w.z = pk_bf16(a0[4], a0[5]); w.w = pk_bf16(a0[6], a0[7]); *(u32x4*)yo0 = w;
      w.x = pk_bf16(a0[8], a0[9]); w.y = pk_bf16(a0[10], a0[11]); w.z = pk_bf16(a0[12], a0[13]); w.w = pk_bf16(a0[14], a0[15]); *(u32x4*)(yo0 + 8) = w;
      w.x = pk_bf16(a1[0], a1[1]); w.y = pk_bf16(a1[2], a1[3]); w.z = pk_bf16(a1[4], a1[5]); w.w = pk_bf16(a1[6], a1[7]); *(u32x4*)yo1 = w;
      w.x = pk_bf16(a1[8], a1[9]); w.y = pk_bf16(a1[10], a1[11]); w.z = pk_bf16(a1[12], a1[13]); w.w = pk_bf16(a1[14], a1[15]); *(u32x4*)(yo1 + 8) = w; }
    __syncthreads();
}
DI void hy_ctx_item(const Ctx& c_, int l, int b, int cch) {
    Ctx c = c_; asm volatile("" : "+v"(c.lane));
    LAS float* wl = (LAS float*)(c.lds + c.wid * 8192);
    LAS float* tp1 = wl; LAS float* tp2 = wl + 512; LAS float* vv = wl + 1024; LAS float* zz = wl + 1280;
    const float* sp = WSP(float, WS_SPART); const float* hw = WSP(float, WS_HWTC);
    float sc[2];
#pragma unroll
    for (int o = 0; o < 2; ++o) { float s = 0.f; if (c.lane < 16) s = sp[(size_t)(256 + c.lane) * 2048 + o * 1024 + cch] + sp[(size_t)(256 + c.lane) * 2048 + o * 1024 + 512 + cch];
#pragma unroll
        for (int of = 8; of; of >>= 1) s += __shfl_xor(s, of);
        sc[o] = 1.0f / (__shfl(s, 0) + 1e-6f); }
#pragma unroll
    for (int o = 0; o < 2; ++o) { LAS float* tp = o ? tp2 : tp1; const float* hf = hw + (size_t)(o * 1024 + cch) * 256; const float* hb = hw + (size_t)(o * 1024 + 512 + cch) * 256;
        for (int i = c.lane; i < 511; i += 64) { const int d = i - 255; float v = d > 0 ? hf[d] : (d < 0 ? hb[-d] : hf[0] + hb[0]); tp[i] = v * sc[o]; } }
    const float* cw = c.in[9] + (size_t)l * 3 * 1536; const float* cbv = c.in[10] + (size_t)l * 1536; const float* skip = c.in[17] + (size_t)l * 2 * 512;
    const bf16_t* base = WSP(bf16_t, WS_HYTC) + (size_t)b * 1536 * 256;
    float xv[3][4];
#pragma unroll 1
    for (int g = 0; g < 3; ++g) { const int ch = g * 512 + cch; const bf16_t* r = base + (size_t)ch * 256; const float w0 = cw[ch], w1 = cw[1536 + ch], w2 = cw[3072 + ch], cb = cbv[ch];
        unsigned xr[12];
#pragma unroll
        for (int i = 0; i < 4; ++i) { const int t = c.lane + 64 * i; xr[3 * i] = r[t > 0 ? t - 1 : 0]; xr[3 * i + 1] = r[t]; xr[3 * i + 2] = r[t < 255 ? t + 1 : 255]; }
        asm volatile("" : "+v"(xr[0]), "+v"(xr[1]), "+v"(xr[2]), "+v"(xr[3]), "+v"(xr[4]), "+v"(xr[5]), "+v"(xr[6]), "+v"(xr[7]), "+v"(xr[8]), "+v"(xr[9]), "+v"(xr[10]), "+v"(xr[11]));
        float xg[4];
#pragma unroll
        for (int i = 0; i < 4; ++i) { const int t = c.lane + 64 * i; const float xm = t > 0 ? bf2f((bf16_t)xr[3 * i]) : 0.f, x0 = bf2f((bf16_t)xr[3 * i + 1]), xp = t < 255 ? bf2f((bf16_t)xr[3 * i + 2]) : 0.f; xg[i] = cb + w0 * xm + w1 * x0 + w2 * xp; }
#pragma unroll
        for (int i = 0; i < 4; ++i) { if (g == 0) xv[0][i] = xg[i]; else if (g == 1) xv[1][i] = xg[i]; else xv[2][i] = xg[i]; } }
#pragma unroll
    for (int i = 0; i < 4; ++i) vv[c.lane + 64 * i] = xv[0][i];
    LDS_FENCE();
    const float sk1 = skip[cch], sk2 = skip[512 + cch];
    float y[4]; const int lane = c.lane;
    { float s0 = 0.f, s1 = 0.f, s2 = 0.f, s3 = 0.f; const LAS float* t1 = tp1 + lane + 255;
#pragma unroll 4
      for (int k = 0; k < 256; k += 4) { const f32x4 v4 = *(const LAS f32x4*)(vv + k);
#pragma unroll
          for (int j = 0; j < 4; ++j) { const float vk = v4[j]; s0 += t1[-(k + j)] * vk; s1 += t1[64 - (k + j)] * vk; s2 += t1[128 - (k + j)] * vk; s3 += t1[192 - (k + j)] * vk; } }
      y[0] = xv[1][0] * (s0 + sk1 * xv[0][0]); y[1] = xv[1][1] * (s1 + sk1 * xv[0][1]); y[2] = xv[1][2] * (s2 + sk1 * xv[0][2]); y[3] = xv[1][3] * (s3 + sk1 * xv[0][3]); }
#pragma unroll
    for (int i = 0; i < 4; ++i) zz[lane + 64 * i] = y[i];
    LDS_FENCE();
    bf16_t* yo = WSP(bf16_t, WS_YHY) + (size_t)(NLAT + b * 256) * 512 + cch;
    { float s0 = 0.f, s1 = 0.f, s2 = 0.f, s3 = 0.f; const LAS float* t2 = tp2 + lane + 255;
#pragma unroll 4
      for (int k = 0; k < 256; k += 4) { const f32x4 v4 = *(const LAS f32x4*)(zz + k);
#pragma unroll
          for (int j = 0; j < 4; ++j) { const float vk = v4[j]; s0 += t2[-(k + j)] * vk; s1 += t2[64 - (k + j)] * vk; s2 += t2[128 - (k + j)] * vk; s3 += t2[192 - (k + j)] * vk; } }
      const float sv[4] = {s0, s1, s2, s3};
#pragma unroll
      for (int i = 0; i < 4; ++i) { const int t = lane + 64 * i; yo[(size_t)t * 512] = (ABL & 1) ? (bf16_t)0 : f2bf(xv[2][i] * (sv[i] + sk2 * y[i])); } }
    LDS_FENCE();
}
DI void yhy_tr_tile2(const Ctx& c_, int pair) {
    Ctx c = c_; asm volatile("" : "+v"(c.tid));
    LAS bf16_t* t = (LAS bf16_t*)c.lds;
    u32x4 a[2];
#pragma unroll
    for (int k = 0; k < 2; ++k) { const int it = pair * 2 + k, b = it >> 10, c0 = ((it >> 7) & 7) * 64, t0 = (it & 127) * 64; const int ch = c.tid >> 3, tq = (c.tid & 7) * 8;
        a[k] = *(const u32x4*)(WSP(bf16_t, WS_YHT) + ((size_t)b * 512 + c0 + ch) * 8192 + t0 + tq); }
#pragma unroll
    for (int k = 0; k < 2; ++k) { const int ch = c.tid >> 3, tq = (c.tid & 7) * 8; LAS unsigned* d = (LAS unsigned*)(t + k * 64 * 66 + ch * 66 + tq); d[0] = a[k].x; d[1] = a[k].y; d[2] = a[k].z; d[3] = a[k].w; }
    __syncthreads();
#pragma unroll
    for (int k = 0; k < 2; ++k) { const int it = pair * 2 + k, b = it >> 10, c0 = ((it >> 7) & 7) * 64, t0 = (it & 127) * 64; const int tk = c.tid >> 3, cq = (c.tid & 7) * 8; bf16_t v[8];
#pragma unroll
        for (int j = 0; j < 8; ++j) v[j] = t[k * 64 * 66 + (cq + j) * 66 + tk];
        u32x4 w; w.x = v[0] | ((unsigned)v[1] << 16); w.y = v[2] | ((unsigned)v[3] << 16); w.z = v[4] | ((unsigned)v[5] << 16); w.w = v[6] | ((unsigned)v[7] << 16);
        if (ABL & 1) w = (u32x4){0u, 0u, 0u, 0u};
        *(u32x4*)(WSP(bf16_t, WS_YHY) + (size_t)(b * 8192 + t0 + tk) * 512 + c0 + cq) = w; }
    __syncthreads();
}
template <bool FINAL, int D>
DI void rg_dir(const Ctx& c, int l, int b, int chunk) {
    int lane = c.lane; asm volatile("" : "+v"(lane));
    const int g = c.wid, ch = g * 64 + lane, fr = lane & 15, fq = lane >> 4;
    LAS unsigned char* wl = c.lds + c.wid * 16384;
    LAS bf16_t* xcs = (LAS bf16_t*)wl;
    LAS cf2* stg = (LAS cf2*)(wl + 2304);
    const bool isctx = chunk < 4;
    const int rowbase = isctx ? NLAT + b * 256 : b * 8192, seglen = isctx ? 256 : 8192, tbase = isctx ? chunk * 64 : (chunk - 4) * 64;
    const bf16_t* P2 = WSP(bf16_t, WS_P2);
    const int pd = (l * 2 + D) * 512 + ch;
    const float* cwp = c.in[18] + (size_t)(l * 2 + D) * 4 * 512 + ch;
    const float cw0 = cwp[0], cw1 = cwp[512], cw2 = cwp[1024], cw3 = cwp[1536], cb = c.in[19][pd], ba = c.in[21][pd], bx = c.in[23][pd];
    const float lam = c.in[24][pd]; const float cneg = -8.0f * log1pf(expf(-lam));
    bf16x8 wa[4][2], wx[4][2];
    { const bf16_t* wb = WSP(bf16_t, WS_RGW) + (size_t)((D * 2 + 0) * 8 + g) * 4096; const bf16_t* xb = WSP(bf16_t, WS_RGW) + (size_t)((D * 2 + 1) * 8 + g) * 4096;
#pragma unroll
      for (int nt = 0; nt < 4; ++nt)
#pragma unroll
          for (int ks = 0; ks < 2; ++ks) { wa[nt][ks] = *(const bf16x8*)(wb + (nt * 16 + fr) * 64 + fq * 8 + 32 * ks); wx[nt][ks] = *(const bf16x8*)(xb + (nt * 16 + fr) * 64 + fq * 8 + 32 * ks); } }
    float h = 0.f, Aagg = 1.f, Bagg = 0.f;
    if (FINAL) h = WSP(float, WS_RGCAR)[(size_t)((b * 2 + D) * NCHK + chunk) * 512 + ch];
    float* HF = WSP(float, WS_HF);
    float um3, um2, um1;
    { const int t3 = tbase + (D ? 66 : -3), t2 = tbase + (D ? 65 : -2), t1 = tbase + (D ? 64 : -1);
      um3 = (t3 >= 0 && t3 < seglen) ? bf2f(P2[(size_t)(rowbase + t3) * P2W + PC_RGX + ch]) : 0.f;
      um2 = (t2 >= 0 && t2 < seglen) ? bf2f(P2[(size_t)(rowbase + t2) * P2W + PC_RGX + ch]) : 0.f;
      um1 = (t1 >= 0 && t1 < seglen) ? bf2f(P2[(size_t)(rowbase + t1) * P2W + PC_RGX + ch]) : 0.f; }
    bf16_t uall[64];
#pragma unroll
    for (int s = 0; s < 64; ++s) { const int tok = tbase + (D ? 63 - s : s); uall[s] = P2[(size_t)(rowbase + tok) * P2W + PC_RGX + ch]; }
    asm volatile("" ::: "memory");
#pragma unroll
    for (int mt = 0; mt < 4; ++mt) {
        bf16_t uc[16], gc[16]; float hc[16];
#pragma unroll
        for (int q = 0; q < 16; ++q) { uc[q] = uall[mt * 16 + q]; gc[q] = 0; hc[q] = 0.f; }
        float xcf[16];
#pragma unroll
        for (int q = 0; q < 16; ++q) {
            const float u0 = bf2f(uc[q]);
            const float xc = cb + cw0 * um3 + cw1 * um2 + cw2 * um1 + cw3 * u0;
            xcf[q] = xc; xcs[q * 72 + lane] = f2bf(xc); um3 = um2; um2 = um1; um1 = u0; }
        LDS_FENCE();
        bf16x8 af[2];
#pragma unroll
        for (int ks = 0; ks < 2; ++ks) af[ks] = *(const LAS bf16x8*)(xcs + fr * 72 + fq * 8 + 32 * ks);
        f32x4 ar[4], ai[4];
#pragma unroll
        for (int nt = 0; nt < 4; ++nt) { ar[nt] = (f32x4){0.f, 0.f, 0.f, 0.f}; ai[nt] = (f32x4){0.f, 0.f, 0.f, 0.f};
#pragma unroll
            for (int ks = 0; ks < 2; ++ks) { ar[nt] = __builtin_amdgcn_mfma_f32_16x16x32_bf16(af[ks], wa[nt][ks], ar[nt], 0, 0, 0); ai[nt] = __builtin_amdgcn_mfma_f32_16x16x32_bf16(af[ks], wx[nt][ks], ai[nt], 0, 0, 0); } }
#pragma unroll
        for (int nt = 0; nt < 4; ++nt)
#pragma unroll
            for (int jj = 0; jj < 4; ++jj) stg[(fq * 4 + jj) * 64 + nt * 16 + fr] = mk2(ar[nt][jj], ai[nt][jj]);
        LDS_FENCE();
#pragma unroll
        for (int q = 0; q < 16; ++q) { const int s = mt * 16 + q, tokl = D ? 63 - s : s;
            const cf2 pre = stg[q * 64 + lane];
            const float r = sigmoidf_(pre.x + ba), ii = sigmoidf_(pre.y + bx);
            const float a = __expf(r * cneg);
            const float bb = sqrtf(fmaxf(1.0f - a * a, 0.f)) * ii * xcf[q];
            if (FINAL) { h = a * h + bb;
                const size_t row = (size_t)(rowbase + tbase + tokl);
                if (D == 0) HF[row * 512 + ch] = h;
                else WSP(bf16_t, WS_YRG)[row * 512 + ch] = (ABL & 2) ? (bf16_t)0 : f2bf((hc[q] + h) * geluf_(bf2f(gc[q]))); }
            else { const unsigned w = pk_bf16(r * cneg, bb);
                WSP(unsigned, WS_RGAB)[((size_t)(rowbase + tbase + tokl) * 2 + D) * 512 + ch] = w;
                const float a2 = __expf(bflo(w)), b2 = bfhi(w); Bagg = a2 * Bagg + b2; Aagg *= a2; } }
        LDS_FENCE();
    }
    if (!FINAL) WSP(cf2, WS_RGAGG)[(size_t)((b * 2 + D) * NCHK + chunk) * 512 + ch] = mk2(Aagg, Bagg);
}
template <bool FINAL>
DI void rg_item(const Ctx& c, int l, int item) {
    const int b = item / NCHK, chunk = item % NCHK;
    rg_dir<FINAL, 0>(c, l, b, chunk);
    rg_dir<FINAL, 1>(c, l, b, chunk);
}
DI void rg_c_item(const Ctx& c, int item) {
    int lane = c.lane; asm volatile("" : "+v"(lane));
    const int b = item / NCHK, chunk = item % NCHK, ch = c.wid * 64 + lane;
    LAS float* hb = (LAS float*)(c.lds + c.wid * 16384) + lane;
    const bool isctx = chunk < 4;
    const size_t r0 = (size_t)(isctx ? NLAT + b * 256 + chunk * 64 : b * 8192 + (chunk - 4) * 64);
    const unsigned* AB = WSP(unsigned, WS_RGAB) + ch; const bf16_t* GP = WSP(bf16_t, WS_P2) + PC_RGG + ch; bf16_t* YP = WSP(bf16_t, WS_YRG) + ch;
    const float* car = WSP(float, WS_RGCAR) + ch;
    {
        float h = car[(size_t)((b * 2 + 1) * NCHK + chunk) * 512];
        unsigned w[64];
#pragma unroll
        for (int q = 0; q < 64; ++q) w[q] = AB[((r0 + q) * 2 + 1) * 512];
        asm volatile("" ::: "memory");
#pragma unroll
        for (int s2 = 0; s2 < 64; ++s2) { const int tok = 63 - s2; h = __builtin_fmaf(__expf(bflo(w[tok])), h, bfhi(w[tok])); hb[tok * 64] = h; }
    }
    {
        float h = car[(size_t)((b * 2 + 0) * NCHK + chunk) * 512];
        unsigned w[64]; bf16_t g[64];
#pragma unroll
        for (int q = 0; q < 64; ++q) { w[q] = AB[((r0 + q) * 2 + 0) * 512]; g[q] = GP[(r0 + q) * P2W]; }
        asm volatile("" ::: "memory");
#pragma unroll
        for (int tok = 0; tok < 64; ++tok) { h = __builtin_fmaf(__expf(bflo(w[tok])), h, bfhi(w[tok]));
            YP[(r0 + tok) * 512] = (ABL & 2) ? (bf16_t)0 : f2bf((h + hb[tok * 64]) * geluf_(bf2f(g[tok]))); }
    }
}
DI int scan_order(int d, int i) { return d == 0 ? i : (i < 4 ? 3 - i : 135 - i); }
DI void rg_carry_scan(const Ctx& c) {
    for (int idx = c.bid * 512 + c.tid; idx < 4096; idx += c.G * 512) {
    const int bd = idx >> 9, ch = idx & 511, d = bd & 1;
    const cf2* agg = WSP(cf2, WS_RGAGG) + (size_t)bd * NCHK * 512 + ch; float* car = WSP(float, WS_RGCAR) + (size_t)bd * NCHK * 512 + ch;
    float cv = 0.f;
#pragma unroll 1
    for (int i0 = 0; i0 < NCHK; i0 += 12) {
        cf2 ab[12];
#pragma unroll
        for (int u = 0; u < 12; ++u) ab[u] = agg[(size_t)scan_order(d, i0 + u) * 512];
        asm volatile("" ::: "memory");
#pragma unroll
        for (int u = 0; u < 12; ++u) { car[(size_t)scan_order(d, i0 + u) * 512] = cv; cv = ab[u].x * cv + ab[u].y; }
    }
    }
}

DI int gla_row(int b, int chunk, int i) {
    if (chunk < 4) return NLAT + b * 256 + chunk * 64 + i;
    const int jl = chunk - 4; return b * 8192 + ((jl & 1) * 64 + i) * 64 + (jl >> 1);
}
DI void gla_a_item(const Ctx& c, int item) {
    const int h = item & 3, bc = item >> 2, b = bc / NCHK, chunk = bc % NCHK;
    int lane = c.lane; asm volatile("" : "+v"(lane));
    const int fr = lane & 15, fq = lane >> 4, tid = c.wid * 64 + lane;
    LAS bf16_t* vT = (LAS bf16_t*)c.lds;
    LAS bf16_t* kdT = vT + 128 * 68;
    const bf16_t* P2 = WSP(bf16_t, WS_P2);
    { const int s = tid >> 3, ec = (tid & 7) * 16; const bf16_t* vp = P2 + (size_t)gla_row(b, chunk, s) * P2W + PC_V + h * 128 + ec;
      const u32x4 a = *(const u32x4*)vp, bq = *(const u32x4*)(vp + 8);
      const unsigned w[8] = {a.x, a.y, a.z, a.w, bq.x, bq.y, bq.z, bq.w};
#pragma unroll
      for (int j = 0; j < 8; ++j) { vT[(ec + 2 * j) * 68 + s] = (bf16_t)(w[j] & 0xffffu); vT[(ec + 2 * j + 1) * 68 + s] = (bf16_t)(w[j] >> 16); } }
    {
        const int d = c.wid >> 2, qt = c.wid & 3, dk = lane;
        unsigned short lar[64]; unsigned short kr[16];
#pragma unroll
        for (int i = 0; i < 64; ++i) lar[i] = P2[(size_t)gla_row(b, chunk, i) * P2W + (d ? PC_LAB : PC_LAF) + h * 64 + dk];
#pragma unroll
        for (int j = 0; j < 16; ++j) kr[j] = P2[(size_t)gla_row(b, chunk, qt * 16 + j) * P2W + PC_K + h * 64 + dk];
        asm volatile("" ::: "memory");
        float tot = 0.f, before = 0.f;
#pragma unroll
        for (int i = 0; i < 64; ++i) { const float v = bf2f(lar[i]); tot += v; if (i < qt * 16) before += v; }
        LAS bf16_t* kd = kdT + d * 64 * 68 + dk * 68;
        if (d == 0) { float rem = tot - before;
#pragma unroll
            for (int q4 = 0; q4 < 4; ++q4) if (q4 == qt) {
#pragma unroll
                for (int j = 0; j < 16; ++j) { const int i = q4 * 16 + j; rem -= bf2f(lar[i]); kd[i] = f2bf(bf2f(kr[j]) * __expf(rem)); } }
        } else { float pre = before;
#pragma unroll
            for (int q4 = 0; q4 < 4; ++q4) if (q4 == qt) {
#pragma unroll
                for (int j = 0; j < 16; ++j) { const int i = q4 * 16 + j; kd[i] = f2bf(bf2f(kr[j]) * __expf(pre)); pre += bf2f(lar[i]); } }
        }
        if (qt == 0) WSP(float, WS_GDEC)[(size_t)((((b * 4 + h) * 2 + d) * NCHK) + chunk) * 64 + dk] = __expf(tot);
    }
    __syncthreads();
    {
        const int d = c.wid >> 2, eq = c.wid & 3;
        f32x4 acc[2][4];
#pragma unroll
        for (int et = 0; et < 2; ++et)
#pragma unroll
            for (int dt = 0; dt < 4; ++dt) acc[et][dt] = (f32x4){0.f, 0.f, 0.f, 0.f};
#pragma unroll
        for (int ks = 0; ks < 2; ++ks) {
            bf16x8 af[2], bfr[4];
#pragma unroll
            for (int et = 0; et < 2; ++et) { const LAS u32x2* p = (const LAS u32x2*)(vT + ((eq * 2 + et) * 16 + fr) * 68 + fq * 8 + 32 * ks); const u32x2 lo = p[0], hi = p[1]; u32x4 w = {lo.x, lo.y, hi.x, hi.y}; af[et] = __builtin_bit_cast(bf16x8, w); }
#pragma unroll
            for (int dt = 0; dt < 4; ++dt) { const LAS u32x2* p = (const LAS u32x2*)(kdT + d * 64 * 68 + (dt * 16 + fr) * 68 + fq * 8 + 32 * ks); const u32x2 lo = p[0], hi = p[1]; u32x4 w = {lo.x, lo.y, hi.x, hi.y}; bfr[dt] = __builtin_bit_cast(bf16x8, w); }
#pragma unroll
            for (int et = 0; et < 2; ++et)
#pragma unroll
                for (int dt = 0; dt < 4; ++dt) acc[et][dt] = __builtin_amdgcn_mfma_f32_16x16x32_bf16(af[et], bfr[dt], acc[et][dt], 0, 0, 0);
        }
        float* st = WSP(float, WS_GST) + (size_t)((((b * 4 + h) * 2 + d) * NCHK) + chunk) * 8192;
#pragma unroll
        for (int et = 0; et < 2; ++et)
#pragma unroll
            for (int dt = 0; dt < 4; ++dt)
#pragma unroll
                for (int jj = 0; jj < 4; ++jj) st[((eq * 2 + et) * 16 + fq * 4 + jj) * 64 + dt * 16 + fr] = acc[et][dt][jj];
    }
    __syncthreads();
}
DI void gla_state_scan(const Ctx& c) {
    for (int idx = c.bid * 512 + c.tid; idx < 131072; idx += c.G * 512) {
    const int chain = idx >> 12, e2 = idx & 4095, d = chain & 1, dk2 = (e2 & 31) * 2;
    cf2* st = (cf2*)(WSP(float, WS_GST) + (size_t)chain * NCHK * 8192) + e2;
    const cf2* dc = (const cf2*)(WSP(float, WS_GDEC) + (size_t)chain * NCHK * 64 + dk2);
    cf2 S = mk2(0.f, 0.f);
#pragma unroll 1
    for (int i0 = 0; i0 < NCHK; i0 += 4) {
        cf2 ds[4], de[4];
#pragma unroll
        for (int u = 0; u < 4; ++u) { const int ck = scan_order(d, i0 + u); ds[u] = st[(size_t)ck * 4096]; de[u] = dc[(size_t)ck * 32]; }
#pragma unroll
        for (int u = 0; u < 4; ++u) { const int ck = scan_order(d, i0 + u); st[(size_t)ck * 4096] = S; S = mk2(de[u].x * S.x + ds[u].x, de[u].y * S.y + ds[u].y); }
    }
    }
}
DI void gla_c_item(const Ctx& c, int l, int item) {
    const int hp = item & 1, bc = item >> 1, b = bc / NCHK, chunk = bc % NCHK;
    int lane = c.lane; asm volatile("" : "+v"(lane));
    const int hl = c.wid >> 2, it = c.wid & 3, h = hp * 2 + hl, fr = lane & 15, fq = lane >> 4;
    LAS unsigned char* hb = c.lds + hl * 63488;
    LAS bf16_t* qg = (LAS bf16_t*)hb;
    LAS bf16_t* kg = qg + 2 * 64 * 72;
    LAS bf16_t* vT = kg + 2 * 64 * 72;
    LAS bf16_t* Pw = vT + 128 * 68 + it * 16 * 72;
    const bf16_t* P2 = WSP(bf16_t, WS_P2);
    if (it < 2) {
        const int d = it, dk = lane; float cum = 0.f;
        LAS bf16_t* qd = qg + d * 64 * 72 + dk; LAS bf16_t* kd = kg + d * 64 * 72 + dk;
#pragma unroll 1
        for (int s0 = 0; s0 < 64; s0 += 16) {
            unsigned la[16], qq[16], kk[16];
#pragma unroll
            for (int j = 0; j < 16; ++j) { const int i = d ? 63 - (s0 + j) : s0 + j; const bf16_t* rp = P2 + (size_t)gla_row(b, chunk, i) * P2W;
                la[j] = rp[(d ? PC_LAB : PC_LAF) + h * 64 + dk]; qq[j] = rp[PC_Q + h * 64 + dk]; kk[j] = rp[PC_K + h * 64 + dk]; }
            asm volatile("" : "+v"(la[0]), "+v"(la[1]), "+v"(la[2]), "+v"(la[3]), "+v"(la[4]), "+v"(la[5]), "+v"(la[6]), "+v"(la[7]), "+v"(qq[0]), "+v"(qq[1]), "+v"(qq[2]), "+v"(qq[3]), "+v"(qq[4]), "+v"(qq[5]), "+v"(qq[6]), "+v"(qq[7]),
                         "+v"(kk[0]), "+v"(kk[1]), "+v"(kk[2]), "+v"(kk[3]), "+v"(kk[4]), "+v"(kk[5]), "+v"(kk[6]), "+v"(kk[7]));
            asm volatile("" : "+v"(la[8]), "+v"(la[9]), "+v"(la[10]), "+v"(la[11]), "+v"(la[12]), "+v"(la[13]), "+v"(la[14]), "+v"(la[15]), "+v"(qq[8]), "+v"(qq[9]), "+v"(qq[10]), "+v"(qq[11]), "+v"(qq[12]), "+v"(qq[13]), "+v"(qq[14]), "+v"(qq[15]),
                         "+v"(kk[8]), "+v"(kk[9]), "+v"(kk[10]), "+v"(kk[11]), "+v"(kk[12]), "+v"(kk[13]), "+v"(kk[14]), "+v"(kk[15]));
#pragma unroll
            for (int j = 0; j < 16; ++j) { const int i = d ? 63 - (s0 + j) : s0 + j;
                cum += bf2f((bf16_t)la[j]);
                const float qv = bf2f((bf16_t)qq[j]), kv = bf2f((bf16_t)kk[j]);
                qd[i * 72] = f2bf(qv * 0.125f * __expf(cum)); kd[i * 72] = f2bf(kv * __expf(-cum)); }
        }
    } else {
        const int t = (it - 2) * 64 + lane, s = t >> 1, e0 = (t & 1) * 64; const bf16_t* vp = P2 + (size_t)gla_row(b, chunk, s) * P2W + PC_V + h * 128 + e0;
#pragma unroll
        for (int q8 = 0; q8 < 8; ++q8) { const u32x4 a = *(const u32x4*)(vp + q8 * 8); const unsigned w[4] = {a.x, a.y, a.z, a.w};
#pragma unroll
            for (int j = 0; j < 4; ++j) { vT[(e0 + q8 * 8 + 2 * j) * 68 + s] = (bf16_t)(w[j] & 0xffffu); vT[(e0 + q8 * 8 + 2 * j + 1) * 68 + s] = (bf16_t)(w[j] >> 16); } }
    }
    __syncthreads();
#ifdef DEBUG_DET
    if (hp == 0) {
        const size_t slot = (size_t)(bc * 2 + hl);
        unsigned* dq = (unsigned*)(c.ws + WS_END) + slot * 9216; const LAS unsigned* sq = (const LAS unsigned*)hb;
        for (int i = it * 64 + lane; i < 256 * 32; i += 256) dq[i] = sq[(i >> 5) * 36 + (i & 31)];
        unsigned* dv = (unsigned*)(c.ws + WS_END + 40000000) + slot * 4352; const LAS unsigned* sv = (const LAS unsigned*)vT;
        for (int i = it * 64 + lane; i < 128 * 32; i += 256) dv[i] = sv[(i >> 5) * 34 + (i & 31)];
    }
#endif
    f32x4 o[8];
#pragma unroll
    for (int et = 0; et < 8; ++et) o[et] = (f32x4){0.f, 0.f, 0.f, 0.f};
#pragma unroll
    for (int d = 0; d < 2; ++d) {
        bf16x8 qf[2];
#pragma unroll
        for (int ks = 0; ks < 2; ++ks) qf[ks] = *(const LAS bf16x8*)(qg + d * 64 * 72 + (it * 16 + fr) * 72 + fq * 8 + 32 * ks);
        f32x4 sc[4];
#pragma unroll
        for (int st = 0; st < 4; ++st) { sc[st] = (f32x4){0.f, 0.f, 0.f, 0.f};
#pragma unroll
            for (int ks = 0; ks < 2; ++ks) { const bf16x8 kf = *(const LAS bf16x8*)(kg + d * 64 * 72 + (st * 16 + fr) * 72 + fq * 8 + 32 * ks); sc[st] = __builtin_amdgcn_mfma_f32_16x16x32_bf16(qf[ks], kf, sc[st], 0, 0, 0); } }
#pragma unroll
        for (int st = 0; st < 4; ++st)
#pragma unroll
            for (int jj = 0; jj < 4; ++jj) { const int ig = it * 16 + fq * 4 + jj, sg = st * 16 + fr; const bool keep = d == 0 ? (sg <= ig) : (sg > ig);
                Pw[(fq * 4 + jj) * 72 + st * 16 + fr] = f2bf(keep ? sc[st][jj] : 0.f); }
        __syncthreads();
#ifdef DEBUG_DET
        if (hp == 0) { const size_t slot = (size_t)(((bc * 2 + hl) * 2 + d) * 4 + it);
            unsigned* dp = (unsigned*)(c.ws + WS_END + 60000000) + slot * 576; const LAS unsigned* sp = (const LAS unsigned*)Pw;
            for (int i = lane; i < 16 * 32; i += 64) dp[i] = sp[(i >> 5) * 36 + (i & 31)]; }
#endif
        bf16x8 pf[2];
#pragma unroll
        for (int ks = 0; ks < 2; ++ks) pf[ks] = *(const LAS bf16x8*)(Pw + fr * 72 + fq * 8 + 32 * ks);
        const float* stp = WSP(float, WS_GST) + (size_t)((((b * 4 + h) * 2 + d) * NCHK) + chunk) * 8192;
#pragma unroll
        for (int eh = 0; eh < 2; ++eh) {
            f32x4 sv[4][2][2];
#pragma unroll
            for (int e4 = 0; e4 < 4; ++e4)
#pragma unroll
                for (int ks = 0; ks < 2; ++ks) { const float* sp_ = stp + ((eh * 4 + e4) * 16 + fr) * 64 + fq * 8 + 32 * ks; sv[e4][ks][0] = *(const f32x4*)sp_; sv[e4][ks][1] = *(const f32x4*)(sp_ + 4); }
            asm volatile("" : "+v"(sv[0][0][0]), "+v"(sv[0][0][1]), "+v"(sv[0][1][0]), "+v"(sv[0][1][1]), "+v"(sv[1][0][0]), "+v"(sv[1][0][1]), "+v"(sv[1][1][0]), "+v"(sv[1][1][1]),
                         "+v"(sv[2][0][0]), "+v"(sv[2][0][1]), "+v"(sv[2][1][0]), "+v"(sv[2][1][1]), "+v"(sv[3][0][0]), "+v"(sv[3][0][1]), "+v"(sv[3][1][0]), "+v"(sv[3][1][1]));
#pragma unroll
            for (int e4 = 0; e4 < 4; ++e4) { const int et = eh * 4 + e4;
#pragma unroll
                for (int ks = 0; ks < 2; ++ks) {
                    const LAS u32x2* p = (const LAS u32x2*)(vT + (et * 16 + fr) * 68 + fq * 8 + 32 * ks); const u32x2 lo = p[0], hi = p[1]; u32x4 w = {lo.x, lo.y, hi.x, hi.y};
                    o[et] = __builtin_amdgcn_mfma_f32_16x16x32_bf16(pf[ks], __builtin_bit_cast(bf16x8, w), o[et], 0, 0, 0);
                    const f32x4 s0 = sv[e4][ks][0], s1 = sv[e4][ks][1];
                    u32x4 sw; sw.x = pk_bf16(s0[0], s0[1]); sw.y = pk_bf16(s0[2], s0[3]); sw.z = pk_bf16(s1[0], s1[1]); sw.w = pk_bf16(s1[2], s1[3]);
                    o[et] = __builtin_amdgcn_mfma_f32_16x16x32_bf16(qf[ks], __builtin_bit_cast(bf16x8, sw), o[et], 0, 0, 0);
                }
            }
        }
        __syncthreads();
#ifdef DEBUG_DET
        if (hp == 0 && b == 0) { const size_t slot = (size_t)(((chunk * 2 + hl) * 2 + d) * 4 + it);
            float* dp = (float*)(c.ws + WS_END + 80000000) + slot * 2048 + lane * 32;
#pragma unroll
            for (int et = 0; et < 8; ++et) *(f32x4*)(dp + et * 4) = o[et]; }
#endif
    }
    float ss[4];
#pragma unroll
    for (int jj = 0; jj < 4; ++jj) { float s = 0.f;
#pragma unroll
        for (int et = 0; et < 8; ++et) s += o[et][jj] * o[et][jj];
        s += __shfl_xor(s, 1); s += __shfl_xor(s, 2); s += __shfl_xor(s, 4); s += __shfl_xor(s, 8);
        ss[jj] = rsqrtf(s * (1.0f / 128.0f) + NORM_EPS); }
    const float* ng = c.in[27] + (size_t)l * 128;
    unsigned gv[4][8]; float ngv[8];
#pragma unroll
    for (int et = 0; et < 8; ++et) ngv[et] = ng[et * 16 + fr];
#pragma unroll
    for (int jj = 0; jj < 4; ++jj) { const bf16_t* gp = P2 + (size_t)gla_row(b, chunk, it * 16 + fq * 4 + jj) * P2W + PC_GG + h * 128;
#pragma unroll
        for (int et = 0; et < 8; ++et) gv[jj][et] = gp[et * 16 + fr]; }
#pragma unroll
    for (int jj = 0; jj < 4; ++jj) asm volatile("" : "+v"(gv[jj][0]), "+v"(gv[jj][1]), "+v"(gv[jj][2]), "+v"(gv[jj][3]), "+v"(gv[jj][4]), "+v"(gv[jj][5]), "+v"(gv[jj][6]), "+v"(gv[jj][7]));
#pragma unroll
    for (int jj = 0; jj < 4; ++jj) { const size_t row = (size_t)gla_row(b, chunk, it * 16 + fq * 4 + jj);
        bf16_t* yp = WSP(bf16_t, WS_YGLA) + row * 512 + h * 128;
#pragma unroll
        for (int et = 0; et < 8; ++et) { const int e = et * 16 + fr; yp[e] = (ABL & 4) ? (bf16_t)0 : f2bf(o[et][jj] * ss[jj] * ngv[et] * siluf_(bf2f((bf16_t)gv[jj][et]))); } }
    __syncthreads();
}
DI void ce(float& a, float& b) { const float t = fmaxf(a, b); b = fminf(a, b); a = t; }
DI void ce2(float& va, unsigned& pa, float& vb, unsigned& pb) { const bool s = va >= vb; const float hv = s ? va : vb, lv = s ? vb : va; const unsigned hp = s ? pa : pb, lp = s ? pb : pa; va = hv; vb = lv; pa = hp; pb = lp; }
DI void sort16(float (&x)[16]) {
#pragma unroll
    for (int kk = 1; kk <= 4; ++kk)
#pragma unroll
        for (int jj = kk - 1; jj >= 0; --jj)
#pragma unroll
            for (int i = 0; i < 16; ++i) { const int k = 1 << kk, j = 1 << jj, l = i ^ j; if (l > i) { if ((i & k) == 0) ce(x[i], x[l]); else ce(x[l], x[i]); } }
}
DI void merge16(float (&x)[16], const float (&y)[16]) {
#pragma unroll
    for (int i = 0; i < 16; ++i) x[i] = fmaxf(x[i], y[15 - i]);
#pragma unroll
    for (int jj = 3; jj >= 0; --jj)
#pragma unroll
        for (int i = 0; i < 16; ++i) { const int j = 1 << jj, l = i ^ j; if (l > i) ce(x[i], x[l]); }
}
DI void sort16p(float (&x)[16], unsigned (&p)[16]) {
#pragma unroll
    for (int kk = 1; kk <= 4; ++kk)
#pragma unroll
        for (int jj = kk - 1; jj >= 0; --jj)
#pragma unroll
            for (int i = 0; i < 16; ++i) { const int k = 1 << kk, j = 1 << jj, l = i ^ j; if (l > i) { if ((i & k) == 0) ce2(x[i], p[i], x[l], p[l]); else ce2(x[l], p[l], x[i], p[i]); } }
}
DI void merge16p(float (&x)[16], unsigned (&p)[16], const float (&y)[16], const unsigned (&q)[16]) {
#pragma unroll
    for (int i = 0; i < 16; ++i) { const bool s = x[i] >= y[15 - i]; p[i] = s ? p[i] : q[15 - i]; x[i] = s ? x[i] : y[15 - i]; }
#pragma unroll
    for (int jj = 3; jj >= 0; --jj)
#pragma unroll
        for (int i = 0; i < 16; ++i) { const int j = 1 << jj, l = i ^ j; if (l > i) ce2(x[i], p[i], x[l], p[l]); }
}
DI void peer_half_top16(const bf16_t* qrow, const bf16_t* keys, int lane, float (&res)[16]) {
    const int tl = lane & 31, hf = lane >> 5;
    f32x16 acc[4];
#pragma unroll
    for (int t4 = 0; t4 < 4; ++t4)
#pragma unroll
        for (int r = 0; r < 16; ++r) acc[t4][r] = 0.f;
    bf16x8 bq[8];
#pragma unroll
    for (int ks = 0; ks < 8; ++ks) bq[ks] = *(const bf16x8*)(qrow + 8 * hf + 16 * ks);
#pragma unroll
    for (int kp = 0; kp < 4; ++kp) {
        bf16x8 ak[2][4];
#pragma unroll
        for (int k4 = 0; k4 < 2; ++k4)
#pragma unroll
            for (int t4 = 0; t4 < 4; ++t4) ak[k4][t4] = *(const bf16x8*)(keys + (size_t)(t4 * 32 + tl) * 128 + 8 * hf + 16 * (kp * 2 + k4));
        asm volatile("" ::: "memory");
#pragma unroll
        for (int k4 = 0; k4 < 2; ++k4)
#pragma unroll
            for (int t4 = 0; t4 < 4; ++t4) acc[t4] = __builtin_amdgcn_mfma_f32_32x32x16_bf16(ak[k4][t4], bq[kp * 2 + k4], acc[t4], 0, 0, 0);
    }
    float L0[16], L1[16], L2[16], L3[16];
#pragma unroll
    for (int r = 0; r < 16; ++r) { const unsigned n = (unsigned)((r & 3) + 8 * (r >> 2) + 4 * hf);
        L0[r] = __uint_as_float((__float_as_uint(acc[0][r]) & ~127u) | n); L1[r] = __uint_as_float((__float_as_uint(acc[1][r]) & ~127u) | (32u + n));
        L2[r] = __uint_as_float((__float_as_uint(acc[2][r]) & ~127u) | (64u + n)); L3[r] = __uint_as_float((__float_as_uint(acc[3][r]) & ~127u) | (96u + n)); }
    sort16(L0); sort16(L1); sort16(L2); sort16(L3);
    merge16(L0, L1); merge16(L2, L3); merge16(L0, L2);
#pragma unroll
    for (int i = 0; i < 16; ++i) L1[i] = __shfl_xor(L0[i], 32);
    merge16(L0, L1);
#pragma unroll
    for (int i = 0; i < 16; ++i) res[i] = L0[i];
}
DI void peer_topk_wave(const Ctx& c, int tile, int h) {
    int lane = c.lane; asm volatile("" : "+v"(lane));
    const int tl = lane & 31, hf = lane >> 5; const size_t row = (size_t)tile * 32 + tl;
    const bf16_t* qrow = WSP(bf16_t, WS_Q) + row * 2048 + h * 256; const bf16_t* keys = WSP(bf16_t, WS_KEYS) + (size_t)h * 2 * 128 * 128;
    float A[16], B[16];
    peer_half_top16(qrow, keys, lane, A);
    peer_half_top16(qrow + 128, keys + 128 * 128, lane, B);
    LAS unsigned* tab = (LAS unsigned*)(c.lds + c.wid * 8192);
    float sa[16], sb[16];
#pragma unroll
    for (int i = 0; i < 16; ++i) { const unsigned ua = __float_as_uint(A[i]), ub = __float_as_uint(B[i]); sa[i] = __uint_as_float(ua & ~127u); sb[i] = __uint_as_float(ub & ~127u);
        tab[i * 64 + lane] = (ua & 127u) << 7; tab[(16 + i) * 64 + lane] = ub & 127u; }
#define PK2(i, j) __uint_as_float((__float_as_uint(sa[i] + sb[j]) & ~255u) | (unsigned)(((i) << 4) | (j)))
    float G0[16], G1[16];
#pragma unroll
    for (int j = 0; j < 16; ++j) G0[j] = PK2(0, j);
#pragma unroll
    for (int j = 0; j < 8; ++j) G1[j] = PK2(1, j);
#pragma unroll
    for (int j = 0; j < 5; ++j) G1[8 + j] = PK2(2, j);
#pragma unroll
    for (int j = 0; j < 3; ++j) G1[13 + j] = PK2(4, j);
    sort16(G1); merge16(G0, G1);
#pragma unroll
    for (int j = 0; j < 4; ++j) G1[j] = PK2(3, j);
#pragma unroll
    for (int i = 0; i < 3; ++i)
#pragma unroll
        for (int j = 0; j < 2; ++j) G1[4 + i * 2 + j] = PK2(5 + i, j);
#pragma unroll
    for (int i = 0; i < 6; ++i) G1[10 + i] = PK2(8 + i, 0);
    sort16(G1); merge16(G0, G1);
#pragma unroll
    for (int j = 0; j < 16; ++j) G1[j] = -3.0e38f;
    G1[0] = PK2(14, 0); G1[1] = PK2(15, 0); ce(G1[0], G1[1]);
    merge16(G0, G1);
#undef PK2
    LDS_FENCE();
    unsigned P0[16]; float den = 0.f; const float vmax = __uint_as_float(__float_as_uint(G0[0]) & ~255u);
#pragma unroll
    for (int i = 0; i < 16; ++i) { const unsigned u = __float_as_uint(G0[i]); const unsigned ci = (u >> 4) & 15u, cj = u & 15u;
        P0[i] = tab[ci * 64 + lane] | tab[(16 + cj) * 64 + lane];
        G0[i] = __expf(__uint_as_float(u & ~255u) - vmax); den += G0[i]; }
    const float inv = 1.0f / den;
    if (hf == 0) { unsigned* dp = WSP(unsigned, WS_SELI) + row * 128 + h * 16;
#pragma unroll
        for (int i = 0; i < 4; ++i) *(u32x4*)(dp + 4 * i) = (u32x4){P0[4 * i], P0[4 * i + 1], P0[4 * i + 2], P0[4 * i + 3]}; }
    else { float* dp = WSP(float, WS_SELW) + row * 128 + h * 16;
#pragma unroll
        for (int i = 0; i < 4; ++i) *(f32x4*)(dp + 4 * i) = (f32x4){G0[4 * i] * inv, G0[4 * i + 1] * inv, G0[4 * i + 2] * inv, G0[4 * i + 3] * inv}; }
    LDS_FENCE();
}

typedef float f32x2v __attribute__((ext_vector_type(2)));
DI float dot16_fp8(const u32x4 u, const float (&h)[16]) {
    f32x2v a0 = {0.f, 0.f}, a1 = {0.f, 0.f};
#pragma unroll
    for (int k = 0; k < 4; ++k) { const f32x2v lo = __builtin_amdgcn_cvt_pk_f32_fp8((int)u[k], false), hi = __builtin_amdgcn_cvt_pk_f32_fp8((int)u[k], true);
        const f32x2v h0 = {h[4 * k], h[4 * k + 1]}, h1 = {h[4 * k + 2], h[4 * k + 3]};
        a0 = __builtin_elementwise_fma(lo, h0, a0); a1 = __builtin_elementwise_fma(hi, h1, a1); }
    const f32x2v t = a0 + a1; return t.x + t.y;
}
DI void fma16_fp8(float (&acc)[16], const u32x4 v, float cf) {
#pragma unroll
    for (int k = 0; k < 4; ++k) { const f32x2v lo = __builtin_amdgcn_cvt_pk_f32_fp8((int)v[k], false), hi = __builtin_amdgcn_cvt_pk_f32_fp8((int)v[k], true);
        acc[4 * k] += cf * lo.x; acc[4 * k + 1] += cf * lo.y; acc[4 * k + 2] += cf * hi.x; acc[4 * k + 3] += cf * hi.y; }
}
#define FP4X(w, sel) __builtin_amdgcn_cvt_scalef32_pk_f32_fp4((w), 1.0f, (sel))
DI float dot16_fp4(const u32x2 u, const float (&h)[16]) {
    f32x2v a0 = {0.f, 0.f}, a1 = {0.f, 0.f};
#pragma unroll
    for (int k = 0; k < 2; ++k) { const unsigned w = u[k]; const f32x2v v0 = FP4X(w, 0), v1 = FP4X(w, 1), v2 = FP4X(w, 2), v3 = FP4X(w, 3);
        const f32x2v h0 = {h[8 * k], h[8 * k + 1]}, h1 = {h[8 * k + 2], h[8 * k + 3]}, h2 = {h[8 * k + 4], h[8 * k + 5]}, h3 = {h[8 * k + 6], h[8 * k + 7]};
        a0 = __builtin_elementwise_fma(v0, h0, a0); a1 = __builtin_elementwise_fma(v1, h1, a1); a0 = __builtin_elementwise_fma(v2, h2, a0); a1 = __builtin_elementwise_fma(v3, h3, a1); }
    const f32x2v t = a0 + a1; return t.x + t.y;
}
DI void fma16_fp4(float (&acc)[16], const u32x2 v, float cf) {
#pragma unroll
    for (int k = 0; k < 2; ++k) { const unsigned w = v[k]; const f32x2v v0 = FP4X(w, 0), v1 = FP4X(w, 1), v2 = FP4X(w, 2), v3 = FP4X(w, 3);
        acc[8 * k] += cf * v0.x; acc[8 * k + 1] += cf * v0.y; acc[8 * k + 2] += cf * v1.x; acc[8 * k + 3] += cf * v1.y; acc[8 * k + 4] += cf * v2.x; acc[8 * k + 5] += cf * v2.y; acc[8 * k + 6] += cf * v3.x; acc[8 * k + 7] += cf * v3.y; }
}
template <bool FINAL, bool SPLIT = false>
DI void peer_expert_token(const Ctx& c, int l, int r, const float* xsrc_lat) {
    int lane = c.lane; asm volatile("" : "+v"(lane));
    const int half = SPLIT ? (c.wid & 1) : 0;
    const bf16_t* hr = WSP(bf16_t, WS_H) + (size_t)r * 1024 + lane * 16;
    float h[16];
    { const u32x4 ha = *(const u32x4*)hr, hb = *(const u32x4*)(hr + 8);
      h[0] = bflo(ha.x); h[1] = bfhi(ha.x); h[2] = bflo(ha.y); h[3] = bfhi(ha.y); h[4] = bflo(ha.z); h[5] = bfhi(ha.z); h[6] = bflo(ha.w); h[7] = bfhi(ha.w);
      h[8] = bflo(hb.x); h[9] = bfhi(hb.x); h[10] = bflo(hb.y); h[11] = bfhi(hb.y); h[12] = bflo(hb.z); h[13] = bfhi(hb.z); h[14] = bflo(hb.w); h[15] = bfhi(hb.w); }
    const unsigned* si = WSP(unsigned, WS_SELI) + (size_t)r * 128; const float* sw = WSP(float, WS_SELW) + (size_t)r * 128;
    const unsigned idx_lo = si[lane], idx_hi = si[64 + lane]; const float w_lo = sw[lane], w_hi = sw[64 + lane];
    const __attribute__((address_space(1))) unsigned char* PUV = (const __attribute__((address_space(1))) unsigned char*)(c.ws + WS_PU); const unsigned lo16 = (unsigned)lane * 16u;
    unsigned hd[2][2] = {{0u, 0u}, {0u, 0u}};
#pragma unroll
    for (int i = 0; i < 16; ++i) { const int q = (int)fminf(fmaxf(rintf(h[i] * PH_ISCALE), -119.f), 119.f);
        const int d0 = ((q + 8) & 15) - 8, d1 = (q - d0) >> 4; const int sh = 4 * (i & 7);
        hd[0][i >> 3] |= ((unsigned)d0 & 15u) << sh; hd[1][i >> 3] |= ((unsigned)d1 & 15u) << sh; }
    float acc[16];
#pragma unroll
    for (int i = 0; i < 16; ++i) acc[i] = 0.f;
    const int myr = ((lane >> 5) & 1) * 4 + ((lane >> 4) & 1) * 2 + ((lane >> 3) & 1);
#pragma unroll 1
    for (int g2 = SPLIT ? half * 4 : 0; g2 < (SPLIT ? half * 4 + 4 : 8); ++g2) {
        const unsigned idxv = g2 < 4 ? idx_lo : idx_hi; const float wv = g2 < 4 ? w_lo : w_hi; const int l0 = (g2 * 16) & 63;
        unsigned e[16];
#pragma unroll
        for (int rr = 0; rr < 16; ++rr) e[rr] = (unsigned)__builtin_amdgcn_readlane((int)idxv, l0 + rr);
        u32x4 uv[16];
#pragma unroll
        for (int rr = 0; rr < 16; ++rr) uv[rr] = *(const __attribute__((address_space(1))) u32x4*)(PUV + (e[rr] * 1024u + lo16));
#pragma unroll
        for (int hf = 0; hf < 2; ++hf) {
            int p[8];
#pragma unroll
            for (int rr = 0; rr < 8; ++rr) { const int ux = (int)uv[hf * 8 + rr].x, uy = (int)uv[hf * 8 + rr].y;
                int t = __builtin_amdgcn_sdot8(uy, (int)hd[1][1], __builtin_amdgcn_sdot8(ux, (int)hd[1][0], 0, false), false);
                t = __builtin_amdgcn_sdot8(uy, (int)hd[0][1], __builtin_amdgcn_sdot8(ux, (int)hd[0][0], t * 16, false), false);
                p[rr] = t; }
            int q4[4], q2[2], q1i;
#pragma unroll
            for (int i = 0; i < 4; ++i) { const auto r = __builtin_amdgcn_permlane32_swap((unsigned)p[i], (unsigned)p[i + 4], false, false); q4[i] = (int)r[0] + (int)r[1]; }
#pragma unroll
            for (int i = 0; i < 2; ++i) { const auto r = __builtin_amdgcn_permlane16_swap((unsigned)q4[i], (unsigned)q4[i + 2], false, false); q2[i] = (int)r[0] + (int)r[1]; }
            { const bool up = (lane & 8) != 0; const int send = up ? q2[0] : q2[1]; const int keep = up ? q2[1] : q2[0];
              q1i = keep + __builtin_amdgcn_update_dpp(0, send, 0x128, 0xf, 0xf, false); }
            q1i += __builtin_amdgcn_update_dpp(0, q1i, 0xB1, 0xf, 0xf, false);
            q1i += __builtin_amdgcn_update_dpp(0, q1i, 0x4E, 0xf, 0xf, false);
            q1i += __builtin_amdgcn_update_dpp(0, q1i, 0x141, 0xf, 0xf, false);
            const float q1 = (float)q1i;
            const float wsel = __shfl(wv, l0 + hf * 8 + myr);
            const float coef = wsel * geluf_(q1 * (1.0f / (PU_ISCALE * PH_ISCALE))) * (1.0f / PV_SCALE);
#pragma unroll
            for (int rr = 0; rr < 8; ++rr) { const float cf = __int_as_float(__builtin_amdgcn_readlane(__float_as_int(coef), ((rr & 4) ? 32 : 0) + ((rr & 2) ? 16 : 0) + ((rr & 1) ? 8 : 0))); fma16_fp4(acc, (u32x2){uv[hf * 8 + rr].z, uv[hf * 8 + rr].w}, cf); }
        }
    }
    if (SPLIT) {
        LAS float* xb = (LAS float*)c.lds + (c.wid >> 1) * 1024 + lane;
        if (half) {
#pragma unroll
            for (int i = 0; i < 16; ++i) xb[i * 64] = acc[i];
        }
        __syncthreads();
        if (half) return;
#pragma unroll
        for (int i = 0; i < 16; ++i) acc[i] += xb[i * 64];
    }
    const int b = r < NLAT ? (r >> 13) : 4;
    const float* gt = WSP(float, WS_MOD) + (size_t)(l * 5 + b) * 6144 + 5120 + lane * 16;
    const float* xr = (r < NLAT ? xsrc_lat + (size_t)r * 1024 : WSP(float, WS_XCTX) + (size_t)(r - NLAT) * 1024) + lane * 16;
    float* xw = (r < NLAT ? c.out + (size_t)r * 1024 : WSP(float, WS_XCTX) + (size_t)(r - NLAT) * 1024) + lane * 16;
    float xn[16]; float s = 0.f;
#pragma unroll
    for (int k = 0; k < 4; ++k) { const f32x4 xa = *(const f32x4*)(xr + 4 * k), ga = *(const f32x4*)(gt + 4 * k);
#pragma unroll
        for (int j = 0; j < 4; ++j) xn[4 * k + j] = xa[j] + ((ABL & 8) ? 0.f : ga[j] * acc[4 * k + j]); }
    if (FINAL) {
#pragma unroll
        for (int i = 0; i < 16; ++i) s += xn[i] * xn[i];
#pragma unroll
        for (int o = 32; o; o >>= 1) s += __shfl_xor(s, o);
        const float rs = rsqrtf(s * (1.f / 1024.f) + NORM_EPS); const float* gf = c.in[37] + lane * 16;
#pragma unroll
        for (int i = 0; i < 16; ++i) xn[i] *= rs * gf[i];
    }
#pragma unroll
    for (int k = 0; k < 4; ++k) *(f32x4*)(xw + 4 * k) = (f32x4){xn[4 * k], xn[4 * k + 1], xn[4 * k + 2], xn[4 * k + 3]};
    if (!FINAL) {
        float s2 = 0.f;
#pragma unroll
        for (int i = 0; i < 16; ++i) s2 += xn[i] * xn[i];
#pragma unroll
        for (int o = 32; o; o >>= 1) s2 += __shfl_xor(s2, o);
        const float rs = rsqrtf(s2 * (1.f / 1024.f) + NORM_EPS);
        const float* g1 = c.in[6] + (size_t)(l + 1) * 1024 + lane * 16; const float* m1 = WSP(float, WS_MOD) + (size_t)((l + 1) * 5 + b) * 6144 + lane * 16;
        float o[16];
#pragma unroll
        for (int k = 0; k < 4; ++k) { const f32x4 ga = *(const f32x4*)(g1 + 4 * k), sh = *(const f32x4*)(m1 + 4 * k), sc = *(const f32x4*)(m1 + 1024 + 4 * k);
#pragma unroll
            for (int j = 0; j < 4; ++j) o[4 * k + j] = xn[4 * k + j] * rs * ga[j] * (1.f + sc[j]) + sh[j]; }
        bf16_t* hw = WSP(bf16_t, WS_H) + (size_t)r * 1024 + lane * 16;
        u32x4 w0, w1; w0.x = pk_bf16(o[0], o[1]); w0.y = pk_bf16(o[2], o[3]); w0.z = pk_bf16(o[4], o[5]); w0.w = pk_bf16(o[6], o[7]);
        w1.x = pk_bf16(o[8], o[9]); w1.y = pk_bf16(o[10], o[11]); w1.z = pk_bf16(o[12], o[13]); w1.w = pk_bf16(o[14], o[15]);
        *(u32x4*)hw = w0; *(u32x4*)(hw + 8) = w1;
    }
}
constexpr int PH_PER_LAYER = 11, N_PHASES = 1 + 4 * PH_PER_LAYER;

DI void prep_item(const Ctx& c, int l, int it) {
    if (it < 448) { int ng = (it >> 3) * 2; const int kg = it & 7; if (ng >= 56) ng += 8;
        const int n0 = ng * 64, ns0 = n0 < 3584 ? n0 : n0 - 480;
        tr_tile128(c, c.in[8] + (size_t)l * 1024 * 7200, 7200, kg * 128, ns0, WSP(bf16_t, WS_BTIN), 1024, n0); return; }
    it -= 448;
    if (it < 128) { const int d = it >> 6, jg = (it >> 4) & 3, kg = it & 15; fold_tile(c, c.in[8] + (size_t)l * 1024 * 7200, c.in[25] + (size_t)l * 2 * 16 * 256, d, jg * 64, kg * 64, WSP(bf16_t, WS_BTIN)); return; }
    it -= 128;
    if (it < 96) { const int w = it >> 5, r = it & 31, ng = r >> 2, kg = r & 3;
        tr_tile128(c, c.in[28 + w] + (size_t)l * 512 * 1024, 1024, kg * 128, ng * 128, WSP(bf16_t, w == 0 ? WS_BTHY : (w == 1 ? WS_BTRG : WS_BTGLA)), 512, ng * 128); return; }
    it -= 96;
    if (it < 64) { const int ng = it >> 3, kg = it & 7; tr_tile128(c, c.in[32] + (size_t)l * 1024 * 1024, 1024, kg * 128, ng * 128, WSP(bf16_t, WS_BTOUT), 1024, ng * 128); return; }
    it -= 64;
    if (it < 128) { const int ng = it >> 3, kg = it & 7; tr_tile128(c, c.in[33] + (size_t)l * 1024 * 2048, 2048, kg * 128, ng * 128, WSP(bf16_t, WS_BTWQ), 1024, ng * 128); return; }
    it -= 128;
    if (it < 32) { const int d = it >> 4, mat = (it >> 3) & 1, g = it & 7;
        tr_tile(c, c.in[mat ? 22 : 20] + (size_t)((l * 2 + d) * 8 + g) * 4096, 64, 0, 0, WSP(bf16_t, WS_RGW) + (size_t)((d * 2 + mat) * 8 + g) * 4096, 64, 0); return; }
    it -= 32;
    if (it < 32) { cvt_chunk(c, c.in[34] + (size_t)l * 262144 + (size_t)it * 8192, WSP(bf16_t, WS_KEYS) + (size_t)it * 8192); return; }
    it -= 32;
    if (it < 2048) { cvt_chunk_int4_il(c, c.in[35] + (size_t)l * 16777216 + (size_t)it * 8192, c.ws + WS_PU + (size_t)it * 8192, PU_ISCALE); return; }
    it -= 2048;
    cvt_chunk_fp4_il(c, c.in[36] + (size_t)l * 16777216 + (size_t)it * 8192, c.ws + WS_PU + (size_t)it * 8192, PV_SCALE, 1);
}
constexpr int N_PREP = 448 + 128 + 96 + 64 + 128 + 32 + 32 + 2048 + 2048;

__global__ void __launch_bounds__(512, 2) fwd_kernel(Args a) {
    extern __shared__ __attribute__((aligned(16))) unsigned char shm[];
    Ctx c0; c0.in = a.in; c0.out = a.out; c0.ws = a.ws; c0.lds = (LAS unsigned char*)shm;
    c0.tid = threadIdx.x; c0.lane = c0.tid & 63; c0.wid = __builtin_amdgcn_readfirstlane(c0.tid >> 6); c0.G = gridDim.x; c0.bid = blockIdx.x;
    const Ctx& c = c0;
    volatile LAS unsigned* barw = (volatile LAS unsigned*)(c.lds + LDS_BARW);
    if (c.tid < 4) barw[c.tid] = 0u;
    tw_init(c);
    __syncthreads();
    const int lo = a.ph_lo, hi = a.ph_hi;
    XcdBarrier bar; bar.bar = (unsigned*)(c.ws + WS_CTL); bar.x = 0; bar.st = barw;
    if (hi - lo > 1) bar = xcd_barrier_post((unsigned*)(c.ws + WS_CTL), barw);
#ifdef ONLY_PHASE
#define PHON(j) ((j) == ONLY_PHASE)
#else
#define PHON(j) 1
#endif
#ifdef ONLY_SUB
#define SUB(j) ((j) == ONLY_SUB)
#else
#define SUB(j) 1
#endif
#define PH_BEGIN() Ctx cc = c0; int ll = l0; asm volatile("" : "+s"(ll)); asm volatile("" : "+v"(cc.tid)); cc.lane = cc.tid & 63; cc.wid = __builtin_amdgcn_readfirstlane(cc.tid >> 6); asm volatile("" : "+s"(cc.bid)); const Ctx& c = cc; const int l = ll; (void)l;
#define IN(k) (lo <= (k) && (k) < hi)
#ifdef DEBUG_TIME
#define STAMP(k) do { if (c0.bid == 0 && c0.tid == 0) ((unsigned long long*)(c0.ws + WS_CTL + 40000))[(k)] = wall_clock64(); } while (0)
#else
#define STAMP(k) do {} while (0)
#endif
#define SEAM(k) do { if (IN(k) && IN((k) + 1)) xcd_barrier(bar); STAMP((k) + 1); } while (0)
    int ph = 0;
    STAMP(0);
    if (PHON(0) && IN(ph)) p0_prologue(c);
    SEAM(ph); ++ph;
#pragma unroll 1
    for (int l0 = 0; l0 < 4; ++l0) {
        if (PHON(1) && IN(ph)) { PH_BEGIN(); const float* xlat_in = l == 0 ? c.in[0] : c.out; const float* modl = WSP(float, WS_MOD) + (size_t)l * 5 * 6144; (void)xlat_in; (void)modl;
            for (int it = c.bid; it < 272; it += c.G) hy_filter_tile(c, l, it);
            const int NL = N_PREP + (l == 0 ? NTOK / 8 : 0);
#pragma unroll 1
            for (int k = 0; ; ++k) {
                int j;
                const int R = c.G > 16 ? 36 : 0, Gr = c.G - 16;
                if (k < R) { if (c.bid < 16) continue; j = k * Gr + c.bid - 16; if (j >= NL) continue; }
                else { j = R * Gr + (k - R) * c.G + c.bid; if (j >= NL) break; }
                if (j < N_PREP) prep_item(c, l, j);
                else norm_row_to_h<0>(c, l, (j - N_PREP) * 8 + c.wid, xlat_in);
            }
        }
        SEAM(ph); ++ph;
        if (PHON(2) && IN(ph)) { PH_BEGIN(); const float* xlat_in = l == 0 ? c.in[0] : c.out; const float* modl = WSP(float, WS_MOD) + (size_t)l * 5 * 6144; (void)xlat_in; (void)modl;
            SchedIn S; S.so.init(NTOK, 7680, c.G, c.bid); S.H = (const char*)WSP(bf16_t, WS_H); S.Bt = (const char*)WSP(bf16_t, WS_BTIN);
            EpiIn E{WSP(bf16_t, WS_P2), WSP(bf16_t, WS_HYT), WSP(bf16_t, WS_HYTC), c.in[26] + (size_t)l * 512, c.in[31] + (size_t)l * 3072, WSP(bf16_t, WS_GF)};
            if (SUB(0)) pg8::gemm_phase<EpiIn, SchedIn>(c.lds, 1024, S, E);
            __syncthreads();
            if (SUB(1)) for (int it = c.bid; it < 512; it += c.G) hy_spec_pair_item(c, it >> 8, it & 255);
        }
        SEAM(ph); ++ph;
        if (PHON(3) && IN(ph)) { PH_BEGIN(); const float* xlat_in = l == 0 ? c.in[0] : c.out; const float* modl = WSP(float, WS_MOD) + (size_t)l * 5 * 6144; (void)xlat_in; (void)modl;
#ifdef DEBUG_SUB
            for (int it = c.bid; it < 1024; it += c.G) hy_lat_item(c, l, it >> 9, it & 511);
            xcd_barrier(bar); if (c0.bid == 0 && c0.tid == 0) ((unsigned long long*)(c0.ws + WS_CTL + 48000))[l * 8 + 0] = wall_clock64();
            for (int it = c.bid; it < 256; it += c.G) { if (l < 3) { const int w = it * 8 + c.wid; hy_ctx_item(c, l, w >> 9, w & 511); } __syncthreads(); }
            xcd_barrier(bar); if (c0.bid == 0 && c0.tid == 0) ((unsigned long long*)(c0.ws + WS_CTL + 48000))[l * 8 + 1] = wall_clock64();
            for (int it = c.bid; it < 4 * NCHK; it += c.G) { rg_item<false>(c, l, it); __syncthreads(); }
            xcd_barrier(bar); if (c0.bid == 0 && c0.tid == 0) ((unsigned long long*)(c0.ws + WS_CTL + 48000))[l * 8 + 2] = wall_clock64();
            for (int it = c.bid; it < 16 * NCHK; it += c.G) gla_a_item(c, it);
#else
            const int n_items = 1024 + 256 + 4 * NCHK;
            for (int it = c.bid; it < n_items; it += c.G) {
                if (it < 1024) { if (SUB(0)) hy_lat_item(c, l, it >> 9, it & 511); }
                else if (it < 1280) { if (SUB(1) && l < 3) { const int w = (it - 1024) * 8 + c.wid; hy_ctx_item(c, l, w >> 9, w & 511); } __syncthreads(); }
                else { if (SUB(2)) { rg_item<false>(c, l, it - 1280); __syncthreads(); } }
            }
#pragma unroll 1
            for (int k = 0; ; ++k) {
                const int R = c.G > 16 ? 7 : 0, Gr = c.G - 16; int j;
                if (k < R) { if (c.bid < 16) continue; j = k * Gr + c.bid - 16; }
                else { j = R * Gr + (k - R) * c.G + c.bid; if (j >= 16 * NCHK) break; }
                if (SUB(3)) gla_a_item(c, j);
            }
#endif
        }
        SEAM(ph); ++ph;
        if (PHON(4) && IN(ph)) { PH_BEGIN(); const float* xlat_in = l == 0 ? c.in[0] : c.out; const float* modl = WSP(float, WS_MOD) + (size_t)l * 5 * 6144; (void)xlat_in; (void)modl;
            rg_carry_scan(c);
            gla_state_scan(c);
            if (c.G > 8) { if (c.bid >= 8) for (int it = c.bid - 8; it < 2048; it += c.G - 8) yhy_tr_tile2(c, it); }
            else for (int it = c.bid; it < 2048; it += c.G) yhy_tr_tile2(c, it);
        }
        SEAM(ph); ++ph;
        if (PHON(5) && IN(ph)) { PH_BEGIN(); const float* xlat_in = l == 0 ? c.in[0] : c.out; const float* modl = WSP(float, WS_MOD) + (size_t)l * 5 * 6144; (void)xlat_in; (void)modl;
#ifdef DEBUG_SUB
            for (int it = c.bid; it < 4 * NCHK; it += c.G) { rg_c_item(c, it); __syncthreads(); }
            xcd_barrier(bar); if (c0.bid == 0 && c0.tid == 0) ((unsigned long long*)(c0.ws + WS_CTL + 48000))[l * 8 + 4] = wall_clock64();
            for (int it = c.bid; it < 8 * NCHK; it += c.G) gla_c_item(c, l, it);
        }
#else
            const bool lat = l == 3; const int n_rg = lat ? 512 : 4 * NCHK, n_items = lat ? 512 + 1024 : 4 * NCHK + 8 * NCHK;
            for (int it = c.bid; it < n_items; it += c.G) {
                if (it < n_rg) { if (SUB(0)) { rg_c_item(c, lat ? (it >> 7) * NCHK + 4 + (it & 127) : it); __syncthreads(); } }
                else { const int j = it - n_rg, bc = j >> 1; if (SUB(1)) gla_c_item(c, l, lat ? ((((bc >> 7) * NCHK + 4 + (bc & 127)) << 1) | (j & 1)) : j); }
            }
        }
#endif
        SEAM(ph); ++ph;
        if (PHON(6) && IN(ph)) { PH_BEGIN(); const float* xlat_in = l == 0 ? c.in[0] : c.out; const float* modl = WSP(float, WS_MOD) + (size_t)l * 5 * 6144; (void)xlat_in; (void)modl;
            SchedMg S; S.so.init(l == 3 ? NLAT : NTOK, 1024, c.G, c.bid); S.ws = (const char*)c.ws;
            EpiMg E{c.ws};
            pg8::gemm_phase<EpiMg, SchedMg>(c.lds, 512, S, E);
        }
        SEAM(ph); ++ph;
        if (PHON(7) && IN(ph)) { PH_BEGIN(); const float* xlat_in = l == 0 ? c.in[0] : c.out; const float* modl = WSP(float, WS_MOD) + (size_t)l * 5 * 6144; (void)xlat_in; (void)modl;
            SchedPlain S; S.so.init(l == 3 ? NLAT : NTOK, 1024, c.G, c.bid); S.A0 = (const char*)WSP(bf16_t, WS_M); S.B0 = (const char*)WSP(bf16_t, WS_BTOUT); S.ts = (size_t)256 * 1024 * 2;
            EpiOut E{xlat_in, c.out, WSP(float, WS_XCTX), modl};
            pg8::gemm_phase<EpiOut, SchedPlain>(c.lds, 1024, S, E);
        }
        SEAM(ph); ++ph;
        if (PHON(8) && IN(ph)) { PH_BEGIN(); const float* xlat_in = l == 0 ? c.in[0] : c.out; const float* modl = WSP(float, WS_MOD) + (size_t)l * 5 * 6144; (void)xlat_in; (void)modl;
            for (int it = c.bid; it < (l == 3 ? NLAT : NTOK) / 8; it += c.G) norm_row_to_h<1>(c, l, it * 8 + c.wid, c.out);
        }
        SEAM(ph); ++ph;
        if (PHON(9) && IN(ph)) { PH_BEGIN(); const float* xlat_in = l == 0 ? c.in[0] : c.out; const float* modl = WSP(float, WS_MOD) + (size_t)l * 5 * 6144; (void)xlat_in; (void)modl;
            SchedPlain S; S.so.init(l == 3 ? NLAT : NTOK, 2048, c.G, c.bid); S.A0 = (const char*)WSP(bf16_t, WS_H); S.B0 = (const char*)WSP(bf16_t, WS_BTWQ); S.ts = (size_t)256 * 1024 * 2;
            EpiQ E{WSP(bf16_t, WS_Q)};
            pg8::gemm_phase<EpiQ, SchedPlain>(c.lds, 1024, S, E);
        }
        SEAM(ph); ++ph;
        if (PHON(10) && IN(ph)) { PH_BEGIN(); const float* xlat_in = l == 0 ? c.in[0] : c.out; const float* modl = WSP(float, WS_MOD) + (size_t)l * 5 * 6144; (void)xlat_in; (void)modl;
            for (int it = c.bid; it < (l == 3 ? NLAT : NTOK) / 32; it += c.G) peer_topk_wave(c, it, c.wid);
        }
        SEAM(ph); ++ph;
        if (PHON(11) && IN(ph)) { PH_BEGIN(); const float* xlat_in = l == 0 ? c.in[0] : c.out; const float* modl = WSP(float, WS_MOD) + (size_t)l * 5 * 6144; (void)xlat_in; (void)modl;
            if (l < 3) { for (int it = c.bid; it < NLAT / 8; it += c.G) peer_expert_token<false>(c, l, it * 8 + c.wid, c.out);
                for (int it = c.bid; it < (NTOK - NLAT) / 4; it += c.G) peer_expert_token<false, true>(c, l, NLAT + it * 4 + (c.wid >> 1), c.out); }
            else { for (int it = c.bid; it < NLAT / 8; it += c.G) peer_expert_token<true>(c, l, it * 8 + c.wid, c.out); }
        }
        SEAM(ph); ++ph;
    }
#undef IN
#undef SEAM
}

#if !defined(DEBUG_DET) && !defined(DEBUG_PEER) && !defined(DEBUG_TIME)
#ifndef N_LAUNCH_MODE
#define N_LAUNCH_MODE 0
#endif
extern "C" void kernel_launch(void* const* d_in, const int* in_sizes, int n_in, void* d_out, int out_size, void* d_ws, size_t ws_size, hipStream_t stream) {
    static int grid = 0;
    if (grid == 0) {
        if (n_in != 38 || ws_size < WS_END) { fprintf(stderr, "kernel_launch: need 38 inputs and %zu bytes of workspace (got %d, %zu)\n", (size_t)WS_END, n_in, ws_size); grid = -1; return; }
        int dev = 0, cus = 0, per_cu = 0;
        if (hipGetDevice(&dev) != hipSuccess || hipDeviceGetAttribute(&cus, hipDeviceAttributeMultiprocessorCount, dev) != hipSuccess) { grid = -1; return; }
        if (hipFuncSetAttribute((const void*)fwd_kernel, hipFuncAttributeMaxDynamicSharedMemorySize, LDS_BYTES) != hipSuccess) { fprintf(stderr, "kernel_launch: hipFuncSetAttribute failed\n"); grid = -1; return; }
        if (hipOccupancyMaxActiveBlocksPerMultiprocessor(&per_cu, (const void*)fwd_kernel, 512, LDS_BYTES) != hipSuccess || per_cu < 1) { fprintf(stderr, "kernel_launch: occupancy query says %d\n", per_cu); }
        (void)hipGetLastError();
        grid = cus;
    }
    if (grid < 0) return;
    (void)hipMemsetAsync((char*)d_ws + WS_CTL, 0, 65536, stream);
    Args a; memset(&a, 0, sizeof(a));
    for (int i = 0; i < 38; ++i) a.in[i] = (const float*)d_in[i];
    a.out = (float*)d_out; a.ws = (unsigned char*)d_ws;
#if N_LAUNCH_MODE == 1
    a.ph_lo = 0; a.ph_hi = N_PHASES;
    hipLaunchKernelGGL(fwd_kernel, dim3(grid), dim3(512), LDS_BYTES, stream, a);
#else
    for (int p = 0; p < N_PHASES; ++p) { a.ph_lo = p; a.ph_hi = p + 1; hipLaunchKernelGGL(fwd_kernel, dim3(grid), dim3(512), LDS_BYTES, stream, a); }
#endif
}
#endif
```

```cpp
#define N_LAUNCH_MODE 1
#include <hip/hip_runtime.h>
#include <stdint.h>
#include <cstdio>
#include <cstring>

typedef unsigned short bf16_t;
typedef float cf2 __attribute__((ext_vector_type(2)));
typedef short bf16x8 __attribute__((ext_vector_type(8)));
typedef float f32x4 __attribute__((ext_vector_type(4)));
typedef float f32x16 __attribute__((ext_vector_type(16)));
typedef unsigned u32x4 __attribute__((ext_vector_type(4)));
typedef unsigned u32x2 __attribute__((ext_vector_type(2)));
#define LAS __attribute__((address_space(3)))

#define DI __device__ __forceinline__

constexpr int NTOK = 33792, NLAT = 32768, DM = 1024, SEQ = 8192, CTXL = 256, NCHK = 132;
constexpr int P2W = 3072;
constexpr int PC_RGX = 0, PC_RGG = 512, PC_Q = 1024, PC_K = 1280, PC_V = 1536, PC_LAF = 2048, PC_LAB = 2304, PC_GG = 2560, PC_MG = 3072;
constexpr float NORM_EPS = 1e-6f;
constexpr size_t WS_CTL = 0;
constexpr size_t WS_MOD = 65536;
constexpr size_t WS_XCTX = WS_MOD + 491520;
constexpr size_t WS_H = WS_XCTX + 4194304;
constexpr size_t WS_YHT = WS_H, WS_YHY = WS_H + 33554432;
constexpr size_t WS_P2 = WS_H + 69206016;
constexpr size_t WS_Q = WS_P2, WS_SELI = WS_P2 + 138412032, WS_SELW = WS_SELI + 17301504;
constexpr size_t WS_GF = WS_P2 + 207618048;
constexpr size_t WS_HYT = WS_GF + 207618048;
constexpr size_t WS_HYTC = WS_HYT + 100663296;
constexpr size_t WS_M = WS_HYT;
constexpr size_t WS_HF = WS_HYT;
constexpr size_t WS_YRG = WS_HYT + 103809024;
constexpr size_t WS_YGLA = WS_YRG + 34603008;
constexpr size_t WS_SPEC = WS_YGLA + 34603008;
constexpr size_t WS_GST = WS_SPEC + 67108864;
constexpr size_t WS_HWT = WS_GST;
constexpr size_t WS_GDEC = WS_GST + 138412032;
constexpr size_t WS_RGAGG = WS_GDEC + 1081344;
constexpr size_t WS_RGCAR = WS_RGAGG + 4325376;
constexpr size_t WS_BTIN = WS_RGCAR + 2162688;
constexpr size_t WS_BTHY = WS_BTIN + 15728640;
constexpr size_t WS_BTRG = WS_BTHY + 1048576, WS_BTGLA = WS_BTRG + 1048576;
constexpr size_t WS_BTOUT = WS_BTGLA + 1048576;
constexpr size_t WS_BTWQ = WS_BTOUT + 2097152;
constexpr size_t WS_KEYS = WS_BTWQ + 4194304;
constexpr size_t WS_RGW = WS_KEYS + 524288;
constexpr size_t WS_PU = WS_RGW + 262144;
constexpr size_t WS_PV = WS_PU + 16777216;
constexpr size_t WS_RGAB = WS_PV + 8388608;
constexpr size_t WS_HWTC = WS_RGAB + 138412032;
constexpr size_t WS_SPART = WS_HWTC + 2097152;
constexpr size_t WS_W3T = WS_SPART + 272 * 2048 * 4;
constexpr size_t WS_END = WS_W3T + 4 * 2048 * 64 * 2;

constexpr int LDS_BIG = 131072, LDS_TW = 139264, LDS_BARW = 141312, LDS_BYTES = 147456;

#ifndef ABL
#define ABL 0
#endif
#ifndef PU_FP4
#define PU_FP4 1
#endif
#ifndef PV_FP4
#define PV_FP4 1
#endif
constexpr float PU_ISCALE = 96.0f, PH_ISCALE = 8.0f;
constexpr float PU_SCALE = PU_FP4 ? 54.4f : 1024.0f, PV_SCALE = PV_FP4 ? 3.4f : 64.0f;
struct Args {
    const float* in[38];
    float* out;
    unsigned char* ws;
    int ph_lo, ph_hi;
};

typedef __bf16 bfv2_t __attribute__((ext_vector_type(2)));
DI unsigned pk_bf16(float lo, float hi) { cf2 f; f.x = lo; f.y = hi; const bfv2_t r = __builtin_convertvector(f, bfv2_t); return __builtin_bit_cast(unsigned, r); }
DI bf16_t f2bf(float x) { return (bf16_t)(pk_bf16(x, 0.f) & 0xffffu); }
DI float bf2f(bf16_t u) { return __uint_as_float(((unsigned)u) << 16); }
DI float bflo(unsigned u) { return __uint_as_float(u << 16); }
DI float bfhi(unsigned u) { return __uint_as_float(u & 0xffff0000u); }
DI float sigmoidf_(float x) { return __builtin_amdgcn_rcpf(1.0f + __expf(-x)); }
DI float siluf_(float x) { return x * sigmoidf_(x); }
DI float geluf_(float x) { const float z = 1.5957691216057308f * (x + 0.044715f * x * x * x); return x * sigmoidf_(z); }
DI float logsigmoidf_(float x) { return -(fmaxf(-x, 0.f) + __logf(1.0f + __expf(-fabsf(x)))); }
DI cf2 mk2(float a, float b) { cf2 r; r.x = a; r.y = b; return r; }
DI cf2 cmul(cf2 a, cf2 b) { return mk2(a.x * b.x - a.y * b.y, a.x * b.y + a.y * b.x); }
DI cf2 cmulc(cf2 a, cf2 b) { return mk2(a.x * b.x + a.y * b.y, a.y * b.x - a.x * b.y); }
#define LDS_FENCE() asm volatile("s_waitcnt lgkmcnt(0)" ::: "memory")

#define XB_TMO      128
#define XB_XCNT(j)  (256  + 64 * (j))
#define XB_XSUB(j)  (1280 + 64 * (j))
#define XB_XGEN(j)  (2304 + 64 * (j))
#define XB_TOP      3328
#define XB_TOPGEN   3392
#define XCD_BAR_WORDS 3456
#define XB_SPIN_CAP (1u << 18)
__device__ __forceinline__ unsigned xb_ld(unsigned* p)              { return __hip_atomic_load(p, __ATOMIC_RELAXED, __HIP_MEMORY_SCOPE_AGENT); }
__device__ __forceinline__ unsigned xb_add(unsigned* p, unsigned v) { return __hip_atomic_fetch_add(p, v, __ATOMIC_RELAXED, __HIP_MEMORY_SCOPE_AGENT); }
__device__ __forceinline__ unsigned xb_xcc_id() { return (unsigned)__builtin_amdgcn_s_getreg((3 << 11) | 20) & 0xFu; }
#define XB_SPIN(cond, bar) do { unsigned _sp = 0; while (cond) { __builtin_amdgcn_s_sleep(1); \
    if ((++_sp & 255u) == 0u) { if (xb_ld(&(bar)[XB_TMO])) break; if (_sp > XB_SPIN_CAP) { atomicAdd(&(bar)[XB_TMO], 1u); break; } } } } while (0)
struct XcdBarrier { unsigned* bar; unsigned x; volatile LAS unsigned* st; };
__device__ __forceinline__ XcdBarrier xcd_barrier_post(unsigned* bar, volatile LAS unsigned* st) {
    XcdBarrier b; b.bar = bar; b.x = xb_xcc_id(); b.st = st;
    if (threadIdx.x == 0) (void)xb_add(&bar[XB_XCNT(b.x)], 1u);
    return b;
}
__device__ __forceinline__ void xcd_barrier_complete(unsigned* bar, unsigned x, unsigned& nloc, unsigned& nx) {
    const unsigned G = gridDim.x * gridDim.y * gridDim.z;
    unsigned sum, cnt, mine, sp = 0u;
    for (;;) {
        sum = 0u; cnt = 0u; mine = 0u;
#pragma unroll
        for (unsigned j = 0; j < 16; ++j) { const unsigned c = xb_ld(&bar[XB_XCNT(j)]); sum += c; cnt += (c > 0u) ? 1u : 0u; mine = (j == x) ? c : mine; }
        if (sum == G) break;
        __builtin_amdgcn_s_sleep(1);
        if ((++sp & 255u) == 0u) { if (xb_ld(&bar[XB_TMO])) break; if (sp > XB_SPIN_CAP) { atomicAdd(&bar[XB_TMO], 1u); break; } }
    }
    nloc = mine > 0u ? mine : 1u; nx = cnt > 0u ? cnt : 1u;
}
__device__ __forceinline__ void xcd_barrier(const XcdBarrier& b) {
    asm volatile("s_waitcnt vmcnt(0)" ::: "memory");
    __syncthreads();
    if (threadIdx.x == 0) {
        unsigned* bar = b.bar;
        __builtin_amdgcn_s_waitcnt(0);
        unsigned nloc = b.st[0], nx = b.st[1];
        if (nloc == 0u) { xcd_barrier_complete(bar, b.x, nloc, nx); b.st[0] = nloc; b.st[1] = nx; }
        const unsigned old = xb_add(&bar[XB_XSUB(b.x)], 1u);
        const unsigned gen = old / nloc;
        if (old + 1u == (gen + 1u) * nloc) {
            __builtin_amdgcn_fence(__ATOMIC_RELEASE, "agent");
            asm volatile("s_waitcnt vmcnt(0)" ::: "memory");
            const unsigned og = xb_add(&bar[XB_TOP], 1u);
            const unsigned tg = og / nx;
            if (og + 1u == (tg + 1u) * nx) xb_add(&bar[XB_TOPGEN], 1u);
            else XB_SPIN(xb_ld(&bar[XB_TOPGEN]) == tg, bar);
            __builtin_amdgcn_fence(__ATOMIC_ACQUIRE, "agent");
            xb_add(&bar[XB_XGEN(b.x)], 1u);
            asm volatile("s_waitcnt vmcnt(0)" ::: "memory");
        } else {
            XB_SPIN(xb_ld(&bar[XB_XGEN(b.x)]) == gen, bar);
            __builtin_amdgcn_fence(__ATOMIC_ACQUIRE, "agent");
            asm volatile("s_waitcnt vmcnt(0)" ::: "memory");
        }
    }
    __syncthreads();
}

namespace pg8 {
constexpr int BM = 256, BK = 64, HALF = 128, HTB = HALF * BK * 2, STAGE_BYTES = 8 * HTB, NXCD = 8, WGM = 8;
__host__ __device__ __forceinline__ int lds_byte(int r, int c) { const int st = (r >> 4) * 2 + (c >> 5), rr = r & 15, cc = c & 31, ob = rr * 64 + cc * 2; return st * 1024 + (ob ^ (((ob >> 9) & 1) << 5)); }
__host__ __device__ __forceinline__ void stage_rc(int b, int& R, int& C) { const int st = b / 1024, sb = b % 1024, swz = sb ^ (((sb >> 9) & 1) << 5); R = (st >> 1) * 16 + swz / 64; C = (st & 1) * 32 + (swz % 64) / 2; }
__host__ __device__ __forceinline__ int perm32(int rho) { const int n = rho >> 4, i = rho & 15; return 8 * (i >> 2) + 4 * n + (i & 3); }
struct Unit { int pm, pn, seg; };
struct StaticOrder {
    int nM, nN, nwg, G, c;
    __device__ void init(int M, int N, int G_, int c_) { nM = M / BM; nN = N / BM; nwg = nM * nN; G = G_; c = c_; }
    __device__ bool next(int i, Unit& u) const {
        const long L = (long)i * G + c; if (L >= nwg) return false;
        int wgid = (int)L; { const int q = nwg / NXCD, r = nwg % NXCD, xcd = wgid % NXCD, off = wgid / NXCD; wgid = (xcd < r ? xcd * (q + 1) : r * (q + 1) + (xcd - r) * q) + off; }
        const int nig = WGM * nN, gid = wgid / nig, fm = gid * WGM, gsz = (nM - fm) < WGM ? (nM - fm) : WGM;
        u.pm = fm + ((wgid % nig) % gsz); u.pn = (wgid % nig) / gsz; u.seg = 0; return true;
    }
};
template <class Epi, class Sched>
__device__ __forceinline__ void gemm_phase(LAS unsigned char* lds, const int K, const Sched& S, const Epi& E) {
    int tid_ = threadIdx.x; asm volatile("" : "+v"(tid_));
    const int tid = tid_, wid = __builtin_amdgcn_readfirstlane(tid >> 6), lane = tid & 63, wr = wid >> 2, wc = wid & 3, fr = lane & 15, fq = lane >> 4;
    const int nt = K / BK;
    unsigned voffA[2], voffB[2];
#pragma unroll
    for (int i = 0; i < 2; ++i) { int R, C; stage_rc(tid * 16 + i * 8192, R, C); const int Rb = Epi::PERM ? ((R & ~31) + perm32(R & 31)) : R;
        voffA[i] = (unsigned)(R * K + C) * 2u; voffB[i] = (unsigned)(Rb * K + C) * 2u; }
    const size_t kstep = (size_t)(BK * 2);
    const size_t hstep = (size_t)HALF * K * 2;
    const unsigned ldsw = (unsigned)wid * 1024u;
    const int aoff = lds_byte(wr * 64 + fr, fq * 8), boff = lds_byte(wc * 32 + fr, fq * 8);
#define PG8_SA(b, h) (((b) * 2 + (h)) * HTB)
#define PG8_SB(b, h) ((4 + (b) * 2 + (h)) * HTB)
#define PG8_STAGE(bufoff, gbase, voff) do { _Pragma("unroll") for (int _i = 0; _i < 2; ++_i) \
        __builtin_amdgcn_global_load_lds((const unsigned*)((const char*)(gbase) + (voff)[_i]), (LAS unsigned*)(lds + (bufoff) + ldsw + _i * 8192), 16, 0, 0); } while (0)
#define PG8_LDA(dst, b, h) do { _Pragma("unroll") for (int m = 0; m < 4; ++m) _Pragma("unroll") for (int k = 0; k < 2; ++k) dst[m][k] = *(const LAS bf16x8*)(lds + PG8_SA(b, h) + aoff + m * 2048 + k * 1024); } while (0)
#define PG8_LDB(dst, b, h) do { _Pragma("unroll") for (int n = 0; n < 2; ++n) _Pragma("unroll") for (int k = 0; k < 2; ++k) dst[n][k] = *(const LAS bf16x8*)(lds + PG8_SB(b, h) + boff + n * 2048 + k * 1024); } while (0)
#define PG8_MMA(ai, bj, At, Bt) do { __builtin_amdgcn_s_setprio(1); _Pragma("unroll") for (int m = 0; m < 4; ++m) _Pragma("unroll") for (int n = 0; n < 2; ++n) _Pragma("unroll") for (int k = 0; k < 2; ++k) \
        acc[ai][bj][m][n] = __builtin_amdgcn_mfma_f32_16x16x32_bf16(Bt[n][k], At[m][k], acc[ai][bj][m][n], 0, 0, 0); __builtin_amdgcn_s_setprio(0); } while (0)
#define PG8_WAIT_V(n) asm volatile("s_waitcnt vmcnt(" #n ")" ::: "memory")
#define PG8_WAIT_L(n) asm volatile("s_waitcnt lgkmcnt(" #n ")" ::: "memory")
#define PG8_BAR __builtin_amdgcn_s_barrier()
#define PG8_SCHED __builtin_amdgcn_sched_barrier(0)
    Unit cur, nxt; int ui = 0;
    if (!S.next(0, cur)) return;
    f32x4 acc[2][2][4][2];
#pragma unroll
    for (int a = 0; a < 2; ++a)
#pragma unroll
        for (int b = 0; b < 2; ++b)
#pragma unroll
            for (int m = 0; m < 4; ++m)
#pragma unroll
                for (int n = 0; n < 2; ++n) acc[a][b][m][n] = (f32x4){0.f, 0.f, 0.f, 0.f};
    bf16x8 At[4][2], B0[2][2], B1[2][2];
    const char* cA; const char* cB; S.ptrs(cur, cA, cB);
    PG8_STAGE(PG8_SB(0, 0), cB, voffB); PG8_STAGE(PG8_SA(0, 0), cA, voffA); PG8_STAGE(PG8_SB(0, 1), cB + hstep, voffB); PG8_STAGE(PG8_SA(0, 1), cA + hstep, voffA);
    if (wr == 1) PG8_BAR;
    PG8_WAIT_V(4); PG8_BAR;
    PG8_STAGE(PG8_SB(1, 0), cB + kstep, voffB); PG8_STAGE(PG8_SA(1, 0), cA + kstep, voffA); PG8_STAGE(PG8_SB(1, 1), cB + hstep + kstep, voffB);
    PG8_WAIT_V(6); PG8_BAR;
    for (;;) {
        const bool has_next = S.next(ui + 1, nxt);
        const char* nA = cA; const char* nB = cB; if (has_next) S.ptrs(nxt, nA, nB);
        for (int t = 0; t < nt; t += 2) {
            const bool last = (t == nt - 2);
            const char* a1 = cA + (size_t)(t + 1) * kstep;
            const char* a2 = last ? nA : cA + (size_t)(t + 2) * kstep; const char* b2 = last ? nB : cB + (size_t)(t + 2) * kstep;
            const char* a3 = a2 + kstep; const char* b3 = b2 + kstep;
            PG8_LDB(B0, 0, 0); PG8_SCHED; PG8_LDA(At, 0, 0); PG8_STAGE(PG8_SA(1, 1), a1 + hstep, voffA);
            PG8_WAIT_L(8); PG8_BAR; PG8_WAIT_L(0); PG8_MMA(0, 0, At, B0); PG8_BAR; PG8_SCHED;
            PG8_LDB(B1, 0, 1); PG8_STAGE(PG8_SB(0, 0), b2, voffB);
            PG8_BAR; PG8_WAIT_L(0); PG8_MMA(0, 1, At, B1); PG8_BAR;
            PG8_LDA(At, 0, 1); PG8_STAGE(PG8_SA(0, 0), a2, voffA);
            PG8_BAR; PG8_WAIT_L(0); PG8_MMA(1, 0, At, B0); PG8_BAR; PG8_SCHED;
            PG8_STAGE(PG8_SB(0, 1), b2 + hstep, voffB);
            PG8_WAIT_V(6); PG8_BAR; PG8_MMA(1, 1, At, B1); PG8_BAR;
            PG8_LDB(B0, 1, 0); PG8_SCHED; PG8_LDA(At, 1, 0); PG8_STAGE(PG8_SA(0, 1), a2 + hstep, voffA);
            PG8_WAIT_L(8); PG8_BAR; PG8_WAIT_L(0); PG8_MMA(0, 0, At, B0); PG8_BAR; PG8_SCHED;
            PG8_LDB(B1, 1, 1); PG8_STAGE(PG8_SB(1, 0), b3, voffB);
            PG8_BAR; PG8_WAIT_L(0); PG8_MMA(0, 1, At, B1); PG8_BAR;
            PG8_LDA(At, 1, 1); PG8_STAGE(PG8_SA(1, 0), a3, voffA);
            PG8_BAR; PG8_WAIT_L(0); PG8_MMA(1, 0, At, B0); PG8_BAR; PG8_SCHED;
            PG8_STAGE(PG8_SB(1, 1), b3 + hstep, voffB);
            PG8_WAIT_V(6); PG8_BAR; PG8_MMA(1, 1, At, B1); PG8_BAR;
        }
        const bool keep = E(acc, cur, wr, wc, fr, fq);
        if (!has_next) break;
        if (!keep) {
#pragma unroll
        for (int a = 0; a < 2; ++a)
#pragma unroll
            for (int b = 0; b < 2; ++b)
#pragma unroll
                for (int m = 0; m < 4; ++m)
#pragma unroll
                    for (int n = 0; n < 2; ++n) acc[a][b][m][n] = (f32x4){0.f, 0.f, 0.f, 0.f};
        }
        cur = nxt; cA = nA; cB = nB; ++ui;
    }
    PG8_WAIT_V(0);
    if (wr == 0) PG8_BAR;
    PG8_BAR;
#undef PG8_SA
#undef PG8_SB
#undef PG8_STAGE
#undef PG8_LDA
#undef PG8_LDB
#undef PG8_MMA
#undef PG8_WAIT_V
#undef PG8_WAIT_L
#undef PG8_BAR
#undef PG8_SCHED
}
}
struct Ctx {
    const float* const* in;
    float* out; unsigned char* ws; LAS unsigned char* lds;
    int tid, lane, wid, G, bid;
};
#define WSP(T, off) ((T*)(c.ws + (off)))

struct SchedIn {
    pg8::StaticOrder so; const char* H; const char* Bt;
    DI bool next(int i, pg8::Unit& u) const { return so.next(i, u); }
    DI void ptrs(const pg8::Unit& u, const char*& A, const char*& B) const { const size_t ts = (size_t)256 * 1024 * 2;
        if (u.pn < 6) { A = Bt + (size_t)u.pn * ts; B = H + (size_t)u.pm * ts; } else { A = H + (size_t)u.pm * ts; B = Bt + (size_t)u.pn * ts; } }
};
struct EpiIn {
    static constexpr bool PERM = true;
    bf16_t* P2; bf16_t* HYT; bf16_t* HYTC; const float* b_lr; const float* b_merge; bf16_t* GF;
    DI bool operator()(f32x4 (&acc)[2][2][4][2], const pg8::Unit& u, int wr, int wc, int fr, int fq) const {
        if (u.pn < 6) {
            bf16_t* base; size_t ld;
            if (u.pm < 128) { const int b = u.pm >> 5, t0 = (u.pm & 31) * 256; base = HYT + (size_t)b * 1536 * 8192 + t0; ld = 8192; }
            else { const int b = u.pm - 128; base = HYTC + (size_t)b * 1536 * 256; ld = 256; }
#pragma unroll
            for (int ai = 0; ai < 2; ++ai)
#pragma unroll
                for (int m = 0; m < 4; ++m) {
                    const int ch = 256 * u.pn + 128 * ai + 64 * wr + 16 * m + fr;
                    bf16_t* rowp = base + (size_t)ch * ld;
#pragma unroll
                    for (int bj = 0; bj < 2; ++bj) { const int tk = 128 * bj + 32 * wc + 8 * fq; const f32x4 v0 = acc[ai][bj][m][0], v1 = acc[ai][bj][m][1];
                        u32x4 w; w.x = pk_bf16(v0[0], v0[1]); w.y = pk_bf16(v0[2], v0[3]); w.z = pk_bf16(v1[0], v1[1]); w.w = pk_bf16(v1[2], v1[3]);
                        *(u32x4*)(rowp + tk) = w; }
                }
        } else {
            const int kind = (u.pn == 14 || u.pn == 15) ? 1 : (u.pn >= 18 ? 2 : 0);
            const int pc0 = 256 * (u.pn - 6);
#pragma unroll
            for (int bj = 0; bj < 2; ++bj) {
                const int cl = 128 * bj + 32 * wc + 8 * fq;
                float bias[8];
#pragma unroll
                for (int j = 0; j < 8; ++j) bias[j] = 0.f;
                if (kind == 1) { const float* bp = b_lr + (u.pn - 14) * 256 + cl;
#pragma unroll
                    for (int j = 0; j < 8; ++j) bias[j] = bp[j]; }
                if (kind == 2) { const float* bp = b_merge + (u.pn - 18) * 256 + cl;
#pragma unroll
                    for (int j = 0; j < 8; ++j) bias[j] = bp[j]; }
#pragma unroll
                for (int ai = 0; ai < 2; ++ai)
#pragma unroll
                    for (int m = 0; m < 4; ++m) {
                        const int row = 256 * u.pm + 128 * ai + 64 * wr + 16 * m + fr;
                        float v[8];
#pragma unroll
                        for (int j = 0; j < 4; ++j) { v[j] = acc[ai][bj][m][0][j] + bias[j]; v[4 + j] = acc[ai][bj][m][1][j] + bias[4 + j]; }
                        if (kind == 1) {
#pragma unroll
                            for (int j = 0; j < 8; ++j) v[j] = logsigmoidf_(v[j]) * 0.0625f; }
                        if (kind == 2) {
#pragma unroll
                            for (int j = 0; j < 8; ++j) v[j] = sigmoidf_(v[j]); }
                        u32x4 w; w.x = pk_bf16(v[0], v[1]); w.y = pk_bf16(v[2], v[3]); w.z = pk_bf16(v[4], v[5]); w.w = pk_bf16(v[6], v[7]);
                        if (kind == 2) *(u32x4*)(GF + ((((size_t)u.pm * 12 + (u.pn - 18)) * 8 + (wr * 4 + wc)) * 16 + (ai * 8 + m * 2 + bj)) * 512 + (fq * 16 + fr) * 8) = w;
                        else *(u32x4*)(P2 + (size_t)row * P2W + pc0 + cl) = w;
                    }
            }
        }
        return false;
    }
};
struct SchedMg {
    pg8::StaticOrder so; const char* ws;
    DI bool next(int i, pg8::Unit& u) const { if (!so.next(i / 3, u)) return false; u.seg = i % 3; return true; }
    DI void ptrs(const pg8::Unit& u, const char*& A, const char*& B) const { const size_t ts = (size_t)256 * 512 * 2;
        const size_t yo = u.seg == 0 ? WS_YHY : (u.seg == 1 ? WS_YRG : WS_YGLA); const size_t bo = u.seg == 0 ? WS_BTHY : (u.seg == 1 ? WS_BTRG : WS_BTGLA);
        A = ws + yo + (size_t)u.pm * ts; B = ws + bo + (size_t)u.pn * ts; }
};
struct EpiMg {
    static constexpr bool PERM = true;
    unsigned char* ws;
    DI bool operator()(f32x4 (&acc)[2][2][4][2], const pg8::Unit& u, int wr, int wc, int fr, int fq) const {
        const bf16_t* GF = (const bf16_t*)(ws + WS_GF); bf16_t* M = (bf16_t*)(ws + WS_M);
        const bf16_t* g0 = GF + (((size_t)u.pm * 12 + (u.seg * 4 + u.pn)) * 8 + (wr * 4 + wc)) * 16 * 512 + (fq * 16 + fr) * 8;
        const bf16_t* g1 = g0 + (size_t)4 * 8 * 16 * 512;
#pragma unroll
        for (int ai = 0; ai < 2; ++ai) {
            u32x4 ga[4][2], gb[4][2];
#pragma unroll
            for (int m = 0; m < 4; ++m)
#pragma unroll
                for (int bj = 0; bj < 2; ++bj) { const int fi = (ai * 8 + m * 2 + bj) * 512; ga[m][bj] = *(const u32x4*)(g0 + fi); gb[m][bj] = u.seg < 2 ? *(const u32x4*)(g1 + fi) : (u32x4){0x3f803f80u, 0x3f803f80u, 0x3f803f80u, 0x3f803f80u}; }
            asm volatile("" ::: "memory");
#pragma unroll
            for (int m = 0; m < 4; ++m) {
                const int row = 256 * u.pm + 128 * ai + 64 * wr + 16 * m + fr;
#pragma unroll
                for (int bj = 0; bj < 2; ++bj) {
                    const int col = 256 * u.pn + 128 * bj + 32 * wc + 8 * fq;
                    const u32x4 a4 = ga[m][bj], b4 = gb[m][bj];
                    float f[8] = {bflo(a4.x), bfhi(a4.x), bflo(a4.y), bfhi(a4.y), bflo(a4.z), bfhi(a4.z), bflo(a4.w), bfhi(a4.w)};
                    if (u.seg < 2) {
                        f[0] *= __builtin_amdgcn_rcpf(bflo(b4.x)); f[1] *= __builtin_amdgcn_rcpf(bfhi(b4.x)); f[2] *= __builtin_amdgcn_rcpf(bflo(b4.y)); f[3] *= __builtin_amdgcn_rcpf(bfhi(b4.y));
                        f[4] *= __builtin_amdgcn_rcpf(bflo(b4.z)); f[5] *= __builtin_amdgcn_rcpf(bfhi(b4.z)); f[6] *= __builtin_amdgcn_rcpf(bflo(b4.w)); f[7] *= __builtin_amdgcn_rcpf(bfhi(b4.w)); }
#pragma unroll
                    for (int j = 0; j < 4; ++j) { acc[ai][bj][m][0][j] *= f[j]; acc[ai][bj][m][1][j] *= f[4 + j]; }
                    if (u.seg == 2) { const f32x4 v0 = acc[ai][bj][m][0], v1 = acc[ai][bj][m][1];
                        u32x4 w; w.x = pk_bf16(v0[0], v0[1]); w.y = pk_bf16(v0[2], v0[3]); w.z = pk_bf16(v1[0], v1[1]); w.w = pk_bf16(v1[2], v1[3]);
                        *(u32x4*)(M + (size_t)row * 1024 + col) = w; }
                }
            }
        }
        return u.seg != 2;
    }
};
struct SchedPlain {
    pg8::StaticOrder so; const char* A0; const char* B0; size_t ts;
    DI bool next(int i, pg8::Unit& u) const { return so.next(i, u); }
    DI void ptrs(const pg8::Unit& u, const char*& A, const char*& B) const { A = A0 + (size_t)u.pm * ts; B = B0 + (size_t)u.pn * ts; }
};
struct EpiOut {
    static constexpr bool PERM = false;
    const float* xsrc_lat; float* xdst_lat; float* xctx; const float* mod;
    DI bool operator()(f32x4 (&acc)[2][2][4][2], const pg8::Unit& u, int wr, int wc, int fr, int fq) const {
        const int b = u.pm < 128 ? (u.pm >> 5) : 4;
        const float* gt = mod + b * 6144 + 2048;
        f32x4 g[2][2];
#pragma unroll
        for (int bj = 0; bj < 2; ++bj)
#pragma unroll
            for (int n = 0; n < 2; ++n) g[bj][n] = *(const f32x4*)(gt + 256 * u.pn + 128 * bj + 32 * wc + 16 * n + 4 * fq);
#pragma unroll
        for (int ai = 0; ai < 2; ++ai)
#pragma unroll
        for (int mh = 0; mh < 2; ++mh) {
            f32x4 xv[2][2][2];
#pragma unroll
            for (int m2 = 0; m2 < 2; ++m2) { const int row = 256 * u.pm + 128 * ai + 64 * wr + 16 * (mh * 2 + m2) + fr;
                const float* sp = row < NLAT ? xsrc_lat + (size_t)row * 1024 : xctx + (size_t)(row - NLAT) * 1024;
#pragma unroll
                for (int bj = 0; bj < 2; ++bj)
#pragma unroll
                    for (int n = 0; n < 2; ++n) xv[m2][bj][n] = *(const f32x4*)(sp + 256 * u.pn + 128 * bj + 32 * wc + 16 * n + 4 * fq); }
            asm volatile("" ::: "memory");
#pragma unroll
            for (int m2 = 0; m2 < 2; ++m2) { const int m = mh * 2 + m2, row = 256 * u.pm + 128 * ai + 64 * wr + 16 * m + fr;
                float* dp = row < NLAT ? xdst_lat + (size_t)row * 1024 : xctx + (size_t)(row - NLAT) * 1024;
#pragma unroll
                for (int bj = 0; bj < 2; ++bj)
#pragma unroll
                    for (int n = 0; n < 2; ++n) { const int col = 256 * u.pn + 128 * bj + 32 * wc + 16 * n + 4 * fq; const f32x4 x = xv[m2][bj][n];
                        *(f32x4*)(dp + col) = (ABL & 16) ? x : x + g[bj][n] * acc[ai][bj][m][n]; } }
        }
        return false;
    }
};
struct EpiQ {
    static constexpr bool PERM = true;
    bf16_t* Q;
    DI bool operator()(f32x4 (&acc)[2][2][4][2], const pg8::Unit& u, int wr, int wc, int fr, int fq) const {
#pragma unroll
        for (int ai = 0; ai < 2; ++ai)
#pragma unroll
            for (int m = 0; m < 4; ++m) {
                const int row = 256 * u.pm + 128 * ai + 64 * wr + 16 * m + fr;
#pragma unroll
                for (int bj = 0; bj < 2; ++bj) { const int col = 256 * u.pn + 128 * bj + 32 * wc + 8 * fq; const f32x4 v0 = acc[ai][bj][m][0], v1 = acc[ai][bj][m][1];
                    u32x4 w; w.x = pk_bf16(v0[0], v0[1]); w.y = pk_bf16(v0[2], v0[3]); w.z = pk_bf16(v1[0], v1[1]); w.w = pk_bf16(v1[2], v1[3]);
                    *(u32x4*)(Q + (size_t)row * 2048 + col) = w; }
            }
        return false;
    }
};

DI void tr_tile(const Ctx& c_, const float* src, int lds_, int k0, int ns0, bf16_t* dst, int ldd, int n0);
DI void p0_prologue(const Ctx& c) {
    LAS float* cond = (LAS float*)c.lds;
    LAS float* red = cond + 5 * 1024;
    const float* cin = c.in[1]; const float* cctx = c.in[3]; const float* wmod = c.in[4]; const float* bmod = c.in[5];
    for (int i = c.tid; i < 5 * 1024; i += 512) { const int b = i >> 10, k = i & 1023; const float v = b < 4 ? cin[b * 1024 + k] : cctx[k]; cond[i] = siluf_(v); }
    __syncthreads();
    float* mod = WSP(float, WS_MOD);
    for (int item = c.bid; item < 384; item += c.G) {
        const int l = item / 96, col0 = (item % 96) * 64, col = col0 + c.lane, ks = c.wid;
        float a0 = 0.f, a1 = 0.f, a2 = 0.f, a3 = 0.f, a4 = 0.f;
        const float* w = wmod + ((size_t)l * 1024 + ks * 128) * 6144 + col;
#pragma unroll 8
        for (int k = 0; k < 128; ++k) { const float wv = w[(size_t)k * 6144]; const int kk = ks * 128 + k;
            a0 += cond[kk] * wv; a1 += cond[1024 + kk] * wv; a2 += cond[2048 + kk] * wv; a3 += cond[3072 + kk] * wv; a4 += cond[4096 + kk] * wv; }
        red[(c.wid * 5 + 0) * 64 + c.lane] = a0; red[(c.wid * 5 + 1) * 64 + c.lane] = a1; red[(c.wid * 5 + 2) * 64 + c.lane] = a2;
        red[(c.wid * 5 + 3) * 64 + c.lane] = a3; red[(c.wid * 5 + 4) * 64 + c.lane] = a4;
        __syncthreads();
        if (c.tid < 320) { const int b = c.tid >> 6, ln = c.tid & 63; float s = 0.f;
#pragma unroll
            for (int w8 = 0; w8 < 8; ++w8) s += red[(w8 * 5 + b) * 64 + ln];
            mod[(size_t)(l * 5 + b) * 6144 + col0 + ln] = s + bmod[(size_t)l * 6144 + col0 + ln]; }
        __syncthreads();
    }
    const float4* src = (const float4*)c.in[2]; float4* dst = (float4*)WSP(float, WS_XCTX);
    for (int i = c.bid * 512 + c.tid; i < 262144; i += c.G * 512) dst[i] = src[i];
    __syncthreads();
    for (int it = c.bid; it < 128; it += c.G)
        tr_tile(c, c.in[15] + (size_t)(it >> 5) * 64 * 2048, 2048, 0, (it & 31) * 64, WSP(bf16_t, WS_W3T) + (size_t)(it >> 5) * 2048 * 64, 64, (it & 31) * 64);
}

template <int WHICH>
DI void norm_row_to_h(const Ctx& c, int l, int r, const float* xlat_src) {
    const float* xr = r < NLAT ? xlat_src + (size_t)r * 1024 : WSP(float, WS_XCTX) + (size_t)(r - NLAT) * 1024;
    const int b = r < NLAT ? (r >> 13) : 4;
    const float* mod = WSP(float, WS_MOD) + (size_t)(l * 5 + b) * 6144 + (WHICH ? 3072 : 0);
    const float* g = c.in[WHICH ? 7 : 6] + (size_t)l * 1024;
    float v[16]; float s = 0.f;
#pragma unroll
    for (int i = 0; i < 2; ++i) { const f32x4 p = *(const f32x4*)(xr + i * 512 + c.lane * 8), q = *(const f32x4*)(xr + i * 512 + c.lane * 8 + 4);
#pragma unroll
        for (int j = 0; j < 4; ++j) { v[i * 8 + j] = p[j]; v[i * 8 + 4 + j] = q[j]; s += p[j] * p[j] + q[j] * q[j]; } }
#pragma unroll
    for (int o = 32; o; o >>= 1) s += __shfl_xor(s, o);
    const float rs = rsqrtf(s * (1.f / 1024.f) + NORM_EPS);
    bf16_t* hr = WSP(bf16_t, WS_H) + (size_t)r * 1024;
#pragma unroll
    for (int i = 0; i < 2; ++i) { const int c0 = i * 512 + c.lane * 8; float o[8];
#pragma unroll
        for (int j = 0; j < 8; ++j) o[j] = v[i * 8 + j] * rs * g[c0 + j] * (1.f + mod[1024 + c0 + j]) + mod[c0 + j];
        u32x4 w; w.x = pk_bf16(o[0], o[1]); w.y = pk_bf16(o[2], o[3]); w.z = pk_bf16(o[4], o[5]); w.w = pk_bf16(o[6], o[7]);
        *(u32x4*)(hr + c0) = w; }
}

DI void tr_tile(const Ctx& c_, const float* src, int lds_, int k0, int ns0, bf16_t* dst, int ldd, int n0) {
    Ctx c = c_; asm volatile("" : "+v"(c.tid));
    LAS float* t = (LAS float*)c.lds;
    { const int k = c.tid >> 3, nq = (c.tid & 7) * 8;
      const f32x4 a = *(const f32x4*)(src + (size_t)(k0 + k) * lds_ + ns0 + nq), b = *(const f32x4*)(src + (size_t)(k0 + k) * lds_ + ns0 + nq + 4);
#pragma unroll
      for (int j = 0; j < 4; ++j) { t[k * 65 + nq + j] = a[j]; t[k * 65 + nq + 4 + j] = b[j]; } }
    __syncthreads();
    { const int n = c.tid >> 3, kq = (c.tid & 7) * 8; float v[8];
#pragma unroll
      for (int j = 0; j < 8; ++j) v[j] = t[(kq + j) * 65 + n];
      u32x4 w; w.x = pk_bf16(v[0], v[1]); w.y = pk_bf16(v[2], v[3]); w.z = pk_bf16(v[4], v[5]); w.w = pk_bf16(v[6], v[7]);
      *(u32x4*)(dst + (size_t)(n0 + n) * ldd + k0 + kq) = w; }
    __syncthreads();
}
DI void tr_tile128(const Ctx& c_, const float* src, int lds_, int k0, int ns0, bf16_t* dst, int ldd, int n0) {
    Ctx c = c_; asm volatile("" : "+v"(c.tid));
    LAS float* t = (LAS float*)c.lds;
    { const int k = c.tid >> 2, nq = (c.tid & 3) * 32; const float* sp = src + (size_t)(k0 + k) * lds_ + ns0 + nq;
      f32x4 a[8];
#pragma unroll
      for (int j = 0; j < 8; ++j) a[j] = *(const f32x4*)(sp + 4 * j);
#pragma unroll
      for (int j = 0; j < 8; ++j) { t[k * 129 + nq + 4 * j] = a[j][0]; t[k * 129 + nq + 4 * j + 1] = a[j][1]; t[k * 129 + nq + 4 * j + 2] = a[j][2]; t[k * 129 + nq + 4 * j + 3] = a[j][3]; } }
    __syncthreads();
    { const int n = c.tid & 127, kq = (c.tid >> 7) * 32; bf16_t* dp = dst + (size_t)(n0 + n) * ldd + k0 + kq;
#pragma unroll
      for (int q = 0; q < 4; ++q) { float v[8];
#pragma unroll
          for (int j = 0; j < 8; ++j) v[j] = t[(kq + 8 * q + j) * 129 + n];
          u32x4 w; w.x = pk_bf16(v[0], v[1]); w.y = pk_bf16(v[2], v[3]); w.z = pk_bf16(v[4], v[5]); w.w = pk_bf16(v[6], v[7]);
          *(u32x4*)(dp + 8 * q) = w; } }
    __syncthreads();
}
DI void fold_tile(const Ctx& c, const float* win, const float* wlr, int d, int j0, int k0, bf16_t* dst) {
    LAS float* a = (LAS float*)c.lds;
    LAS float* b = a + 64 * 17;
    for (int i = c.tid; i < 1024; i += 512) { const int k = i >> 4, r = i & 15; a[k * 17 + r] = win[(size_t)(k0 + k) * 7200 + 3584 + d * 16 + r]; }
    for (int i = c.tid; i < 1024; i += 512) { const int r = i >> 6, j = i & 63; b[r * 64 + j] = wlr[(size_t)(d * 16 + r) * 256 + j0 + j]; }
    __syncthreads();
    { const int j = c.tid >> 3, kq = (c.tid & 7) * 8; float v[8];
#pragma unroll
      for (int q = 0; q < 8; ++q) { float s = 0.f;
#pragma unroll
          for (int r = 0; r < 16; ++r) s += a[(kq + q) * 17 + r] * b[r * 64 + j];
          v[q] = s; }
      u32x4 w; w.x = pk_bf16(v[0], v[1]); w.y = pk_bf16(v[2], v[3]); w.z = pk_bf16(v[4], v[5]); w.w = pk_bf16(v[6], v[7]);
      *(u32x4*)(dst + (size_t)(3584 + d * 256 + j0 + j) * 1024 + k0 + kq) = w; }
    __syncthreads();
}
DI void cvt_chunk(const Ctx& c, const float* src, bf16_t* dst) {
#pragma unroll
    for (int i = 0; i < 2; ++i) { const int o = (i * 512 + c.tid) * 8; const f32x4 a = *(const f32x4*)(src + o), b = *(const f32x4*)(src + o + 4);
        u32x4 w; w.x = pk_bf16(a[0], a[1]); w.y = pk_bf16(a[2], a[3]); w.z = pk_bf16(b[0], b[1]); w.w = pk_bf16(b[2], b[3]);
        *(u32x4*)(dst + o) = w; }
}

DI void cvt_chunk_fp8(const Ctx& c, const float* src, unsigned char* dst, float scale) {
    const int o = c.tid * 16; u32x4 w;
#pragma unroll
    for (int k = 0; k < 4; ++k) { const f32x4 a = *(const f32x4*)(src + o + 4 * k); int p = 0;
        p = __builtin_amdgcn_cvt_pk_fp8_f32(a[0] * scale, a[1] * scale, p, false); p = __builtin_amdgcn_cvt_pk_fp8_f32(a[2] * scale, a[3] * scale, p, true); w[k] = (unsigned)p; }
    *(u32x4*)(dst + o) = w;
}

DI void cvt_chunk_fp4(const Ctx& c, const float* src, unsigned char* dst, float scale) {
    const int o = c.tid * 16; u32x2 w;
#pragma unroll
    for (int k = 0; k < 2; ++k) { const f32x4 a = *(const f32x4*)(src + o + 8 * k), b = *(const f32x4*)(src + o + 8 * k + 4); unsigned p = 0;
        p = __builtin_amdgcn_cvt_scalef32_pk_fp4_f32(p, a[0] * scale, a[1] * scale, 1.0f, 0); p = __builtin_amdgcn_cvt_scalef32_pk_fp4_f32(p, a[2] * scale, a[3] * scale, 1.0f, 1);
        p = __builtin_amdgcn_cvt_scalef32_pk_fp4_f32(p, b[0] * scale, b[1] * scale, 1.0f, 2); p = __builtin_amdgcn_cvt_scalef32_pk_fp4_f32(p, b[2] * scale, b[3] * scale, 1.0f, 3); w[k] = p; }
    *(u32x2*)(dst + c.tid * 8) = w;
}
DI void cvt_chunk_int4_il(const Ctx& c, const float* src, unsigned char* dst, float scale) {
    const int o = c.tid * 16; u32x2 w;
#pragma unroll
    for (int k = 0; k < 2; ++k) { const f32x4 a = *(const f32x4*)(src + o + 8 * k), b = *(const f32x4*)(src + o + 8 * k + 4); unsigned p = 0;
#pragma unroll
        for (int j = 0; j < 4; ++j) { const int qa = (int)fminf(fmaxf(rintf(a[j] * scale), -8.f), 7.f), qb = (int)fminf(fmaxf(rintf(b[j] * scale), -8.f), 7.f);
            p |= ((unsigned)qa & 15u) << (4 * j); p |= ((unsigned)qb & 15u) << (4 * (4 + j)); }
        w[k] = p; }
    *(u32x2*)(dst + c.tid * 16) = w;
}
DI void cvt_chunk_fp4_il(const Ctx& c, const float* src, unsigned char* dst, float scale, int half) {
    const int o = c.tid * 16; u32x2 w;
#pragma unroll
    for (int k = 0; k < 2; ++k) { const f32x4 a = *(const f32x4*)(src + o + 8 * k), b = *(const f32x4*)(src + o + 8 * k + 4); unsigned p = 0;
        p = __builtin_amdgcn_cvt_scalef32_pk_fp4_f32(p, a[0] * scale, a[1] * scale, 1.0f, 0); p = __builtin_amdgcn_cvt_scalef32_pk_fp4_f32(p, a[2] * scale, a[3] * scale, 1.0f, 1);
        p = __builtin_amdgcn_cvt_scalef32_pk_fp4_f32(p, b[0] * scale, b[1] * scale, 1.0f, 2); p = __builtin_amdgcn_cvt_scalef32_pk_fp4_f32(p, b[2] * scale, b[3] * scale, 1.0f, 3); w[k] = p; }
    *(u32x2*)(dst + c.tid * 16 + half * 8) = w;
}

DI void hy_filter_tile(const Ctx& c_, int l, int pt) {
    Ctx c = c_; asm volatile("" : "+v"(c.tid)); c.lane = c.tid & 63;
    const bool isctx = pt >= 256; const int n = isctx ? 256 : 8192; const int t0 = isctx ? (pt - 256) * 16 : pt * 32; const int nth = isctx ? 1 : 2;
    LAS float* feats = (LAS float*)c.lds;
    LAS float* h1 = feats + 32 * 33;
    LAS float* h2 = h1 + 32 * 64;
    const float* w1 = c.in[11] + (size_t)l * 33 * 64; const float* b1 = c.in[12] + l * 64; const float* w2 = c.in[13] + (size_t)l * 64 * 64; const float* b2 = c.in[14] + l * 64;
    const float* w3 = c.in[15] + (size_t)l * 64 * 2048; const float* fr = c.in[16] + l * 64;
    for (int i = c.tid; i < 32 * 33; i += 512) { const int t = i / 33, f = i % 33; const float pos = (float)(t0 + t); float v;
        if (f == 0) v = pos / (float)(n - 1);
        else { const int bi = (f - 1) & 15; const float band = 1e-4f + (float)bi * ((15.0f - 1e-4f) / 15.0f); const float ang = (6.283185307179586f / (float)n) * pos * band;
            v = f <= 16 ? cosf(ang) : -sinf(ang); }
        feats[i] = v; }
    __syncthreads();
    for (int i = c.tid; i < 32 * 64; i += 512) { const int t = i >> 6, j = i & 63; float s = b1[j];
        for (int f = 0; f < 33; ++f) s += feats[t * 33 + f] * w1[f * 64 + j];
        h1[i] = sinf(fr[j] * s); }
    __syncthreads();
    for (int i = c.tid; i < 32 * 64; i += 512) { const int t = i >> 6, j = i & 63; float s = b2[j];
        for (int k = 0; k < 64; ++k) s += h1[t * 64 + k] * w2[k * 64 + j];
        h2[i] = sinf(fr[j] * s); }
    __syncthreads();
    {
        const bf16_t* w3t = WSP(bf16_t, WS_W3T) + (size_t)l * 2048 * 64;
        const int pos = c.lane & 31, kh = c.lane >> 5;
        bf16x8 bfr[4];
#pragma unroll
        for (int ks = 0; ks < 4; ++ks) { const LAS float* hp = h2 + pos * 64 + 16 * ks + 8 * kh; const f32x4 x0 = *(const LAS f32x4*)hp, x1 = *(const LAS f32x4*)(hp + 4);
            u32x4 w; w.x = pk_bf16(x0[0], x0[1]); w.y = pk_bf16(x0[2], x0[3]); w.z = pk_bf16(x1[0], x1[1]); w.w = pk_bf16(x1[2], x1[3]); bfr[ks] = __builtin_bit_cast(bf16x8, w); }
        const bool pv = pos < (isctx ? 16 : 32);
        const float tn = (float)(t0 + pos) / (float)(n - 1);
        float* hw = isctx ? WSP(float, WS_HWTC) : WSP(float, WS_HWT);
        float* spart = WSP(float, WS_SPART) + (size_t)pt * 2048;
#pragma unroll 1
        for (int nt = 0; nt < 8; ++nt) {
            const int nb = c.wid * 256 + nt * 32;
            f32x16 acc;
#pragma unroll
            for (int r = 0; r < 16; ++r) acc[r] = 0.f;
            bf16x8 af[4];
#pragma unroll
            for (int ks = 0; ks < 4; ++ks) af[ks] = *(const bf16x8*)(w3t + (size_t)(nb + pos) * 64 + 16 * ks + 8 * kh);
#pragma unroll
            for (int ks = 0; ks < 4; ++ks) acc = __builtin_amdgcn_mfma_f32_32x32x16_bf16(af[ks], bfr[ks], acc, 0, 0, 0);
#pragma unroll
            for (int r = 0; r < 16; ++r) {
                const int chn = nb + (r & 3) + 8 * (r >> 2) + 4 * kh;
                const float delta = fabsf(-15.350567286626973f + (float)(chn & 511) * ((-3.0701134573253946f + 15.350567286626973f) / 511.0f));
                const float v = pv ? acc[r] * __expf(-tn * delta) : 0.f;
                if (pv) hw[(size_t)chn * n + t0 + pos] = v;
                float as = fabsf(v);
                as += __int_as_float(__builtin_amdgcn_update_dpp(0, __float_as_int(as), 0xB1, 0xf, 0xf, false));
                as += __int_as_float(__builtin_amdgcn_update_dpp(0, __float_as_int(as), 0x4E, 0xf, 0xf, false));
                as += __int_as_float(__builtin_amdgcn_update_dpp(0, __float_as_int(as), 0x141, 0xf, 0xf, false));
                as += __int_as_float(__builtin_amdgcn_update_dpp(0, __float_as_int(as), 0x140, 0xf, 0xf, false));
                as += __shfl_xor(as, 16);
                if (pos == 0) spart[chn] = as;
            }
        }
    }
    __syncthreads();
}
DI int PADX(int a) { return a + ((a >> 6) << 2); }
DI cf2 cadd(cf2 a, cf2 b) { return mk2(a.x + b.x, a.y + b.y); }
DI cf2 csub(cf2 a, cf2 b) { return mk2(a.x - b.x, a.y - b.y); }
template <bool INV> DI cf2 cmuli(cf2 d) { return INV ? mk2(-d.y, d.x) : mk2(d.y, -d.x); }
template <bool INV> DI cf2 cmulw(cf2 a, float wr, float wi) { return INV ? mk2(a.x * wr + a.y * wi, a.y * wr - a.x * wi) : mk2(a.x * wr - a.y * wi, a.x * wi + a.y * wr); }
template <bool INV> DI void dft4(cf2& a0, cf2& a1, cf2& a2, cf2& a3) {
    const cf2 s0 = cadd(a0, a2), s1 = csub(a0, a2), s2 = cadd(a1, a3), s3 = cmuli<INV>(csub(a1, a3));
    a0 = cadd(s0, s2); a1 = cadd(s1, s3); a2 = csub(s0, s2); a3 = csub(s1, s3);
}
template <bool INV> DI void dft16(cf2 (&x)[16]) {
#pragma unroll
    for (int b = 0; b < 4; ++b) dft4<INV>(x[b], x[4 + b], x[8 + b], x[12 + b]);
    constexpr float C1 = 0.9238795325112867f, S1 = 0.3826834323650898f, C2 = 0.7071067811865476f;
    x[4 + 1] = cmulw<INV>(x[4 + 1], C1, -S1); x[4 + 2] = cmulw<INV>(x[4 + 2], C2, -C2); x[4 + 3] = cmulw<INV>(x[4 + 3], S1, -C1);
    x[8 + 1] = cmulw<INV>(x[8 + 1], C2, -C2); x[8 + 2] = cmulw<INV>(x[8 + 2], 0.f, -1.f); x[8 + 3] = cmulw<INV>(x[8 + 3], -C2, -C2);
    x[12 + 1] = cmulw<INV>(x[12 + 1], S1, -C1); x[12 + 2] = cmulw<INV>(x[12 + 2], -C2, -C2); x[12 + 3] = cmulw<INV>(x[12 + 3], -C1, S1);
#pragma unroll
    for (int cc = 0; cc < 4; ++cc) dft4<INV>(x[4 * cc], x[4 * cc + 1], x[4 * cc + 2], x[4 * cc + 3]);
}
template <bool INV>
DI void fft_pass16(const Ctx& c, int llog) {
    LAS cf2* z = (LAS cf2*)c.lds;
    const LAS cf2* twlo = (const LAS cf2*)(c.lds + LDS_TW);
    const LAS cf2* twhi = twlo + 128;
    const int lq = llog - 4, q = 1 << lq;
#pragma unroll 1
    for (int i = 0; i < 2; ++i) {
        const int b = c.tid + i * 512, j = b & (q - 1), base = ((b >> lq) << llog) + j;
        const int tk = j << (14 - llog);
        const cf2 w1 = cmul(twhi[tk >> 7], twlo[tk & 127]);
        cf2 w[16]; w[1] = w1; w[2] = cmul(w1, w1); w[3] = cmul(w[2], w1); w[4] = cmul(w[2], w[2]); w[5] = cmul(w[4], w1); w[6] = cmul(w[3], w[3]); w[7] = cmul(w[4], w[3]);
        w[8] = cmul(w[4], w[4]); w[9] = cmul(w[8], w1); w[10] = cmul(w[5], w[5]); w[11] = cmul(w[8], w[3]); w[12] = cmul(w[6], w[6]); w[13] = cmul(w[12], w1); w[14] = cmul(w[7], w[7]); w[15] = cmul(w[8], w[7]);
        cf2 x[16];
#pragma unroll
        for (int m = 0; m < 16; ++m) x[m] = z[PADX(base + m * q)];
        if (INV) {
#pragma unroll
            for (int r = 1; r < 16; ++r) x[r] = cmulc(x[r], w[r]);
        }
        dft16<INV>(x);
#pragma unroll
        for (int cc = 0; cc < 4; ++cc)
#pragma unroll
            for (int d = 0; d < 4; ++d) { const int r = cc + 4 * d; cf2 v = x[4 * cc + d]; if (!INV && r > 0) v = cmul(v, w[r]); z[PADX(base + r * q)] = v; }
    }
    __syncthreads();
}
template <bool INV>
DI void fft_pass4(const Ctx& c) {
    LAS cf2* z = (LAS cf2*)c.lds;
#pragma unroll 2
    for (int i = 0; i < 8; ++i) { const int b = c.tid + i * 512; LAS f32x4* p = (LAS f32x4*)(z + PADX(4 * b));
        const f32x4 u = p[0], v = p[1]; cf2 a0 = mk2(u[0], u[1]), a1 = mk2(u[2], u[3]), a2 = mk2(v[0], v[1]), a3 = mk2(v[2], v[3]);
        dft4<INV>(a0, a1, a2, a3);
        p[0] = (f32x4){a0.x, a0.y, a1.x, a1.y}; p[1] = (f32x4){a2.x, a2.y, a3.x, a3.y}; }
    __syncthreads();
}
template <bool INV>
DI void fft16k(const Ctx& c) {
    if (!INV) { fft_pass16<false>(c, 14); fft_pass16<false>(c, 10); fft_pass16<false>(c, 6); fft_pass4<false>(c); }
    else { fft_pass4<true>(c); fft_pass16<true>(c, 6); fft_pass16<true>(c, 10); fft_pass16<true>(c, 14); }
}
DI void tw_init(const Ctx& c) {
    LAS cf2* twlo = (LAS cf2*)(c.lds + LDS_TW);
    if (c.tid < 256) { const int k = c.tid < 128 ? c.tid : (c.tid - 128) * 128; float s, co; sincospif(-(float)k * (1.0f / 8192.0f), &s, &co); twlo[c.tid] = mk2(co, s); }
}
DI unsigned pk_f16(float a, float b) { typedef _Float16 h2 __attribute__((ext_vector_type(2))); h2 v; v.x = (_Float16)a; v.y = (_Float16)b; return __builtin_bit_cast(unsigned, v); }
DI cf2 unpk_f16(unsigned u) { typedef _Float16 h2 __attribute__((ext_vector_type(2))); const h2 v = __builtin_bit_cast(h2, u); return mk2((float)v.x, (float)v.y); }

DI void hy_spec_item(const Ctx& c_, int o, int cch) {
    Ctx c = c_; asm volatile("" : "+v"(c.tid)); c.lane = c.tid & 63;
    LAS cf2* z = (LAS cf2*)c.lds;
    LAS float* red = (LAS float*)(c.lds + LDS_BARW + 64);
    const float* sp = WSP(float, WS_SPART);
    const float* hf = WSP(float, WS_HWT) + (size_t)(o * 1024 + cch) * 8192;
    const float* hb = WSP(float, WS_HWT) + (size_t)(o * 1024 + 512 + cch) * 8192;
    float hfv[16], hbv[16];
#pragma unroll
    for (int i = 0; i < 16; ++i) { const int p = c.tid + i * 512; hfv[i] = hf[p]; hbv[i] = hb[p == 0 ? 0 : 8192 - p]; }
    float s = 0.f;
    if (c.tid < 256) s = sp[(size_t)c.tid * 2048 + o * 1024 + cch] + sp[(size_t)c.tid * 2048 + o * 1024 + 512 + cch];
#pragma unroll
    for (int of = 32; of; of >>= 1) s += __shfl_xor(s, of);
    if (c.lane == 0) red[c.wid] = s;
    __syncthreads();
    float tot = 0.f;
#pragma unroll
    for (int w = 0; w < 8; ++w) tot += red[w];
    const float sc = 1.0f / (tot + 1e-6f);
#pragma unroll
    for (int i = 0; i < 16; ++i) { const int p = c.tid + i * 512;
        float v = hfv[i]; if (p == 0) v += hbv[i];
        z[PADX(p)] = mk2(v * sc, 0.f);
        const int p2 = 8192 + p;
        z[PADX(p2)] = mk2(p == 0 ? 0.f : hbv[i] * sc, 0.f); }
    __syncthreads();
    fft16k<false>(c);
    unsigned* dst = WSP(unsigned, WS_SPEC) + (size_t)(o * 512 + cch) * 16384;
#pragma unroll 8
    for (int i = 0; i < 32; ++i) { const int p = c.tid + i * 512; const cf2 v = z[PADX(p)]; dst[p] = pk_f16(v.x, v.y); }
    __syncthreads();
}

DI void hy_spec_pair_item(const Ctx& c_, int o, int cp) {
    Ctx c = c_; asm volatile("" : "+v"(c.tid)); c.lane = c.tid & 63;
    LAS cf2* z = (LAS cf2*)c.lds;
    LAS float* red = (LAS float*)(c.lds + LDS_BARW + 64);
    const float* sp = WSP(float, WS_SPART);
    const int cA = cp, cB = cp + 256;
    const float* hfA = WSP(float, WS_HWT) + (size_t)(o * 1024 + cA) * 8192; const float* hbA = WSP(float, WS_HWT) + (size_t)(o * 1024 + 512 + cA) * 8192;
    const float* hfB = WSP(float, WS_HWT) + (size_t)(o * 1024 + cB) * 8192; const float* hbB = WSP(float, WS_HWT) + (size_t)(o * 1024 + 512 + cB) * 8192;
    float fa[16], ba[16], fb[16], bb[16];
#pragma unroll
    for (int i = 0; i < 16; ++i) { const int p = c.tid + i * 512, pr = p == 0 ? 0 : 8192 - p; fa[i] = hfA[p]; ba[i] = hbA[pr]; fb[i] = hfB[p]; bb[i] = hbB[pr]; }
    { const int t = c.tid & 255, cc = c.tid < 256 ? cA : cB;
      float s = sp[(size_t)t * 2048 + o * 1024 + cc] + sp[(size_t)t * 2048 + o * 1024 + 512 + cc];
#pragma unroll
      for (int of = 32; of; of >>= 1) s += __shfl_xor(s, of);
      if (c.lane == 0) red[c.wid] = s; }
    __syncthreads();
    const float scA = 1.0f / (red[0] + red[1] + red[2] + red[3] + 1e-6f), scB = 1.0f / (red[4] + red[5] + red[6] + red[7] + 1e-6f);
#pragma unroll
    for (int i = 0; i < 16; ++i) { const int p = c.tid + i * 512;
        float va = fa[i], vb = fb[i]; if (p == 0) { va += ba[i]; vb += bb[i]; }
        z[PADX(p)] = mk2(va * scA, vb * scB);
        z[PADX(8192 + p)] = mk2(p == 0 ? 0.f : ba[i] * scA, p == 0 ? 0.f : bb[i] * scB); }
    __syncthreads();
    fft16k<false>(c);
    unsigned* dA = WSP(unsigned, WS_SPEC) + (size_t)(o * 512 + cA) * 16384; unsigned* dB = WSP(unsigned, WS_SPEC) + (size_t)(o * 512 + cB) * 16384;
#pragma unroll 4
    for (int i = 0; i < 32; ++i) { const int p = c.tid + i * 512;
        const int k = (p >> 10) + 16 * ((p >> 6) & 15) + 256 * ((p >> 2) & 15) + 4096 * (p & 3), kn = (16384 - k) & 16383;
        const int pn = 1024 * (kn & 15) + 64 * ((kn >> 4) & 15) + 4 * ((kn >> 8) & 15) + (kn >> 12);
        const cf2 u = z[PADX(p)], w = z[PADX(pn)];
        dA[p] = pk_f16(0.5f * (u.x + w.x), 0.5f * (u.y - w.y)); dB[p] = pk_f16(0.5f * (u.y + w.y), 0.5f * (w.x - u.x)); }
    __syncthreads();
}

DI void load_conv16(const bf16_t* row, int t0, int n, float w0, float w1, float w2, float cb, float (&o)[16]) {
    asm volatile("" : "+v"(t0));
    const u32x4 a = *(const u32x4*)(row + t0), b = *(const u32x4*)(row + t0 + 8);
    float x[18];
    x[0] = t0 > 0 ? bf2f(row[t0 - 1]) : 0.f; x[17] = t0 + 16 < n ? bf2f(row[t0 + 16]) : 0.f;
    x[1] = bflo(a.x); x[2] = bfhi(a.x); x[3] = bflo(a.y); x[4] = bfhi(a.y); x[5] = bflo(a.z); x[6] = bfhi(a.z); x[7] = bflo(a.w); x[8] = bfhi(a.w);
    x[9] = bflo(b.x); x[10] = bfhi(b.x); x[11] = bflo(b.y); x[12] = bfhi(b.y); x[13] = bflo(b.z); x[14] = bfhi(b.z); x[15] = bflo(b.w); x[16] = bfhi(b.w);
#pragma unroll
    for (int i = 0; i < 16; ++i) o[i] = cb + w0 * x[i] + w1 * x[i + 1] + w2 * x[i + 2];
}
struct RawRow { u32x4 a, b; bf16_t hm, hp; };
DI RawRow load_raw16(const bf16_t* row, int t0, int n) { RawRow r; r.a = *(const u32x4*)(row + t0); r.b = *(const u32x4*)(row + t0 + 8); r.hm = t0 > 0 ? row[t0 - 1] : (bf16_t)0; r.hp = t0 + 16 < n ? row[t0 + 16] : (bf16_t)0; return r; }
DI void conv_raw16(const RawRow& r, float w0, float w1, float w2, float cb, float (&o)[16]) {
    float x[18]; const u32x4 a = r.a, b = r.b;
    x[0] = bf2f(r.hm); x[17] = bf2f(r.hp);
    x[1] = bflo(a.x); x[2] = bfhi(a.x); x[3] = bflo(a.y); x[4] = bfhi(a.y); x[5] = bflo(a.z); x[6] = bfhi(a.z); x[7] = bflo(a.w); x[8] = bfhi(a.w);
    x[9] = bflo(b.x); x[10] = bfhi(b.x); x[11] = bflo(b.y); x[12] = bfhi(b.y); x[13] = bflo(b.z); x[14] = bfhi(b.z); x[15] = bflo(b.w); x[16] = bfhi(b.w);
#pragma unroll
    for (int i = 0; i < 16; ++i) o[i] = cb + w0 * x[i] + w1 * x[i + 1] + w2 * x[i + 2];
}
DI void spec_mul(const Ctx& c, const unsigned* spec) {
    LAS cf2* z = (LAS cf2*)c.lds;
#pragma unroll 1
    for (int hb = 0; hb < 4; ++hb) {
        unsigned sw[8];
#pragma unroll
        for (int i = 0; i < 8; ++i) sw[i] = spec[c.tid + (hb * 8 + i) * 512];
        asm volatile("" : "+v"(sw[0]), "+v"(sw[1]), "+v"(sw[2]), "+v"(sw[3]), "+v"(sw[4]), "+v"(sw[5]), "+v"(sw[6]), "+v"(sw[7]));
#pragma unroll
        for (int i = 0; i < 8; ++i) { const int p = c.tid + (hb * 8 + i) * 512; const cf2 hs = unpk_f16(sw[i]); z[PADX(p)] = cmul(z[PADX(p)], mk2(hs.x * (1.0f / 16384.0f), hs.y * (1.0f / 16384.0f))); }
    }
    __syncthreads();
}
DI void fft_mid_spec(const Ctx& c, const unsigned* spec) {
    LAS cf2* z = (LAS cf2*)c.lds;
    u32x4 sw[8];
#pragma unroll
    for (int i = 0; i < 8; ++i) sw[i] = *(const u32x4*)(spec + 4 * (c.tid + i * 512));
    asm volatile("" : "+v"(sw[0]), "+v"(sw[1]), "+v"(sw[2]), "+v"(sw[3]), "+v"(sw[4]), "+v"(sw[5]), "+v"(sw[6]), "+v"(sw[7]));
#pragma unroll 2
    for (int i = 0; i < 8; ++i) { const int b = c.tid + i * 512; LAS f32x4* p = (LAS f32x4*)(z + PADX(4 * b));
        const f32x4 u = p[0], v = p[1]; cf2 a0 = mk2(u[0], u[1]), a1 = mk2(u[2], u[3]), a2 = mk2(v[0], v[1]), a3 = mk2(v[2], v[3]);
        dft4<false>(a0, a1, a2, a3);
        { const cf2 h0 = unpk_f16(sw[i].x), h1 = unpk_f16(sw[i].y), h2 = unpk_f16(sw[i].z), h3 = unpk_f16(sw[i].w); constexpr float S = 1.0f / 16384.0f;
          a0 = cmul(a0, mk2(h0.x * S, h0.y * S)); a1 = cmul(a1, mk2(h1.x * S, h1.y * S)); a2 = cmul(a2, mk2(h2.x * S, h2.y * S)); a3 = cmul(a3, mk2(h3.x * S, h3.y * S)); }
        dft4<true>(a0, a1, a2, a3);
        p[0] = (f32x4){a0.x, a0.y, a1.x, a1.y}; p[1] = (f32x4){a2.x, a2.y, a3.x, a3.y}; }
    __syncthreads();
}
DI void hy_lat_item(const Ctx& c_, int l, int bp, int cch) {
    Ctx c = c_; asm volatile("" : "+v"(c.tid)); c.lane = c.tid & 63;
    LAS cf2* z = (LAS cf2*)c.lds;
    const float* cw = c.in[9] + (size_t)l * 3 * 1536; const float* cbv = c.in[10] + (size_t)l * 1536; const float* skip = c.in[17] + (size_t)l * 2 * 512;
    const bf16_t* hyt = WSP(bf16_t, WS_HYT);
    const int t0 = c.tid * 16, pt0 = PADX(t0);
    const bf16_t* r0 = hyt + ((size_t)(2 * bp) * 1536) * 8192; const bf16_t* r1 = hyt + ((size_t)(2 * bp + 1) * 1536) * 8192;
    float a0[16], a1[16];
    { const int ch = cch; load_conv16(r0 + (size_t)ch * 8192, t0, 8192, cw[ch], cw[1536 + ch], cw[3072 + ch], cbv[ch], a0);
      load_conv16(r1 + (size_t)ch * 8192, t0, 8192, cw[ch], cw[1536 + ch], cw[3072 + ch], cbv[ch], a1); }
    const int pt1 = PADX(8192 + t0);
#pragma unroll 1
    for (int rd = 0; rd < 2; ++rd) {
        const int ch = 512 * (rd + 1) + cch;
#pragma unroll
        for (int i = 0; i < 16; ++i) { z[pt0 + i] = mk2(a0[i], a1[i]); z[pt1 + i] = mk2(0.f, 0.f); }
        const RawRow rx0 = load_raw16(r0 + (size_t)ch * 8192, t0, 8192), rx1 = load_raw16(r1 + (size_t)ch * 8192, t0, 8192);
        __syncthreads();
        fft_pass16<false>(c, 14); fft_pass16<false>(c, 10); fft_pass16<false>(c, 6);
        fft_mid_spec(c, WSP(unsigned, WS_SPEC) + (size_t)(rd * 512 + cch) * 16384);
        fft_pass16<true>(c, 6); fft_pass16<true>(c, 10); fft_pass16<true>(c, 14);
        float b0[16], b1[16];
        conv_raw16(rx0, cw[ch], cw[1536 + ch], cw[3072 + ch], cbv[ch], b0); conv_raw16(rx1, cw[ch], cw[1536 + ch], cw[3072 + ch], cbv[ch], b1);
        const float sk = skip[rd * 512 + cch];
#pragma unroll
        for (int i = 0; i < 16; ++i) { const cf2 y = z[pt0 + i]; a0[i] = b0[i] * (y.x + sk * a0[i]); a1[i] = b1[i] * (y.y + sk * a1[i]); }
    }
    bf16_t* yo0 = WSP(bf16_t, WS_YHT) + ((size_t)(2 * bp) * 512 + cch) * 8192 + t0; bf16_t* yo1 = WSP(bf16_t, WS_YHT) + ((size_t)(2 * bp + 1) * 512 + cch) * 8192 + t0;
    { u32x4 w; w.x = pk_bf16(a0[0], a0[1]); w.y = pk_bf16(a0[2], a0[3]); w.z = pk_bf16(a0[4], a0[5]); w.w = pk_bf16(a0[6], a0[7]); *(u32x4*)yo0 = w;
      w.x = pk_bf16(a0[8], a0[9]); w.y = pk_bf16(a0[10], a0[11]); w.z = pk_bf16(a0[12], a0[13]); w.w = pk_bf16(a0[14], a0[15]); *(u32x4*)(yo0 + 8) = w;
      w.x = pk_bf16(a1[0], a1[1]); w.y = pk_bf16(a1[2], a1[3]); w.z = pk_bf16(a1[4], a1[5]); w.w = pk_bf16(a1[6], a1[7]); *(u32x4*)yo1 = w;
      w.x = pk_bf16(a1[8], a1[9]); w.y = pk_bf16(a1[10], a1[11]); w.z = pk_bf16(a1[12], a1[13]); w.w = pk_bf16(a1[14], a1[15]); *(u32x4*)(yo1 + 8) = w; }
    __syncthreads();
}
DI void hy_ctx_item(const Ctx& c_, int l, int b, int cch) {
    Ctx c = c_; asm volatile("" : "+v"(c.lane));
    LAS float* wl = (LAS float*)(c.lds + c.wid * 8192);
    LAS float* tp1 = wl; LAS float* tp2 = wl + 512; LAS float* vv = wl + 1024; LAS float* zz = wl + 1280;
    const float* sp = WSP(float, WS_SPART); const float* hw = WSP(float, WS_HWTC);
    float sc[2];
#pragma unroll
    for (int o = 0; o < 2; ++o) { float s = 0.f; if (c.lane < 16) s = sp[(size_t)(256 + c.lane) * 2048 + o * 1024 + cch] + sp[(size_t)(256 + c.lane) * 2048 + o * 1024 + 512 + cch];
#pragma unroll
        for (int of = 8; of; of >>= 1) s += __shfl_xor(s, of);
        sc[o] = 1.0f / (__shfl(s, 0) + 1e-6f); }
#pragma unroll
    for (int o = 0; o < 2; ++o) { LAS float* tp = o ? tp2 : tp1; const float* hf = hw + (size_t)(o * 1024 + cch) * 256; const float* hb = hw + (size_t)(o * 1024 + 512 + cch) * 256;
        for (int i = c.lane; i < 511; i += 64) { const int d = i - 255; float v = d > 0 ? hf[d] : (d < 0 ? hb[-d] : hf[0] + hb[0]); tp[i] = v * sc[o]; } }
    const float* cw = c.in[9] + (size_t)l * 3 * 1536; const float* cbv = c.in[10] + (size_t)l * 1536; const float* skip = c.in[17] + (size_t)l * 2 * 512;
    const bf16_t* base = WSP(bf16_t, WS_HYTC) + (size_t)b * 1536 * 256;
    float xv[3][4];
#pragma unroll 1
    for (int g = 0; g < 3; ++g) { const int ch = g * 512 + cch; const bf16_t* r = base + (size_t)ch * 256; const float w0 = cw[ch], w1 = cw[1536 + ch], w2 = cw[3072 + ch], cb = cbv[ch];
        unsigned xr[12];
#pragma unroll
        for (int i = 0; i < 4; ++i) { const int t = c.lane + 64 * i; xr[3 * i] = r[t > 0 ? t - 1 : 0]; xr[3 * i + 1] = r[t]; xr[3 * i + 2] = r[t < 255 ? t + 1 : 255]; }
        asm volatile("" : "+v"(xr[0]), "+v"(xr[1]), "+v"(xr[2]), "+v"(xr[3]), "+v"(xr[4]), "+v"(xr[5]), "+v"(xr[6]), "+v"(xr[7]), "+v"(xr[8]), "+v"(xr[9]), "+v"(xr[10]), "+v"(xr[11]));
        float xg[4];
#pragma unroll
        for (int i = 0; i < 4; ++i) { const int t = c.lane + 64 * i; const float xm = t > 0 ? bf2f((bf16_t)xr[3 * i]) : 0.f, x0 = bf2f((bf16_t)xr[3 * i + 1]), xp = t < 255 ? bf2f((bf16_t)xr[3 * i + 2]) : 0.f; xg[i] = cb + w0 * xm + w1 * x0 + w2 * xp; }
#pragma unroll
        for (int i = 0; i < 4; ++i) { if (g == 0) xv[0][i] = xg[i]; else if (g == 1) xv[1][i] = xg[i]; else xv[2][i] = xg[i]; } }
#pragma unroll
    for (int i = 0; i < 4; ++i) vv[c.lane + 64 * i] = xv[0][i];
    LDS_FENCE();
    const float sk1 = skip[cch], sk2 = skip[512 + cch];
    float y[4]; const int lane = c.lane;
    { float s0 = 0.f, s1 = 0.f, s2 = 0.f, s3 = 0.f; const LAS float* t1 = tp1 + lane + 255;
#pragma unroll 4
      for (int k = 0; k < 256; k += 4) { const f32x4 v4 = *(const LAS f32x4*)(vv + k);
#pragma unroll
          for (int j = 0; j < 4; ++j) { const float vk = v4[j]; s0 += t1[-(k + j)] * vk; s1 += t1[64 - (k + j)] * vk; s2 += t1[128 - (k + j)] * vk; s3 += t1[192 - (k + j)] * vk; } }
      y[0] = xv[1][0] * (s0 + sk1 * xv[0][0]); y[1] = xv[1][1] * (s1 + sk1 * xv[0][1]); y[2] = xv[1][2] * (s2 + sk1 * xv[0][2]); y[3] = xv[1][3] * (s3 + sk1 * xv[0][3]); }
#pragma unroll
    for (int i = 0; i < 4; ++i) zz[lane + 64 * i] = y[i];
    LDS_FENCE();
    bf16_t* yo = WSP(bf16_t, WS_YHY) + (size_t)(NLAT + b * 256) * 512 + cch;
    { float s0 = 0.f, s1 = 0.f, s2 = 0.f, s3 = 0.f; const LAS float* t2 = tp2 + lane + 255;
#pragma unroll 4
      for (int k = 0; k < 256; k += 4) { const f32x4 v4 = *(const LAS f32x4*)(zz + k);
#pragma unroll
          for (int j = 0; j < 4; ++j) { const float vk = v4[j]; s0 += t2[-(k + j)] * vk; s1 += t2[64 - (k + j)] * vk; s2 += t2[128 - (k + j)] * vk; s3 += t2[192 - (k + j)] * vk; } }
      const float sv[4] = {s0, s1, s2, s3};
#pragma unroll
      for (int i = 0; i < 4; ++i) { const int t = lane + 64 * i; yo[(size_t)t * 512] = (ABL & 1) ? (bf16_t)0 : f2bf(xv[2][i] * (sv[i] + sk2 * y[i])); } }
    LDS_FENCE();
}
DI void yhy_tr_tile2(const Ctx& c_, int pair) {
    Ctx c = c_; asm volatile("" : "+v"(c.tid));
    LAS bf16_t* t = (LAS bf16_t*)c.lds;
    u32x4 a[2];
#pragma unroll
    for (int k = 0; k < 2; ++k) { const int it = pair * 2 + k, b = it >> 10, c0 = ((it >> 7) & 7) * 64, t0 = (it & 127) * 64; const int ch = c.tid >> 3, tq = (c.tid & 7) * 8;
        a[k] = *(const u32x4*)(WSP(bf16_t, WS_YHT) + ((size_t)b * 512 + c0 + ch) * 8192 + t0 + tq); }
#pragma unroll
    for (int k = 0; k < 2; ++k) { const int ch = c.tid >> 3, tq = (c.tid & 7) * 8; LAS unsigned* d = (LAS unsigned*)(t + k * 64 * 66 + ch * 66 + tq); d[0] = a[k].x; d[1] = a[k].y; d[2] = a[k].z; d[3] = a[k].w; }
    __syncthreads();
#pragma unroll
    for (int k = 0; k < 2; ++k) { const int it = pair * 2 + k, b = it >> 10, c0 = ((it >> 7) & 7) * 64, t0 = (it & 127) * 64; const int tk = c.tid >> 3, cq = (c.tid & 7) * 8; bf16_t v[8];
#pragma unroll
        for (int j = 0; j < 8; ++j) v[j] = t[k * 64 * 66 + (cq + j) * 66 + tk];
        u32x4 w; w.x = v[0] | ((unsigned)v[1] << 16); w.y = v[2] | ((unsigned)v[3] << 16); w.z = v[4] | ((unsigned)v[5] << 16); w.w = v[6] | ((unsigned)v[7] << 16);
        if (ABL & 1) w = (u32x4){0u, 0u, 0u, 0u};
        *(u32x4*)(WSP(bf16_t, WS_YHY) + (size_t)(b * 8192 + t0 + tk) * 512 + c0 + cq) = w; }
    __syncthreads();
}
template <bool FINAL, int D>
DI void rg_dir(const Ctx& c, int l, int b, int chunk) {
    int lane = c.lane; asm volatile("" : "+v"(lane));
    const int g = c.wid, ch = g * 64 + lane, fr = lane & 15, fq = lane >> 4;
    LAS unsigned char* wl = c.lds + c.wid * 16384;
    LAS bf16_t* xcs = (LAS bf16_t*)wl;
    LAS cf2* stg = (LAS cf2*)(wl + 2304);
    const bool isctx = chunk < 4;
    const int rowbase = isctx ? NLAT + b * 256 : b * 8192, seglen = isctx ? 256 : 8192, tbase = isctx ? chunk * 64 : (chunk - 4) * 64;
    const bf16_t* P2 = WSP(bf16_t, WS_P2);
    const int pd = (l * 2 + D) * 512 + ch;
    const float* cwp = c.in[18] + (size_t)(l * 2 + D) * 4 * 512 + ch;
    const float cw0 = cwp[0], cw1 = cwp[512], cw2 = cwp[1024], cw3 = cwp[1536], cb = c.in[19][pd], ba = c.in[21][pd], bx = c.in[23][pd];
    const float lam = c.in[24][pd]; const float cneg = -8.0f * log1pf(expf(-lam));
    bf16x8 wa[4][2], wx[4][2];
    { const bf16_t* wb = WSP(bf16_t, WS_RGW) + (size_t)((D * 2 + 0) * 8 + g) * 4096; const bf16_t* xb = WSP(bf16_t, WS_RGW) + (size_t)((D * 2 + 1) * 8 + g) * 4096;
#pragma unroll
      for (int nt = 0; nt < 4; ++nt)
#pragma unroll
          for (int ks = 0; ks < 2; ++ks) { wa[nt][ks] = *(const bf16x8*)(wb + (nt * 16 + fr) * 64 + fq * 8 + 32 * ks); wx[nt][ks] = *(const bf16x8*)(xb + (nt * 16 + fr) * 64 + fq * 8 + 32 * ks); } }
    float h = 0.f, Aagg = 1.f, Bagg = 0.f;
    if (FINAL) h = WSP(float, WS_RGCAR)[(size_t)((b * 2 + D) * NCHK + chunk) * 512 + ch];
    float* HF = WSP(float, WS_HF);
    float um3, um2, um1;
    { const int t3 = tbase + (D ? 66 : -3), t2 = tbase + (D ? 65 : -2), t1 = tbase + (D ? 64 : -1);
      um3 = (t3 >= 0 && t3 < seglen) ? bf2f(P2[(size_t)(rowbase + t3) * P2W + PC_RGX + ch]) : 0.f;
      um2 = (t2 >= 0 && t2 < seglen) ? bf2f(P2[(size_t)(rowbase + t2) * P2W + PC_RGX + ch]) : 0.f;
      um1 = (t1 >= 0 && t1 < seglen) ? bf2f(P2[(size_t)(rowbase + t1) * P2W + PC_RGX + ch]) : 0.f; }
    bf16_t uall[64];
#pragma unroll
    for (int s = 0; s < 64; ++s) { const int tok = tbase + (D ? 63 - s : s); uall[s] = P2[(size_t)(rowbase + tok) * P2W + PC_RGX + ch]; }
    asm volatile("" ::: "memory");
#pragma unroll
    for (int mt = 0; mt < 4; ++mt) {
        bf16_t uc[16], gc[16]; float hc[16];
#pragma unroll
        for (int q = 0; q < 16; ++q) { uc[q] = uall[mt * 16 + q]; gc[q] = 0; hc[q] = 0.f; }
        float xcf[16];
#pragma unroll
        for (int q = 0; q < 16; ++q) {
            const float u0 = bf2f(uc[q]);
            const float xc = cb + cw0 * um3 + cw1 * um2 + cw2 * um1 + cw3 * u0;
            xcf[q] = xc; xcs[q * 72 + lane] = f2bf(xc); um3 = um2; um2 = um1; um1 = u0; }
        LDS_FENCE();
        bf16x8 af[2];
#pragma unroll
        for (int ks = 0; ks < 2; ++ks) af[ks] = *(const LAS bf16x8*)(xcs + fr * 72 + fq * 8 + 32 * ks);
        f32x4 ar[4], ai[4];
#pragma unroll
        for (int nt = 0; nt < 4; ++nt) { ar[nt] = (f32x4){0.f, 0.f, 0.f, 0.f}; ai[nt] = (f32x4){0.f, 0.f, 0.f, 0.f};
#pragma unroll
            for (int ks = 0; ks < 2; ++ks) { ar[nt] = __builtin_amdgcn_mfma_f32_16x16x32_bf16(af[ks], wa[nt][ks], ar[nt], 0, 0, 0); ai[nt] = __builtin_amdgcn_mfma_f32_16x16x32_bf16(af[ks], wx[nt][ks], ai[nt], 0, 0, 0); } }
#pragma unroll
        for (int nt = 0; nt < 4; ++nt)
#pragma unroll
            for (int jj = 0; jj < 4; ++jj) stg[(fq * 4 + jj) * 64 + nt * 16 + fr] = mk2(ar[nt][jj], ai[nt][jj]);
        LDS_FENCE();
#pragma unroll
        for (int q = 0; q < 16; ++q) { const int s = mt * 16 + q, tokl = D ? 63 - s : s;
            const cf2 pre = stg[q * 64 + lane];
            const float r = sigmoidf_(pre.x + ba), ii = sigmoidf_(pre.y + bx);
            const float a = __expf(r * cneg);
            const float bb = sqrtf(fmaxf(1.0f - a * a, 0.f)) * ii * xcf[q];
            if (FINAL) { h = a * h + bb;
                const size_t row = (size_t)(rowbase + tbase + tokl);
                if (D == 0) HF[row * 512 + ch] = h;
                else WSP(bf16_t, WS_YRG)[row * 512 + ch] = (ABL & 2) ? (bf16_t)0 : f2bf((hc[q] + h) * geluf_(bf2f(gc[q]))); }
            else { const unsigned w = pk_bf16(r * cneg, bb);
                WSP(unsigned, WS_RGAB)[((size_t)(rowbase + tbase + tokl) * 2 + D) * 512 + ch] = w;
                const float a2 = __expf(bflo(w)), b2 = bfhi(w); Bagg = a2 * Bagg + b2; Aagg *= a2; } }
        LDS_FENCE();
    }
    if (!FINAL) WSP(cf2, WS_RGAGG)[(size_t)((b * 2 + D) * NCHK + chunk) * 512 + ch] = mk2(Aagg, Bagg);
}
template <bool FINAL>
DI void rg_item(const Ctx& c, int l, int item) {
    const int b = item / NCHK, chunk = item % NCHK;
    rg_dir<FINAL, 0>(c, l, b, chunk);
    rg_dir<FINAL, 1>(c, l, b, chunk);
}
DI void rg_c_item(const Ctx& c, int item) {
    int lane = c.lane; asm volatile("" : "+v"(lane));
    const int b = item / NCHK, chunk = item % NCHK, ch = c.wid * 64 + lane;
    LAS float* hb = (LAS float*)(c.lds + c.wid * 16384) + lane;
    const bool isctx = chunk < 4;
    const size_t r0 = (size_t)(isctx ? NLAT + b * 256 + chunk * 64 : b * 8192 + (chunk - 4) * 64);
    const unsigned* AB = WSP(unsigned, WS_RGAB) + ch; const bf16_t* GP = WSP(bf16_t, WS_P2) + PC_RGG + ch; bf16_t* YP = WSP(bf16_t, WS_YRG) + ch;
    const float* car = WSP(float, WS_RGCAR) + ch;
    {
        float h = car[(size_t)((b * 2 + 1) * NCHK + chunk) * 512];
        unsigned w[64];
#pragma unroll
        for (int q = 0; q < 64; ++q) w[q] = AB[((r0 + q) * 2 + 1) * 512];
        asm volatile("" ::: "memory");
#pragma unroll
        for (int s2 = 0; s2 < 64; ++s2) { const int tok = 63 - s2; h = __builtin_fmaf(__expf(bflo(w[tok])), h, bfhi(w[tok])); hb[tok * 64] = h; }
    }
    {
        float h = car[(size_t)((b * 2 + 0) * NCHK + chunk) * 512];
        unsigned w[64]; bf16_t g[64];
#pragma unroll
        for (int q = 0; q < 64; ++q) { w[q] = AB[((r0 + q) * 2 + 0) * 512]; g[q] = GP[(r0 + q) * P2W]; }
        asm volatile("" ::: "memory");
#pragma unroll
        for (int tok = 0; tok < 64; ++tok) { h = __builtin_fmaf(__expf(bflo(w[tok])), h, bfhi(w[tok]));
            YP[(r0 + tok) * 512] = (ABL & 2) ? (bf16_t)0 : f2bf((h + hb[tok * 64]) * geluf_(bf2f(g[tok]))); }
    }
}
DI int scan_order(int d, int i) { return d == 0 ? i : (i < 4 ? 3 - i : 135 - i); }
DI void rg_carry_scan(const Ctx& c) {
    for (int idx = c.bid * 512 + c.tid; idx < 4096; idx += c.G * 512) {
    const int bd = idx >> 9, ch = idx & 511, d = bd & 1;
    const cf2* agg = WSP(cf2, WS_RGAGG) + (size_t)bd * NCHK * 512 + ch; float* car = WSP(float, WS_RGCAR) + (size_t)bd * NCHK * 512 + ch;
    float cv = 0.f;
#pragma unroll 1
    for (int i0 = 0; i0 < NCHK; i0 += 12) {
        cf2 ab[12];
#pragma unroll
        for (int u = 0; u < 12; ++u) ab[u] = agg[(size_t)scan_order(d, i0 + u) * 512];
        asm volatile("" ::: "memory");
#pragma unroll
        for (int u = 0; u < 12; ++u) { car[(size_t)scan_order(d, i0 + u) * 512] = cv; cv = ab[u].x * cv + ab[u].y; }
    }
    }
}

DI int gla_row(int b, int chunk, int i) {
    if (chunk < 4) return NLAT + b * 256 + chunk * 64 + i;
    const int jl = chunk - 4; return b * 8192 + ((jl & 1) * 64 + i) * 64 + (jl >> 1);
}
DI void gla_a_item(const Ctx& c, int item) {
    const int h = item & 3, bc = item >> 2, b = bc / NCHK, chunk = bc % NCHK;
    int lane = c.lane; asm volatile("" : "+v"(lane));
    const int fr = lane & 15, fq = lane >> 4, tid = c.wid * 64 + lane;
    LAS bf16_t* vT = (LAS bf16_t*)c.lds;
    LAS bf16_t* kdT = vT + 128 * 68;
    const bf16_t* P2 = WSP(bf16_t, WS_P2);
    { const int s = tid >> 3, ec = (tid & 7) * 16; const bf16_t* vp = P2 + (size_t)gla_row(b, chunk, s) * P2W + PC_V + h * 128 + ec;
      const u32x4 a = *(const u32x4*)vp, bq = *(const u32x4*)(vp + 8);
      const unsigned w[8] = {a.x, a.y, a.z, a.w, bq.x, bq.y, bq.z, bq.w};
#pragma unroll
      for (int j = 0; j < 8; ++j) { vT[(ec + 2 * j) * 68 + s] = (bf16_t)(w[j] & 0xffffu); vT[(ec + 2 * j + 1) * 68 + s] = (bf16_t)(w[j] >> 16); } }
    {
        const int d = c.wid >> 2, qt = c.wid & 3, dk = lane;
        unsigned short lar[64]; unsigned short kr[16];
#pragma unroll
        for (int i = 0; i < 64; ++i) lar[i] = P2[(size_t)gla_row(b, chunk, i) * P2W + (d ? PC_LAB : PC_LAF) + h * 64 + dk];
#pragma unroll
        for (int j = 0; j < 16; ++j) kr[j] = P2[(size_t)gla_row(b, chunk, qt * 16 + j) * P2W + PC_K + h * 64 + dk];
        asm volatile("" ::: "memory");
        float tot = 0.f, before = 0.f;
#pragma unroll
        for (int i = 0; i < 64; ++i) { const float v = bf2f(lar[i]); tot += v; if (i < qt * 16) before += v; }
        LAS bf16_t* kd = kdT + d * 64 * 68 + dk * 68;
        if (d == 0) { float rem = tot - before;
#pragma unroll
            for (int q4 = 0; q4 < 4; ++q4) if (q4 == qt) {
#pragma unroll
                for (int j = 0; j < 16; ++j) { const int i = q4 * 16 + j; rem -= bf2f(lar[i]); kd[i] = f2bf(bf2f(kr[j]) * __expf(rem)); } }
        } else { float pre = before;
#pragma unroll
            for (int q4 = 0; q4 < 4; ++q4) if (q4 == qt) {
#pragma unroll
                for (int j = 0; j < 16; ++j) { const int i = q4 * 16 + j; kd[i] = f2bf(bf2f(kr[j]) * __expf(pre)); pre += bf2f(lar[i]); } }
        }
        if (qt == 0) WSP(float, WS_GDEC)[(size_t)((((b * 4 + h) * 2 + d) * NCHK) + chunk) * 64 + dk] = __expf(tot);
    }
    __syncthreads();
    {
        const int d = c.wid >> 2, eq = c.wid & 3;
        f32x4 acc[2][4];
#pragma unroll
        for (int et = 0; et < 2; ++et)
#pragma unroll
            for (int dt = 0; dt < 4; ++dt) acc[et][dt] = (f32x4){0.f, 0.f, 0.f, 0.f};
#pragma unroll
        for (int ks = 0; ks < 2; ++ks) {
            bf16x8 af[2], bfr[4];
#pragma unroll
            for (int et = 0; et < 2; ++et) { const LAS u32x2* p = (const LAS u32x2*)(vT + ((eq * 2 + et) * 16 + fr) * 68 + fq * 8 + 32 * ks); const u32x2 lo = p[0], hi = p[1]; u32x4 w = {lo.x, lo.y, hi.x, hi.y}; af[et] = __builtin_bit_cast(bf16x8, w); }
#pragma unroll
            for (int dt = 0; dt < 4; ++dt) { const LAS u32x2* p = (const LAS u32x2*)(kdT + d * 64 * 68 + (dt * 16 + fr) * 68 + fq * 8 + 32 * ks); const u32x2 lo = p[0], hi = p[1]; u32x4 w = {lo.x, lo.y, hi.x, hi.y}; bfr[dt] = __builtin_bit_cast(bf16x8, w); }
#pragma unroll
            for (int et = 0; et < 2; ++et)
#pragma unroll
                for (int dt = 0; dt < 4; ++dt) acc[et][dt] = __builtin_amdgcn_mfma_f32_16x16x32_bf16(af[et], bfr[dt], acc[et][dt], 0, 0, 0);
        }
        float* st = WSP(float, WS_GST) + (size_t)((((b * 4 + h) * 2 + d) * NCHK) + chunk) * 8192;
#pragma unroll
        for (int et = 0; et < 2; ++et)
#pragma unroll
            for (int dt = 0; dt < 4; ++dt)
#pragma unroll
                for (int jj = 0; jj < 4; ++jj) st[((eq * 2 + et) * 16 + fq * 4 + jj) * 64 + dt * 16 + fr] = acc[et][dt][jj];
    }
    __syncthreads();
}
DI void gla_state_scan(const Ctx& c) {
    for (int idx = c.bid * 512 + c.tid; idx < 131072; idx += c.G * 512) {
    const int chain = idx >> 12, e2 = idx & 4095, d = chain & 1, dk2 = (e2 & 31) * 2;
    cf2* st = (cf2*)(WSP(float, WS_GST) + (size_t)chain * NCHK * 8192) + e2;
    const cf2* dc = (const cf2*)(WSP(float, WS_GDEC) + (size_t)chain * NCHK * 64 + dk2);
    cf2 S = mk2(0.f, 0.f);
#pragma unroll 1
    for (int i0 = 0; i0 < NCHK; i0 += 4) {
        cf2 ds[4], de[4];
#pragma unroll
        for (int u = 0; u < 4; ++u) { const int ck = scan_order(d, i0 + u); ds[u] = st[(size_t)ck * 4096]; de[u] = dc[(size_t)ck * 32]; }
#pragma unroll
        for (int u = 0; u < 4; ++u) { const int ck = scan_order(d, i0 + u); st[(size_t)ck * 4096] = S; S = mk2(de[u].x * S.x + ds[u].x, de[u].y * S.y + ds[u].y); }
    }
    }
}
DI void gla_c_item(const Ctx& c, int l, int item) {
    const int hp = item & 1, bc = item >> 1, b = bc / NCHK, chunk = bc % NCHK;
    int lane = c.lane; asm volatile("" : "+v"(lane));
    const int hl = c.wid >> 2, it = c.wid & 3, h = hp * 2 + hl, fr = lane & 15, fq = lane >> 4;
    LAS unsigned char* hb = c.lds + hl * 63488;
    LAS bf16_t* qg = (LAS bf16_t*)hb;
    LAS bf16_t* kg = qg + 2 * 64 * 72;
    LAS bf16_t* vT = kg + 2 * 64 * 72;
    LAS bf16_t* Pw = vT + 128 * 68 + it * 16 * 72;
    const bf16_t* P2 = WSP(bf16_t, WS_P2);
    if (it < 2) {
        const int d = it, dk = lane; float cum = 0.f;
        LAS bf16_t* qd = qg + d * 64 * 72 + dk; LAS bf16_t* kd = kg + d * 64 * 72 + dk;
#pragma unroll 1
        for (int s0 = 0; s0 < 64; s0 += 16) {
            unsigned la[16], qq[16], kk[16];
#pragma unroll
            for (int j = 0; j < 16; ++j) { const int i = d ? 63 - (s0 + j) : s0 + j; const bf16_t* rp = P2 + (size_t)gla_row(b, chunk, i) * P2W;
                la[j] = rp[(d ? PC_LAB : PC_LAF) + h * 64 + dk]; qq[j] = rp[PC_Q + h * 64 + dk]; kk[j] = rp[PC_K + h * 64 + dk]; }
            asm volatile("" : "+v"(la[0]), "+v"(la[1]), "+v"(la[2]), "+v"(la[3]), "+v"(la[4]), "+v"(la[5]), "+v"(la[6]), "+v"(la[7]), "+v"(qq[0]), "+v"(qq[1]), "+v"(qq[2]), "+v"(qq[3]), "+v"(qq[4]), "+v"(qq[5]), "+v"(qq[6]), "+v"(qq[7]),
                         "+v"(kk[0]), "+v"(kk[1]), "+v"(kk[2]), "+v"(kk[3]), "+v"(kk[4]), "+v"(kk[5]), "+v"(kk[6]), "+v"(kk[7]));
            asm volatile("" : "+v"(la[8]), "+v"(la[9]), "+v"(la[10]), "+v"(la[11]), "+v"(la[12]), "+v"(la[13]), "+v"(la[14]), "+v"(la[15]), "+v"(qq[8]), "+v"(qq[9]), "+v"(qq[10]), "+v"(qq[11]), "+v"(qq[12]), "+v"(qq[13]), "+v"(qq[14]), "+v"(qq[15]),
                         "+v"(kk[8]), "+v"(kk[9]), "+v"(kk[10]), "+v"(kk[11]), "+v"(kk[12]), "+v"(kk[13]), "+v"(kk[14]), "+v"(kk[15]));
#pragma unroll
            for (int j = 0; j < 16; ++j) { const int i = d ? 63 - (s0 + j) : s0 + j;
                cum += bf2f((bf16_t)la[j]);
                const float qv = bf2f((bf16_t)qq[j]), kv = bf2f((bf16_t)kk[j]);
                qd[i * 72] = f2bf(qv * 0.125f * __expf(cum)); kd[i * 72] = f2bf(kv * __expf(-cum)); }
        }
    } else {
        const int t = (it - 2) * 64 + lane, s = t >> 1, e0 = (t & 1) * 64; const bf16_t* vp = P2 + (size_t)gla_row(b, chunk, s) * P2W + PC_V + h * 128 + e0;
#pragma unroll
        for (int q8 = 0; q8 < 8; ++q8) { const u32x4 a = *(const u32x4*)(vp + q8 * 8); const unsigned w[4] = {a.x, a.y, a.z, a.w};
#pragma unroll
            for (int j = 0; j < 4; ++j) { vT[(e0 + q8 * 8 + 2 * j) * 68 + s] = (bf16_t)(w[j] & 0xffffu); vT[(e0 + q8 * 8 + 2 * j + 1) * 68 + s] = (bf16_t)(w[j] >> 16); } }
    }
    __syncthreads();
#ifdef DEBUG_DET
    if (hp == 0) {
        const size_t slot = (size_t)(bc * 2 + hl);
        unsigned* dq = (unsigned*)(c.ws + WS_END) + slot * 9216; const LAS unsigned* sq = (const LAS unsigned*)hb;
        for (int i = it * 64 + lane; i < 256 * 32; i += 256) dq[i] = sq[(i >> 5) * 36 + (i & 31)];
        unsigned* dv = (unsigned*)(c.ws + WS_END + 40000000) + slot * 4352; const LAS unsigned* sv = (const LAS unsigned*)vT;
        for (int i = it * 64 + lane; i < 128 * 32; i += 256) dv[i] = sv[(i >> 5) * 34 + (i & 31)];
    }
#endif
    f32x4 o[8];
#pragma unroll
    for (int et = 0; et < 8; ++et) o[et] = (f32x4){0.f, 0.f, 0.f, 0.f};
#pragma unroll
    for (int d = 0; d < 2; ++d) {
        bf16x8 qf[2];
#pragma unroll
        for (int ks = 0; ks < 2; ++ks) qf[ks] = *(const LAS bf16x8*)(qg + d * 64 * 72 + (it * 16 + fr) * 72 + fq * 8 + 32 * ks);
        f32x4 sc[4];
#pragma unroll
        for (int st = 0; st < 4; ++st) { sc[st] = (f32x4){0.f, 0.f, 0.f, 0.f};
#pragma unroll
            for (int ks = 0; ks < 2; ++ks) { const bf16x8 kf = *(const LAS bf16x8*)(kg + d * 64 * 72 + (st * 16 + fr) * 72 + fq * 8 + 32 * ks); sc[st] = __builtin_amdgcn_mfma_f32_16x16x32_bf16(qf[ks], kf, sc[st], 0, 0, 0); } }
#pragma unroll
        for (int st = 0; st < 4; ++st)
#pragma unroll
            for (int jj = 0; jj < 4; ++jj) { const int ig = it * 16 + fq * 4 + jj, sg = st * 16 + fr; const bool keep = d == 0 ? (sg <= ig) : (sg > ig);
                Pw[(fq * 4 + jj) * 72 + st * 16 + fr] = f2bf(keep ? sc[st][jj] : 0.f); }
        __syncthreads();
#ifdef DEBUG_DET
        if (hp == 0) { const size_t slot = (size_t)(((bc * 2 + hl) * 2 + d) * 4 + it);
            unsigned* dp = (unsigned*)(c.ws + WS_END + 60000000) + slot * 576; const LAS unsigned* sp = (const LAS unsigned*)Pw;
            for (int i = lane; i < 16 * 32; i += 64) dp[i] = sp[(i >> 5) * 36 + (i & 31)]; }
#endif
        bf16x8 pf[2];
#pragma unroll
        for (int ks = 0; ks < 2; ++ks) pf[ks] = *(const LAS bf16x8*)(Pw + fr * 72 + fq * 8 + 32 * ks);
        const float* stp = WSP(float, WS_GST) + (size_t)((((b * 4 + h) * 2 + d) * NCHK) + chunk) * 8192;
#pragma unroll
        for (int eh = 0; eh < 2; ++eh) {
            f32x4 sv[4][2][2];
#pragma unroll
            for (int e4 = 0; e4 < 4; ++e4)
#pragma unroll
                for (int ks = 0; ks < 2; ++ks) { const float* sp_ = stp + ((eh * 4 + e4) * 16 + fr) * 64 + fq * 8 + 32 * ks; sv[e4][ks][0] = *(const f32x4*)sp_; sv[e4][ks][1] = *(const f32x4*)(sp_ + 4); }
            asm volatile("" : "+v"(sv[0][0][0]), "+v"(sv[0][0][1]), "+v"(sv[0][1][0]), "+v"(sv[0][1][1]), "+v"(sv[1][0][0]), "+v"(sv[1][0][1]), "+v"(sv[1][1][0]), "+v"(sv[1][1][1]),
                         "+v"(sv[2][0][0]), "+v"(sv[2][0][1]), "+v"(sv[2][1][0]), "+v"(sv[2][1][1]), "+v"(sv[3][0][0]), "+v"(sv[3][0][1]), "+v"(sv[3][1][0]), "+v"(sv[3][1][1]));
#pragma unroll
            for (int e4 = 0; e4 < 4; ++e4) { const int et = eh * 4 + e4;
#pragma unroll
                for (int ks = 0; ks < 2; ++ks) {
                    const LAS u32x2* p = (const LAS u32x2*)(vT + (et * 16 + fr) * 68 + fq * 8 + 32 * ks); const u32x2 lo = p[0], hi = p[1]; u32x4 w = {lo.x, lo.y, hi.x, hi.y};
                    o[et] = __builtin_amdgcn_mfma_f32_16x16x32_bf16(pf[ks], __builtin_bit_cast(bf16x8, w), o[et], 0, 0, 0);
                    const f32x4 s0 = sv[e4][ks][0], s1 = sv[e4][ks][1];
                    u32x4 sw; sw.x = pk_bf16(s0[0], s0[1]); sw.y = pk_bf16(s0[2], s0[3]); sw.z = pk_bf16(s1[0], s1[1]); sw.w = pk_bf16(s1[2], s1[3]);
                    o[et] = __builtin_amdgcn_mfma_f32_16x16x32_bf16(qf[ks], __builtin_bit_cast(bf16x8, sw), o[et], 0, 0, 0);
                }
            }
        }
        __syncthreads();
#ifdef DEBUG_DET
        if (hp == 0 && b == 0) { const size_t slot = (size_t)(((chunk * 2 + hl) * 2 + d) * 4 + it);
            float* dp = (float*)(c.ws + WS_END + 80000000) + slot * 2048 + lane * 32;
#pragma unroll
            for (int et = 0; et < 8; ++et) *(f32x4*)(dp + et * 4) = o[et]; }
#endif
    }
    float ss[4];
#pragma unroll
    for (int jj = 0; jj < 4; ++jj) { float s = 0.f;
#pragma unroll
        for (int et = 0; et < 8; ++et) s += o[et][jj] * o[et][jj];
        s += __shfl_xor(s, 1); s += __shfl_xor(s, 2); s += __shfl_xor(s, 4); s += __shfl_xor(s, 8);
        ss[jj] = rsqrtf(s * (1.0f / 128.0f) + NORM_EPS); }
    const float* ng = c.in[27] + (size_t)l * 128;
    unsigned gv[4][8]; float ngv[8];
#pragma unroll
    for (int et = 0; et < 8; ++et) ngv[et] = ng[et * 16 + fr];
#pragma unroll
    for (int jj = 0; jj < 4; ++jj) { const bf16_t* gp = P2 + (size_t)gla_row(b, chunk, it * 16 + fq * 4 + jj) * P2W + PC_GG + h * 128;
#pragma unroll
        for (int et = 0; et < 8; ++et) gv[jj][et] = gp[et * 16 + fr]; }
#pragma unroll
    for (int jj = 0; jj < 4; ++jj) asm volatile("" : "+v"(gv[jj][0]), "+v"(gv[jj][1]), "+v"(gv[jj][2]), "+v"(gv[jj][3]), "+v"(gv[jj][4]), "+v"(gv[jj][5]), "+v"(gv[jj][6]), "+v"(gv[jj][7]));
#pragma unroll
    for (int jj = 0; jj < 4; ++jj) { const size_t row = (size_t)gla_row(b, chunk, it * 16 + fq * 4 + jj);
        bf16_t* yp = WSP(bf16_t, WS_YGLA) + row * 512 + h * 128;
#pragma unroll
        for (int et = 0; et < 8; ++et) { const int e = et * 16 + fr; yp[e] = (ABL & 4) ? (bf16_t)0 : f2bf(o[et][jj] * ss[jj] * ngv[et] * siluf_(bf2f((bf16_t)gv[jj][et]))); } }
    __syncthreads();
}
DI void ce(float& a, float& b) { const float t = fmaxf(a, b); b = fminf(a, b); a = t; }
DI void ce2(float& va, unsigned& pa, float& vb, unsigned& pb) { const bool s = va >= vb; const float hv = s ? va : vb, lv = s ? vb : va; const unsigned hp = s ? pa : pb, lp = s ? pb : pa; va = hv; vb = lv; pa = hp; pb = lp; }
DI void sort16(float (&x)[16]) {
#pragma unroll
    for (int kk = 1; kk <= 4; ++kk)
#pragma unroll
        for (int jj = kk - 1; jj >= 0; --jj)
#pragma unroll
            for (int i = 0; i < 16; ++i) { const int k = 1 << kk, j = 1 << jj, l = i ^ j; if (l > i) { if ((i & k) == 0) ce(x[i], x[l]); else ce(x[l], x[i]); } }
}
DI void merge16(float (&x)[16], const float (&y)[16]) {
#pragma unroll
    for (int i = 0; i < 16; ++i) x[i] = fmaxf(x[i], y[15 - i]);
#pragma unroll
    for (int jj = 3; jj >= 0; --jj)
#pragma unroll
        for (int i = 0; i < 16; ++i) { const int j = 1 << jj, l = i ^ j; if (l > i) ce(x[i], x[l]); }
}
DI void sort16p(float (&x)[16], unsigned (&p)[16]) {
#pragma unroll
    for (int kk = 1; kk <= 4; ++kk)
#pragma unroll
        for (int jj = kk - 1; jj >= 0; --jj)
#pragma unroll
            for (int i = 0; i < 16; ++i) { const int k = 1 << kk, j = 1 << jj, l = i ^ j; if (l > i) { if ((i & k) == 0) ce2(x[i], p[i], x[l], p[l]); else ce2(x[l], p[l], x[i], p[i]); } }
}
DI void merge16p(float (&x)[16], unsigned (&p)[16], const float (&y)[16], const unsigned (&q)[16]) {
#pragma unroll
    for (int i = 0; i < 16; ++i) { const bool s = x[i] >= y[15 - i]; p[i] = s ? p[i] : q[15 - i]; x[i] = s ? x[i] : y[15 - i]; }
#pragma unroll
    for (int jj = 3; jj >= 0; --jj)
#pragma unroll
        for (int i = 0; i < 16; ++i) { const int j = 1 << jj, l = i ^ j; if (l > i) ce2(x[i], p[i], x[l], p[l]); }
}
DI void peer_half_top16(const bf16_t* qrow, const bf16_t* keys, int lane, float (&res)[16]) {
    const int tl = lane & 31, hf = lane >> 5;
    f32x16 acc[4];
#pragma unroll
    for (int t4 = 0; t4 < 4; ++t4)
#pragma unroll
        for (int r = 0; r < 16; ++r) acc[t4][r] = 0.f;
    bf16x8 bq[8];
#pragma unroll
    for (int ks = 0; ks < 8; ++ks) bq[ks] = *(const bf16x8*)(qrow + 8 * hf + 16 * ks);
#pragma unroll
    for (int kp = 0; kp < 4; ++kp) {
        bf16x8 ak[2][4];
#pragma unroll
        for (int k4 = 0; k4 < 2; ++k4)
#pragma unroll
            for (int t4 = 0; t4 < 4; ++t4) ak[k4][t4] = *(const bf16x8*)(keys + (size_t)(t4 * 32 + tl) * 128 + 8 * hf + 16 * (kp * 2 + k4));
        asm volatile("" ::: "memory");
#pragma unroll
        for (int k4 = 0; k4 < 2; ++k4)
#pragma unroll
            for (int t4 = 0; t4 < 4; ++t4) acc[t4] = __builtin_amdgcn_mfma_f32_32x32x16_bf16(ak[k4][t4], bq[kp * 2 + k4], acc[t4], 0, 0, 0);
    }
    float L0[16], L1[16], L2[16], L3[16];
#pragma unroll
    for (int r = 0; r < 16; ++r) { const unsigned n = (unsigned)((r & 3) + 8 * (r >> 2) + 4 * hf);
        L0[r] = __uint_as_float((__float_as_uint(acc[0][r]) & ~127u) | n); L1[r] = __uint_as_float((__float_as_uint(acc[1][r]) & ~127u) | (32u + n));
        L2[r] = __uint_as_float((__float_as_uint(acc[2][r]) & ~127u) | (64u + n)); L3[r] = __uint_as_float((__float_as_uint(acc[3][r]) & ~127u) | (96u + n)); }
    sort16(L0); sort16(L1); sort16(L2); sort16(L3);
    merge16(L0, L1); merge16(L2, L3); merge16(L0, L2);
#pragma unroll
    for (int i = 0; i < 16; ++i) L1[i] = __shfl_xor(L0[i], 32);
    merge16(L0, L1);
#pragma unroll
    for (int i = 0; i < 16; ++i) res[i] = L0[i];
}
DI void peer_topk_wave(const Ctx& c, int tile, int h) {
    int lane = c.lane; asm volatile("" : "+v"(lane));
    const int tl = lane & 31, hf = lane >> 5; const size_t row = (size_t)tile * 32 + tl;
    const bf16_t* qrow = WSP(bf16_t, WS_Q) + row * 2048 + h * 256; const bf16_t* keys = WSP(bf16_t, WS_KEYS) + (size_t)h * 2 * 128 * 128;
    float A[16], B[16];
    peer_half_top16(qrow, keys, lane, A);
    peer_half_top16(qrow + 128, keys + 128 * 128, lane, B);
    LAS unsigned* tab = (LAS unsigned*)(c.lds + c.wid * 8192);
    float sa[16], sb[16];
#pragma unroll
    for (int i = 0; i < 16; ++i) { const unsigned ua = __float_as_uint(A[i]), ub = __float_as_uint(B[i]); sa[i] = __uint_as_float(ua & ~127u); sb[i] = __uint_as_float(ub & ~127u);
        tab[i * 64 + lane] = (ua & 127u) << 7; tab[(16 + i) * 64 + lane] = ub & 127u; }
#define PK2(i, j) __uint_as_float((__float_as_uint(sa[i] + sb[j]) & ~255u) | (unsigned)(((i) << 4) | (j)))
    float G0[16], G1[16];
#pragma unroll
    for (int j = 0; j < 16; ++j) G0[j] = PK2(0, j);
#pragma unroll
    for (int j = 0; j < 8; ++j) G1[j] = PK2(1, j);
#pragma unroll
    for (int j = 0; j < 5; ++j) G1[8 + j] = PK2(2, j);
#pragma unroll
    for (int j = 0; j < 3; ++j) G1[13 + j] = PK2(4, j);
    sort16(G1); merge16(G0, G1);
#pragma unroll
    for (int j = 0; j < 4; ++j) G1[j] = PK2(3, j);
#pragma unroll
    for (int i = 0; i < 3; ++i)
#pragma unroll
        for (int j = 0; j < 2; ++j) G1[4 + i * 2 + j] = PK2(5 + i, j);
#pragma unroll
    for (int i = 0; i < 6; ++i) G1[10 + i] = PK2(8 + i, 0);
    sort16(G1); merge16(G0, G1);
#pragma unroll
    for (int j = 0; j < 16; ++j) G1[j] = -3.0e38f;
    G1[0] = PK2(14, 0); G1[1] = PK2(15, 0); ce(G1[0], G1[1]);
    merge16(G0, G1);
#undef PK2
    LDS_FENCE();
    unsigned P0[16]; float den = 0.f; const float vmax = __uint_as_float(__float_as_uint(G0[0]) & ~255u);
#pragma unroll
    for (int i = 0; i < 16; ++i) { const unsigned u = __float_as_uint(G0[i]); const unsigned ci = (u >> 4) & 15u, cj = u & 15u;
        P0[i] = tab[ci * 64 + lane] | tab[(16 + cj) * 64 + lane];
        G0[i] = __expf(__uint_as_float(u & ~255u) - vmax); den += G0[i]; }
    const float inv = 1.0f / den;
    if (hf == 0) { unsigned* dp = WSP(unsigned, WS_SELI) + row * 128 + h * 16;
#pragma unroll
        for (int i = 0; i < 4; ++i) *(u32x4*)(dp + 4 * i) = (u32x4){P0[4 * i], P0[4 * i + 1], P0[4 * i + 2], P0[4 * i + 3]}; }
    else { float* dp = WSP(float, WS_SELW) + row * 128 + h * 16;
#pragma unroll
        for (int i = 0; i < 4; ++i) *(f32x4*)(dp + 4 * i) = (f32x4){G0[4 * i] * inv, G0[4 * i + 1] * inv, G0[4 * i + 2] * inv, G0[4 * i + 3] * inv}; }
    LDS_FENCE();
}

typedef float f32x2v __attribute__((ext_vector_type(2)));
DI float dot16_fp8(const u32x4 u, const float (&h)[16]) {
    f32x2v a0 = {0.f, 0.f}, a1 = {0.f, 0.f};
#pragma unroll
    for (int k = 0; k < 4; ++k) { const f32x2v lo = __builtin_amdgcn_cvt_pk_f32_fp8((int)u[k], false), hi = __builtin_amdgcn_cvt_pk_f32_fp8((int)u[k], true);
        const f32x2v h0 = {h[4 * k], h[4 * k + 1]}, h1 = {h[4 * k + 2], h[4 * k + 3]};
        a0 = __builtin_elementwise_fma(lo, h0, a0); a1 = __builtin_elementwise_fma(hi, h1, a1); }
    const f32x2v t = a0 + a1; return t.x + t.y;
}
DI void fma16_fp8(float (&acc)[16], const u32x4 v, float cf) {
#pragma unroll
    for (int k = 0; k < 4; ++k) { const f32x2v lo = __builtin_amdgcn_cvt_pk_f32_fp8((int)v[k], false), hi = __builtin_amdgcn_cvt_pk_f32_fp8((int)v[k], true);
        acc[4 * k] += cf * lo.x; acc[4 * k + 1] += cf * lo.y; acc[4 * k + 2] += cf * hi.x; acc[4 * k + 3] += cf * hi.y; }
}
#define FP4X(w, sel) __builtin_amdgcn_cvt_scalef32_pk_f32_fp4((w), 1.0f, (sel))
DI float dot16_fp4(const u32x2 u, const float (&h)[16]) {
    f32x2v a0 = {0.f, 0.f}, a1 = {0.f, 0.f};
#pragma unroll
    for (int k = 0; k < 2; ++k) { const unsigned w = u[k]; const f32x2v v0 = FP4X(w, 0), v1 = FP4X(w, 1), v2 = FP4X(w, 2), v3 = FP4X(w, 3);
        const f32x2v h0 = {h[8 * k], h[8 * k + 1]}, h1 = {h[8 * k + 2], h[8 * k + 3]}, h2 = {h[8 * k + 4], h[8 * k + 5]}, h3 = {h[8 * k + 6], h[8 * k + 7]};
        a0 = __builtin_elementwise_fma(v0, h0, a0); a1 = __builtin_elementwise_fma(v1, h1, a1); a0 = __builtin_elementwise_fma(v2, h2, a0); a1 = __builtin_elementwise_fma(v3, h3, a1); }
    const f32x2v t = a0 + a1; return t.x + t.y;
}
DI void fma16_fp4(float (&acc)[16], const u32x2 v, float cf) {
#pragma unroll
    for (int k = 0; k < 2; ++k) { const unsigned w = v[k]; const f32x2v v0 = FP4X(w, 0), v1 = FP4X(w, 1), v2 = FP4X(w, 2), v3 = FP4X(w, 3);
        acc[8 * k] += cf * v0.x; acc[8 * k + 1] += cf * v0.y; acc[8 * k + 2] += cf * v1.x; acc[8 * k + 3] += cf * v1.y; acc[8 * k + 4] += cf * v2.x; acc[8 * k + 5] += cf * v2.y; acc[8 * k + 6] += cf * v3.x; acc[8 * k + 7] += cf * v3.y; }
}
template <bool FINAL, bool SPLIT = false>
DI void peer_expert_token(const Ctx& c, int l, int r, const float* xsrc_lat) {
    int lane = c.lane; asm volatile("" : "+v"(lane));
    const int half = SPLIT ? (c.wid & 1) : 0;
    const bf16_t* hr = WSP(bf16_t, WS_H) + (size_t)r * 1024 + lane * 16;
    float h[16];
    { const u32x4 ha = *(const u32x4*)hr, hb = *(const u32x4*)(hr + 8);
      h[0] = bflo(ha.x); h[1] = bfhi(ha.x); h[2] = bflo(ha.y); h[3] = bfhi(ha.y); h[4] = bflo(ha.z); h[5] = bfhi(ha.z); h[6] = bflo(ha.w); h[7] = bfhi(ha.w);
      h[8] = bflo(hb.x); h[9] = bfhi(hb.x); h[10] = bflo(hb.y); h[11] = bfhi(hb.y); h[12] = bflo(hb.z); h[13] = bfhi(hb.z); h[14] = bflo(hb.w); h[15] = bfhi(hb.w); }
    const unsigned* si = WSP(unsigned, WS_SELI) + (size_t)r * 128; const float* sw = WSP(float, WS_SELW) + (size_t)r * 128;
    const unsigned idx_lo = si[lane], idx_hi = si[64 + lane]; const float w_lo = sw[lane], w_hi = sw[64 + lane];
    const __attribute__((address_space(1))) unsigned char* PUV = (const __attribute__((address_space(1))) unsigned char*)(c.ws + WS_PU); const unsigned lo16 = (unsigned)lane * 16u;
    unsigned hd[2][2] = {{0u, 0u}, {0u, 0u}};
#pragma unroll
    for (int i = 0; i < 16; ++i) { const int q = (int)fminf(fmaxf(rintf(h[i] * PH_ISCALE), -119.f), 119.f);
        const int d0 = ((q + 8) & 15) - 8, d1 = (q - d0) >> 4; const int sh = 4 * (i & 7);
        hd[0][i >> 3] |= ((unsigned)d0 & 15u) << sh; hd[1][i >> 3] |= ((unsigned)d1 & 15u) << sh; }
    float acc[16];
#pragma unroll
    for (int i = 0; i < 16; ++i) acc[i] = 0.f;
    const int myr = ((lane >> 5) & 1) * 4 + ((lane >> 4) & 1) * 2 + ((lane >> 3) & 1);
#pragma unroll 1
    for (int g2 = SPLIT ? half * 4 : 0; g2 < (SPLIT ? half * 4 + 4 : 8); ++g2) {
        const unsigned idxv = g2 < 4 ? idx_lo : idx_hi; const float wv = g2 < 4 ? w_lo : w_hi; const int l0 = (g2 * 16) & 63;
        unsigned e[16];
#pragma unroll
        for (int rr = 0; rr < 16; ++rr) e[rr] = (unsigned)__builtin_amdgcn_readlane((int)idxv, l0 + rr);
        u32x4 uv[16];
#pragma unroll
        for (int rr = 0; rr < 16; ++rr) uv[rr] = *(const __attribute__((address_space(1))) u32x4*)(PUV + (e[rr] * 1024u + lo16));
#pragma unroll
        for (int hf = 0; hf < 2; ++hf) {
            int p[8];
#pragma unroll
            for (int rr = 0; rr < 8; ++rr) { const int ux = (int)uv[hf * 8 + rr].x, uy = (int)uv[hf * 8 + rr].y;
                int t = __builtin_amdgcn_sdot8(uy, (int)hd[1][1], __builtin_amdgcn_sdot8(ux, (int)hd[1][0], 0, false), false);
                t = __builtin_amdgcn_sdot8(uy, (int)hd[0][1], __builtin_amdgcn_sdot8(ux, (int)hd[0][0], t * 16, false), false);
                p[rr] = t; }
            int q4[4], q2[2], q1i;
#pragma unroll
            for (int i = 0; i < 4; ++i) { const auto r = __builtin_amdgcn_permlane32_swap((unsigned)p[i], (unsigned)p[i + 4], false, false); q4[i] = (int)r[0] + (int)r[1]; }
#pragma unroll
            for (int i = 0; i < 2; ++i) { const auto r = __builtin_amdgcn_permlane16_swap((unsigned)q4[i], (unsigned)q4[i + 2], false, false); q2[i] = (int)r[0] + (int)r[1]; }
            { const bool up = (lane & 8) != 0; const int send = up ? q2[0] : q2[1]; const int keep = up ? q2[1] : q2[0];
              q1i = keep + __builtin_amdgcn_update_dpp(0, send, 0x128, 0xf, 0xf, false); }
            q1i += __builtin_amdgcn_update_dpp(0, q1i, 0xB1, 0xf, 0xf, false);
            q1i += __builtin_amdgcn_update_dpp(0, q1i, 0x4E, 0xf, 0xf, false);
            q1i += __builtin_amdgcn_update_dpp(0, q1i, 0x141, 0xf, 0xf, false);
            const float q1 = (float)q1i;
            const float wsel = __shfl(wv, l0 + hf * 8 + myr);
            const float coef = wsel * geluf_(q1 * (1.0f / (PU_ISCALE * PH_ISCALE))) * (1.0f / PV_SCALE);
#pragma unroll
            for (int rr = 0; rr < 8; ++rr) { const float cf = __int_as_float(__builtin_amdgcn_readlane(__float_as_int(coef), ((rr & 4) ? 32 : 0) + ((rr & 2) ? 16 : 0) + ((rr & 1) ? 8 : 0))); fma16_fp4(acc, (u32x2){uv[hf * 8 + rr].z, uv[hf * 8 + rr].w}, cf); }
        }
    }
    if (SPLIT) {
        LAS float* xb = (LAS float*)c.lds + (c.wid >> 1) * 1024 + lane;
        if (half) {
#pragma unroll
            for (int i = 0; i < 16; ++i) xb[i * 64] = acc[i];
        }
        __syncthreads();
        if (half) return;
#pragma unroll
        for (int i = 0; i < 16; ++i) acc[i] += xb[i * 64];
    }
    const int b = r < NLAT ? (r >> 13) : 4;
    const float* gt = WSP(float, WS_MOD) + (size_t)(l * 5 + b) * 6144 + 5120 + lane * 16;
    const float* xr = (r < NLAT ? xsrc_lat + (size_t)r * 1024 : WSP(float, WS_XCTX) + (size_t)(r - NLAT) * 1024) + lane * 16;
    float* xw = (r < NLAT ? c.out + (size_t)r * 1024 : WSP(float, WS_XCTX) + (size_t)(r - NLAT) * 1024) + lane * 16;
    float xn[16]; float s = 0.f;
#pragma unroll
    for (int k = 0; k < 4; ++k) { const f32x4 xa = *(const f32x4*)(xr + 4 * k), ga = *(const f32x4*)(gt + 4 * k);
#pragma unroll
        for (int j = 0; j < 4; ++j) xn[4 * k + j] = xa[j] + ((ABL & 8) ? 0.f : ga[j] * acc[4 * k + j]); }
    if (FINAL) {
#pragma unroll
        for (int i = 0; i < 16; ++i) s += xn[i] * xn[i];
#pragma unroll
        for (int o = 32; o; o >>= 1) s += __shfl_xor(s, o);
        const float rs = rsqrtf(s * (1.f / 1024.f) + NORM_EPS); const float* gf = c.in[37] + lane * 16;
#pragma unroll
        for (int i = 0; i < 16; ++i) xn[i] *= rs * gf[i];
    }
#pragma unroll
    for (int k = 0; k < 4; ++k) *(f32x4*)(xw + 4 * k) = (f32x4){xn[4 * k], xn[4 * k + 1], xn[4 * k + 2], xn[4 * k + 3]};
    if (!FINAL) {
        float s2 = 0.f;
#pragma unroll
        for (int i = 0; i < 16; ++i) s2 += xn[i] * xn[i];
#pragma unroll
        for (int o = 32; o; o >>= 1) s2 += __shfl_xor(s2, o);
        const float rs = rsqrtf(s2 * (1.f / 1024.f) + NORM_EPS);
        const float* g1 = c.in[6] + (size_t)(l + 1) * 1024 + lane * 16; const float* m1 = WSP(float, WS_MOD) + (size_t)((l + 1) * 5 + b) * 6144 + lane * 16;
        float o[16];
#pragma unroll
        for (int k = 0; k < 4; ++k) { const f32x4 ga = *(const f32x4*)(g1 + 4 * k), sh = *(const f32x4*)(m1 + 4 * k), sc = *(const f32x4*)(m1 + 1024 + 4 * k);
#pragma unroll
            for (int j = 0; j < 4; ++j) o[4 * k + j] = xn[4 * k + j] * rs * ga[j] * (1.f + sc[j]) + sh[j]; }
        bf16_t* hw = WSP(bf16_t, WS_H) + (size_t)r * 1024 + lane * 16;
        u32x4 w0, w1; w0.x = pk_bf16(o[0], o[1]); w0.y = pk_bf16(o[2], o[3]); w0.z = pk_bf16(o[4], o[5]); w0.w = pk_bf16(o[6], o[7]);
        w1.x = pk_bf16(o[8], o[9]); w1.y = pk_bf16(o[10], o[11]); w1.z = pk_bf16(o[12], o[13]); w1.w = pk_bf16(o[14], o[15]);
        *(u32x4*)hw = w0; *(u32x4*)(hw + 8) = w1;
    }
}
constexpr int PH_PER_LAYER = 11, N_PHASES = 1 + 4 * PH_PER_LAYER;

DI void prep_item(const Ctx& c, int l, int it) {
    if (it < 448) { int ng = (it >> 3) * 2; const int kg = it & 7; if (ng >= 56) ng += 8;
        const int n0 = ng * 64, ns0 = n0 < 3584 ? n0 : n0 - 480;
        tr_tile128(c, c.in[8] + (size_t)l * 1024 * 7200, 7200, kg * 128, ns0, WSP(bf16_t, WS_BTIN), 1024, n0); return; }
    it -= 448;
    if (it < 128) { const int d = it >> 6, jg = (it >> 4) & 3, kg = it & 15; fold_tile(c, c.in[8] + (size_t)l * 1024 * 7200, c.in[25] + (size_t)l * 2 * 16 * 256, d, jg * 64, kg * 64, WSP(bf16_t, WS_BTIN)); return; }
    it -= 128;
    if (it < 96) { const int w = it >> 5, r = it & 31, ng = r >> 2, kg = r & 3;
        tr_tile128(c, c.in[28 + w] + (size_t)l * 512 * 1024, 1024, kg * 128, ng * 128, WSP(bf16_t, w == 0 ? WS_BTHY : (w == 1 ? WS_BTRG : WS_BTGLA)), 512, ng * 128); return; }
    it -= 96;
    if (it < 64) { const int ng = it >> 3, kg = it & 7; tr_tile128(c, c.in[32] + (size_t)l * 1024 * 1024, 1024, kg * 128, ng * 128, WSP(bf16_t, WS_BTOUT), 1024, ng * 128); return; }
    it -= 64;
    if (it < 128) { const int ng = it >> 3, kg = it & 7; tr_tile128(c, c.in[33] + (size_t)l * 1024 * 2048, 2048, kg * 128, ng * 128, WSP(bf16_t, WS_BTWQ), 1024, ng * 128); return; }
    it -= 128;
    if (it < 32) { const int d = it >> 4, mat = (it >> 3) & 1, g = it & 7;
        tr_tile(c, c.in[mat ? 22 : 20] + (size_t)((l * 2 + d) * 8 + g) * 4096, 64, 0, 0, WSP(bf16_t, WS_RGW) + (size_t)((d * 2 + mat) * 8 + g) * 4096, 64, 0); return; }
    it -= 32;
    if (it < 32) { cvt_chunk(c, c.in[34] + (size_t)l * 262144 + (size_t)it * 8192, WSP(bf16_t, WS_KEYS) + (size_t)it * 8192); return; }
    it -= 32;
    if (it < 2048) { cvt_chunk_int4_il(c, c.in[35] + (size_t)l * 16777216 + (size_t)it * 8192, c.ws + WS_PU + (size_t)it * 8192, PU_ISCALE); return; }
    it -= 2048;
    cvt_chunk_fp4_il(c, c.in[36] + (size_t)l * 16777216 + (size_t)it * 8192, c.ws + WS_PU + (size_t)it * 8192, PV_SCALE, 1);
}
constexpr int N_PREP = 448 + 128 + 96 + 64 + 128 + 32 + 32 + 2048 + 2048;

__global__ void __launch_bounds__(512, 2) fwd_kernel(Args a) {
    extern __shared__ __attribute__((aligned(16))) unsigned char shm[];
    Ctx c0; c0.in = a.in; c0.out = a.out; c0.ws = a.ws; c0.lds = (LAS unsigned char*)shm;
    c0.tid = threadIdx.x; c0.lane = c0.tid & 63; c0.wid = __builtin_amdgcn_readfirstlane(c0.tid >> 6); c0.G = gridDim.x; c0.bid = blockIdx.x;
    const Ctx& c = c0;
    volatile LAS unsigned* barw = (volatile LAS unsigned*)(c.lds + LDS_BARW);
    if (c.tid < 4) barw[c.tid] = 0u;
    tw_init(c);
    __syncthreads();
    const int lo = a.ph_lo, hi = a.ph_hi;
    XcdBarrier bar; bar.bar = (unsigned*)(c.ws + WS_CTL); bar.x = 0; bar.st = barw;
    if (hi - lo > 1) bar = xcd_barrier_post((unsigned*)(c.ws + WS_CTL), barw);
#ifdef ONLY_PHASE
#define PHON(j) ((j) == ONLY_PHASE)
#else
#define PHON(j) 1
#endif
#ifdef ONLY_SUB
#define SUB(j) ((j) == ONLY_SUB)
#else
#define SUB(j) 1
#endif
#define PH_BEGIN() Ctx cc = c0; int ll = l0; asm volatile("" : "+s"(ll)); asm volatile("" : "+v"(cc.tid)); cc.lane = cc.tid & 63; cc.wid = __builtin_amdgcn_readfirstlane(cc.tid >> 6); asm volatile("" : "+s"(cc.bid)); const Ctx& c = cc; const int l = ll; (void)l;
#define IN(k) (lo <= (k) && (k) < hi)
#ifdef DEBUG_TIME
#define STAMP(k) do { if (c0.bid == 0 && c0.tid == 0) ((unsigned long long*)(c0.ws + WS_CTL + 40000))[(k)] = wall_clock64(); } while (0)
#else
#define STAMP(k) do {} while (0)
#endif
#define SEAM(k) do { if (IN(k) && IN((k) + 1)) xcd_barrier(bar); STAMP((k) + 1); } while (0)
    int ph = 0;
    STAMP(0);
    if (PHON(0) && IN(ph)) p0_prologue(c);
    SEAM(ph); ++ph;
#pragma unroll 1
    for (int l0 = 0; l0 < 4; ++l0) {
        if (PHON(1) && IN(ph)) { PH_BEGIN(); const float* xlat_in = l == 0 ? c.in[0] : c.out; const float* modl = WSP(float, WS_MOD) + (size_t)l * 5 * 6144; (void)xlat_in; (void)modl;
            for (int it = c.bid; it < 272; it += c.G) hy_filter_tile(c, l, it);
            const int NL = N_PREP + (l == 0 ? NTOK / 8 : 0);
#pragma unroll 1
            for (int k = 0; ; ++k) {
                int j;
                const int R = c.G > 16 ? 36 : 0, Gr = c.G - 16;
                if (k < R) { if (c.bid < 16) continue; j = k * Gr + c.bid - 16; if (j >= NL) continue; }
                else { j = R * Gr + (k - R) * c.G + c.bid; if (j >= NL) break; }
                if (j < N_PREP) prep_item(c, l, j);
                else norm_row_to_h<0>(c, l, (j - N_PREP) * 8 + c.wid, xlat_in);
            }
        }
        SEAM(ph); ++ph;
        if (PHON(2) && IN(ph)) { PH_BEGIN(); const float* xlat_in = l == 0 ? c.in[0] : c.out; const float* modl = WSP(float, WS_MOD) + (size_t)l * 5 * 6144; (void)xlat_in; (void)modl;
            SchedIn S; S.so.init(NTOK, 7680, c.G, c.bid); S.H = (const char*)WSP(bf16_t, WS_H); S.Bt = (const char*)WSP(bf16_t, WS_BTIN);
            EpiIn E{WSP(bf16_t, WS_P2), WSP(bf16_t, WS_HYT), WSP(bf16_t, WS_HYTC), c.in[26] + (size_t)l * 512, c.in[31] + (size_t)l * 3072, WSP(bf16_t, WS_GF)};
            if (SUB(0)) pg8::gemm_phase<EpiIn, SchedIn>(c.lds, 1024, S, E);
            __syncthreads();
            if (SUB(1)) for (int it = c.bid; it < 512; it += c.G) hy_spec_pair_item(c, it >> 8, it & 255);
        }
        SEAM(ph); ++ph;
        if (PHON(3) && IN(ph)) { PH_BEGIN(); const float* xlat_in = l == 0 ? c.in[0] : c.out; const float* modl = WSP(float, WS_MOD) + (size_t)l * 5 * 6144; (void)xlat_in; (void)modl;
#ifdef DEBUG_SUB
            for (int it = c.bid; it < 1024; it += c.G) hy_lat_item(c, l, it >> 9, it & 511);
            xcd_barrier(bar); if (c0.bid == 0 && c0.tid == 0) ((unsigned long long*)(c0.ws + WS_CTL + 48000))[l * 8 + 0] = wall_clock64();
            for (int it = c.bid; it < 256; it += c.G) { if (l < 3) { const int w = it * 8 + c.wid; hy_ctx_item(c, l, w >> 9, w & 511); } __syncthreads(); }
            xcd_barrier(bar); if (c0.bid == 0 && c0.tid == 0) ((unsigned long long*)(c0.ws + WS_CTL + 48000))[l * 8 + 1] = wall_clock64();
            for (int it = c.bid; it < 4 * NCHK; it += c.G) { rg_item<false>(c, l, it); __syncthreads(); }
            xcd_barrier(bar); if (c0.bid == 0 && c0.tid == 0) ((unsigned long long*)(c0.ws + WS_CTL + 48000))[l * 8 + 2] = wall_clock64();
            for (int it = c.bid; it < 16 * NCHK; it += c.G) gla_a_item(c, it);
#else
            const int n_items = 1024 + 256 + 4 * NCHK;
            for (int it = c.bid; it < n_items; it += c.G) {
                if (it < 1024) { if (SUB(0)) hy_lat_item(c, l, it >> 9, it & 511); }
                else if (it < 1280) { if (SUB(1) && l < 3) { const int w = (it - 1024) * 8 + c.wid; hy_ctx_item(c, l, w >> 9, w & 511); } __syncthreads(); }
                else { if (SUB(2)) { rg_item<false>(c, l, it - 1280); __syncthreads(); } }
            }
#pragma unroll 1
            for (int k = 0; ; ++k) {
                const int R = c.G > 16 ? 7 : 0, Gr = c.G - 16; int j;
                if (k < R) { if (c.bid < 16) continue; j = k * Gr + c.bid - 16; }
                else { j = R * Gr + (k - R) * c.G + c.bid; if (j >= 16 * NCHK) break; }
                if (SUB(3)) gla_a_item(c, j);
            }
#endif
        }
        SEAM(ph); ++ph;
        if (PHON(4) && IN(ph)) { PH_BEGIN(); const float* xlat_in = l == 0 ? c.in[0] : c.out; const float* modl = WSP(float, WS_MOD) + (size_t)l * 5 * 6144; (void)xlat_in; (void)modl;
            rg_carry_scan(c);
            gla_state_scan(c);
            if (c.G > 8) { if (c.bid >= 8) for (int it = c.bid - 8; it < 2048; it += c.G - 8) yhy_tr_tile2(c, it); }
            else for (int it = c.bid; it < 2048; it += c.G) yhy_tr_tile2(c, it);
        }
        SEAM(ph); ++ph;
        if (PHON(5) && IN(ph)) { PH_BEGIN(); const float* xlat_in = l == 0 ? c.in[0] : c.out; const float* modl = WSP(float, WS_MOD) + (size_t)l * 5 * 6144; (void)xlat_in; (void)modl;
#ifdef DEBUG_SUB
            for (int it = c.bid; it < 4 * NCHK; it += c.G) { rg_c_item(c, it); __syncthreads(); }
            xcd_barrier(bar); if (c0.bid == 0 && c0.tid == 0) ((unsigned long long*)(c0.ws + WS_CTL + 48000))[l * 8 + 4] = wall_clock64();
            for (int it = c.bid; it < 8 * NCHK; it += c.G) gla_c_item(c, l, it);
        }
#else
            const bool lat = l == 3; const int n_rg = lat ? 512 : 4 * NCHK, n_items = lat ? 512 + 1024 : 4 * NCHK + 8 * NCHK;
            for (int it = c.bid; it < n_items; it += c.G) {
                if (it < n_rg) { if (SUB(0)) { rg_c_item(c, lat ? (it >> 7) * NCHK + 4 + (it & 127) : it); __syncthreads(); } }
                else { const int j = it - n_rg, bc = j >> 1; if (SUB(1)) gla_c_item(c, l, lat ? ((((bc >> 7) * NCHK + 4 + (bc & 127)) << 1) | (j & 1)) : j); }
            }
        }
#endif
        SEAM(ph); ++ph;
        if (PHON(6) && IN(ph)) { PH_BEGIN(); const float* xlat_in = l == 0 ? c.in[0] : c.out; const float* modl = WSP(float, WS_MOD) + (size_t)l * 5 * 6144; (void)xlat_in; (void)modl;
            SchedMg S; S.so.init(l == 3 ? NLAT : NTOK, 1024, c.G, c.bid); S.ws = (const char*)c.ws;
            EpiMg E{c.ws};
            pg8::gemm_phase<EpiMg, SchedMg>(c.lds, 512, S, E);
        }
        SEAM(ph); ++ph;
        if (PHON(7) && IN(ph)) { PH_BEGIN(); const float* xlat_in = l == 0 ? c.in[0] : c.out; const float* modl = WSP(float, WS_MOD) + (size_t)l * 5 * 6144; (void)xlat_in; (void)modl;
            SchedPlain S; S.so.init(l == 3 ? NLAT : NTOK, 1024, c.G, c.bid); S.A0 = (const char*)WSP(bf16_t, WS_M); S.B0 = (const char*)WSP(bf16_t, WS_BTOUT); S.ts = (size_t)256 * 1024 * 2;
            EpiOut E{xlat_in, c.out, WSP(float, WS_XCTX), modl};
            pg8::gemm_phase<EpiOut, SchedPlain>(c.lds, 1024, S, E);
        }
        SEAM(ph); ++ph;
        if (PHON(8) && IN(ph)) { PH_BEGIN(); const float* xlat_in = l == 0 ? c.in[0] : c.out; const float* modl = WSP(float, WS_MOD) + (size_t)l * 5 * 6144; (void)xlat_in; (void)modl;
            for (int it = c.bid; it < (l == 3 ? NLAT : NTOK) / 8; it += c.G) norm_row_to_h<1>(c, l, it * 8 + c.wid, c.out);
        }
        SEAM(ph); ++ph;
        if (PHON(9) && IN(ph)) { PH_BEGIN(); const float* xlat_in = l == 0 ? c.in[0] : c.out; const float* modl = WSP(float, WS_MOD) + (size_t)l * 5 * 6144; (void)xlat_in; (void)modl;
            SchedPlain S; S.so.init(l == 3 ? NLAT : NTOK, 2048, c.G, c.bid); S.A0 = (const char*)WSP(bf16_t, WS_H); S.B0 = (const char*)WSP(bf16_t, WS_BTWQ); S.ts = (size_t)256 * 1024 * 2;
            EpiQ E{WSP(bf16_t, WS_Q)};
            pg8::gemm_phase<EpiQ, SchedPlain>(c.lds, 1024, S, E);
        }
        SEAM(ph); ++ph;
        if (PHON(10) && IN(ph)) { PH_BEGIN(); const float* xlat_in = l == 0 ? c.in[0] : c.out; const float* modl = WSP(float, WS_MOD) + (size_t)l * 5 * 6144; (void)xlat_in; (void)modl;
            for (int it = c.bid; it < NLAT / 32; it += c.G) peer_topk_wave(c, it, c.wid);
            if (l < 3) for (int j = c.bid; j < (NTOK - NLAT) / 32 * 8; j += c.G) { if (c.wid == (j & 7)) peer_topk_wave(c, NLAT / 32 + (j >> 3), j & 7); }
        }
        SEAM(ph); ++ph;
        if (PHON(11) && IN(ph)) { PH_BEGIN(); const float* xlat_in = l == 0 ? c.in[0] : c.out; const float* modl = WSP(float, WS_MOD) + (size_t)l * 5 * 6144; (void)xlat_in; (void)modl;
            if (l < 3) { for (int it = c.bid; it < NLAT / 8; it += c.G) peer_expert_token<false>(c, l, it * 8 + c.wid, c.out);
                for (int it = c.bid; it < (NTOK - NLAT) / 4; it += c.G) peer_expert_token<false, true>(c, l, NLAT + it * 4 + (c.wid >> 1), c.out); }
            else { for (int it = c.bid; it < NLAT / 8; it += c.G) peer_expert_token<true>(c, l, it * 8 + c.wid, c.out); }
        }
        SEAM(ph); ++ph;
    }
#undef IN
#undef SEAM
}

#if !defined(DEBUG_DET) && !defined(DEBUG_PEER) && !defined(DEBUG_TIME)
#ifndef N_LAUNCH_MODE
#define N_LAUNCH_MODE 0
#endif
extern "C" void kernel_launch(void* const* d_in, const int* in_sizes, int n_in, void* d_out, int out_size, void* d_ws, size_t ws_size, hipStream_t stream) {
    static int grid = 0;
    if (grid == 0) {
        if (n_in != 38 || ws_size < WS_END) { fprintf(stderr, "kernel_launch: need 38 inputs and %zu bytes of workspace (got %d, %zu)\n", (size_t)WS_END, n_in, ws_size); grid = -1; return; }
        int dev = 0, cus = 0, per_cu = 0;
        if (hipGetDevice(&dev) != hipSuccess || hipDeviceGetAttribute(&cus, hipDeviceAttributeMultiprocessorCount, dev) != hipSuccess) { grid = -1; return; }
        if (hipFuncSetAttribute((const void*)fwd_kernel, hipFuncAttributeMaxDynamicSharedMemorySize, LDS_BYTES) != hipSuccess) { fprintf(stderr, "kernel_launch: hipFuncSetAttribute failed\n"); grid = -1; return; }
        if (hipOccupancyMaxActiveBlocksPerMultiprocessor(&per_cu, (const void*)fwd_kernel, 512, LDS_BYTES) != hipSuccess || per_cu < 1) { fprintf(stderr, "kernel_launch: occupancy query says %d\n", per_cu); }
        (void)hipGetLastError();
        grid = cus;
    }
    if (grid < 0) return;
    (void)hipMemsetAsync((char*)d_ws + WS_CTL, 0, 65536, stream);
    Args a; memset(&a, 0, sizeof(a));
    for (int i = 0; i < 38; ++i) a.in[i] = (const float*)d_in[i];
    a.out = (float*)d_out; a.ws = (unsigned char*)d_ws;
#if N_LAUNCH_MODE == 1
    a.ph_lo = 0; a.ph_hi = N_PHASES;
    hipLaunchKernelGGL(fwd_kernel, dim3(grid), dim3(512), LDS_BYTES, stream, a);
#else
    for (int p = 0; p < N_PHASES; ++p) { a.ph_lo = p; a.ph_hi = p + 1; hipLaunchKernelGGL(fwd_kernel, dim3(grid), dim3(512), LDS_BYTES, stream, a); }
#endif
}
#endif
```
